# Optimizing an MI355X kernel written in HIP

```python
import math
import jax, jax.numpy as jnp
from jax import lax
import numpy as np

D_MODEL = 2048
BATCH = 4
SEQ = 2048
DEPTH = 4
DEC_BATCH = 32
DEC_SEQ = 8
PAST_LEN = 16384
PAGE_SIZE = 128

N_EVEN = (DEPTH + 1) // 2
N_ODD = DEPTH // 2
D_FF = ((8 * D_MODEL // 3 + 127) // 128) * 128
D_CONV = D_MODEL // 2
CONV_K = 3
D_POOL = D_MODEL // 2
POOL_WINDOWS = (2, 4, 8, 16)
N_POOL_GROUPS = len(POOL_WINDOWS)
POOL_GW = D_POOL // N_POOL_GROUPS
POOL_CTX = max(POOL_WINDOWS) - 1
HEAD_DIM = 64
N_HEADS = D_MODEL // HEAD_DIM
N_KV_HEADS = N_HEADS // 8
GQ = N_HEADS // N_KV_HEADS
WINDOW = 128
BLOCK = WINDOW
KV_BUF = min(WINDOW, PAST_LEN)
ATTN_SCALE = HEAD_DIM ** -0.5
N_BUCKETS = 32
MAX_DISTANCE = 128
EPS = 1e-6
NEG = -1e30

kernel_name = "hybrid_conv_pool_swa_macaron_step"


def rms_norm(x, g):
    xf = x.astype(jnp.float32)
    y = xf * lax.rsqrt(jnp.mean(xf * xf, axis=-1, keepdims=True) + EPS)
    return (y * g.astype(jnp.float32)).astype(x.dtype)


def swiglu(x, w_in, w_out):
    gate, up = jnp.split(x @ w_in, 2, axis=-1)
    return (jax.nn.silu(gate) * up) @ w_out


def short_conv(v, ctx, w):
    L = v.shape[1]
    ext = jnp.concatenate([ctx.astype(v.dtype), v], axis=1)
    y = w[0] * ext[:, 0:L]
    for k in range(1, CONV_K):
        y = y + w[k] * ext[:, k:k + L]
    return y, ext[:, -(CONV_K - 1):]


def pool_mix(u, ctx, p0, w_grp, scale):
    N, L, _ = u.shape
    ext = jnp.concatenate([ctx.astype(u.dtype), u], axis=1)
    extf = ext.astype(jnp.float32)
    cs = jnp.concatenate([jnp.zeros((N, 1, D_POOL), jnp.float32), jnp.cumsum(extf, axis=1)], axis=1)
    end = cs[:, POOL_CTX + 1:POOL_CTX + 1 + L]
    pos = p0 + jnp.arange(L)
    uf = u.astype(jnp.float32)
    outs = []
    for gi, w in enumerate(POOL_WINDOWS):
        c0, c1 = gi * POOL_GW, (gi + 1) * POOL_GW
        start = cs[:, POOL_CTX + 1 - w:POOL_CTX + 1 - w + L, c0:c1]
        cnt = jnp.minimum(w, pos + 1).astype(jnp.float32)[None, :, None]
        outs.append((end[..., c0:c1] - start) / cnt - uf[..., c0:c1])
    d = jnp.stack(outs, axis=2).astype(u.dtype)
    y = jnp.einsum('nlgc,gcd->nlgd', d, w_grp).reshape(N, L, D_POOL)
    return y * scale, ext[:, -POOL_CTX:]


def t5_bucket(dist):
    max_exact = N_BUCKETS // 2
    n = jnp.maximum(dist, 0)
    ratio = jnp.log(jnp.maximum(n, 1).astype(jnp.float32) / max_exact) / math.log(MAX_DISTANCE / max_exact)
    large = jnp.minimum(max_exact + (ratio * (N_BUCKETS - max_exact)).astype(jnp.int32), N_BUCKETS - 1)
    return jnp.where(n < max_exact, n, large)


def sink_attend(q, k, v, dist, valid, sinks, rel_bias):
    Qn, Sn = dist.shape
    s = jnp.einsum('nbqkgd,nbskd->nbkgqs', q, k, preferred_element_type=jnp.float32) * ATTN_SCALE
    bias = rel_bias[t5_bucket(dist)].astype(jnp.float32)
    s = s + bias.transpose(2, 0, 1).reshape(N_KV_HEADS, GQ, Qn, Sn)
    s = jnp.where(valid[None, :, None, None], s, NEG)
    sink = sinks.astype(jnp.float32).reshape(N_KV_HEADS, GQ)[:, :, None, None]
    m = jnp.maximum(jnp.max(s, axis=-1, keepdims=True), sink)
    p = jnp.exp(s - m)
    p = p / (jnp.sum(p, axis=-1, keepdims=True) + jnp.exp(sink - m))
    return jnp.einsum('nbkgqs,nbskd->nbqkgd', p.astype(v.dtype), v)


def attn_prompt(q, k, v, sinks, rel_bias):
    N, L = q.shape[:2]
    nb = L // BLOCK
    qb = q.reshape(N, nb, BLOCK, N_KV_HEADS, GQ, HEAD_DIM)

    def band(t):
        tb = t.reshape(N, nb, BLOCK, N_KV_HEADS, HEAD_DIM)
        prev = jnp.concatenate([jnp.zeros_like(tb[:, :1]), tb[:, :-1]], axis=1)
        return jnp.concatenate([prev, tb], axis=2)

    qi = jnp.arange(BLOCK)[:, None]
    sj = jnp.arange(2 * BLOCK)[None, :]
    dist = BLOCK + qi - sj
    blk = jnp.arange(nb)[:, None, None]
    valid = (dist >= 0) & (dist <= WINDOW) & ((blk - 1) * BLOCK + sj >= 0)
    o = sink_attend(qb, band(k), band(v), dist, valid, sinks, rel_bias)
    return o.reshape(N, L, N_HEADS * HEAD_DIM)


def attn_sample(q, k, v, k_ctx, v_ctx, sinks, rel_bias):
    N, L = q.shape[:2]
    W = k_ctx.shape[1]
    kk = jnp.concatenate([k_ctx.astype(k.dtype), k], axis=1)
    vv = jnp.concatenate([v_ctx.astype(v.dtype), v], axis=1)
    qi = jnp.arange(L)[:, None]
    sj = jnp.arange(W + L)[None, :]
    dist = qi + W - sj
    valid = ((dist >= 0) & (dist <= WINDOW))[None]
    o = sink_attend(q.reshape(N, 1, L, N_KV_HEADS, GQ, HEAD_DIM), kk[:, None], vv[:, None],
                    dist, valid, sinks, rel_bias)
    return o.reshape(N, L, N_HEADS * HEAD_DIM), kk[:, -W:], vv[:, -W:]


def _trunk(x, conv_ctx, pool_ctx, k_ctx, v_ctx, p0, prompt, norm_g, w_ffn_in, w_ffn_out,
           w_mix_in, conv_w, pool_w, pool_scale, w_mix_out, w_qkv, w_o, attn_sinks, rel_bias):
    new_conv, new_pool, new_k, new_v = [], [], [], []
    for i in range(DEPTH):
        g = norm_g[i]
        x = x + 0.5 * rms_norm(swiglu(rms_norm(x, g[0]), w_ffn_in[i, 0], w_ffn_out[i, 0]), g[1])
        h = rms_norm(x, g[2])
        j = i // 2
        if i % 2 == 0:
            z = h @ w_mix_in[j]
            hc, gc, gb, u = jnp.split(z, [D_CONV, 2 * D_CONV, 3 * D_CONV], axis=-1)
            yc, cc = short_conv(gc * hc, conv_ctx[j], conv_w[j])
            yp, pc = pool_mix(u, pool_ctx[j], p0, pool_w[j], pool_scale[j])
            mix = jnp.concatenate([gb * yc, yp], axis=-1) @ w_mix_out[j]
            new_conv.append(cc)
            new_pool.append(pc)
        else:
            n, l = h.shape[:2]
            q, k, v = jnp.split(h @ w_qkv[j], [N_HEADS * HEAD_DIM, (N_HEADS + N_KV_HEADS) * HEAD_DIM], axis=-1)
            k = k.reshape(n, l, N_KV_HEADS, HEAD_DIM)
            v = v.reshape(n, l, N_KV_HEADS, HEAD_DIM)
            if prompt:
                att = attn_prompt(q, k, v, attn_sinks[j], rel_bias)
                kc, vc = k[:, -KV_BUF:], v[:, -KV_BUF:]
            else:
                att, kc, vc = attn_sample(q, k, v, k_ctx[j], v_ctx[j], attn_sinks[j], rel_bias)
            mix = att @ w_o[j]
            new_k.append(kc)
            new_v.append(vc)
        x = x + rms_norm(mix, g[3])
        x = x + 0.5 * rms_norm(swiglu(rms_norm(x, g[4]), w_ffn_in[i, 1], w_ffn_out[i, 1]), g[5])
    return x, jnp.stack(new_conv), jnp.stack(new_pool), jnp.stack(new_k), jnp.stack(new_v)


def setup_inputs(seed: int = 0) -> dict:
    key = jax.random.key(seed)
    ks = jax.random.split(key, 18)

    def nrm(k, shape, scale):
        return jax.random.normal(k, shape, jnp.float32) * scale

    return {
        "x_prompt": nrm(ks[0], (BATCH, SEQ, D_MODEL), 1.0),
        "x_sample": nrm(ks[1], (DEC_BATCH, DEC_SEQ, D_MODEL), 1.0),
        "state_conv": nrm(ks[2], (N_EVEN, DEC_BATCH, CONV_K - 1, D_CONV), 1.0),
        "state_pool": nrm(ks[3], (N_EVEN, DEC_BATCH, POOL_CTX, D_POOL), 1.0),
        "cache_k": nrm(ks[4], (N_ODD, DEC_BATCH, KV_BUF, N_KV_HEADS, HEAD_DIM), 1.0),
        "cache_v": nrm(ks[5], (N_ODD, DEC_BATCH, KV_BUF, N_KV_HEADS, HEAD_DIM), 1.0),
        "norm_g": 1.0 + nrm(ks[6], (DEPTH, 6, D_MODEL), 0.05),
        "w_ffn_in": nrm(ks[7], (DEPTH, 2, D_MODEL, 2 * D_FF), D_MODEL ** -0.5),
        "w_ffn_out": nrm(ks[8], (DEPTH, 2, D_FF, D_MODEL), D_FF ** -0.5),
        "w_mix_in": nrm(ks[9], (N_EVEN, D_MODEL, 3 * D_CONV + D_POOL), D_MODEL ** -0.5),
        "conv_w": nrm(ks[10], (N_EVEN, CONV_K, D_CONV), CONV_K ** -0.5),
        "pool_w": nrm(ks[11], (N_EVEN, N_POOL_GROUPS, POOL_GW, POOL_GW), POOL_GW ** -0.5),
        "pool_scale": 1.0 + nrm(ks[12], (N_EVEN, D_POOL), 0.1),
        "w_mix_out": nrm(ks[13], (N_EVEN, D_CONV + D_POOL, D_MODEL), (D_CONV + D_POOL) ** -0.5),
        "w_qkv": nrm(ks[14], (N_ODD, D_MODEL, (N_HEADS + 2 * N_KV_HEADS) * HEAD_DIM), D_MODEL ** -0.5),
        "w_o": nrm(ks[15], (N_ODD, N_HEADS * HEAD_DIM, D_MODEL), (N_HEADS * HEAD_DIM) ** -0.5),
        "attn_sinks": nrm(ks[16], (N_ODD, N_HEADS), 0.5),
        "rel_bias": nrm(ks[17], (N_BUCKETS, N_HEADS), 0.5),
    }


def reference(x_prompt, x_sample, state_conv, state_pool, cache_k, cache_v, norm_g, w_ffn_in,
              w_ffn_out, w_mix_in, conv_w, pool_w, pool_scale, w_mix_out, w_qkv, w_o,
              attn_sinks, rel_bias):
    nbp = x_prompt.shape[0]
    conv0 = jnp.zeros((N_EVEN, nbp, CONV_K - 1, D_CONV), x_prompt.dtype)
    pool0 = jnp.zeros((N_EVEN, nbp, POOL_CTX, D_POOL), x_prompt.dtype)
    y_prompt, conv_p, pool_p, k_p, v_p = _trunk(
        x_prompt, conv0, pool0, None, None, 0, True, norm_g, w_ffn_in, w_ffn_out,
        w_mix_in, conv_w, pool_w, pool_scale, w_mix_out, w_qkv, w_o, attn_sinks, rel_bias)
    y_sample, conv_s, pool_s, k_s, v_s = _trunk(
        x_sample, state_conv, state_pool, cache_k, cache_v, PAST_LEN, False, norm_g, w_ffn_in,
        w_ffn_out, w_mix_in, conv_w, pool_w, pool_scale, w_mix_out, w_qkv, w_o, attn_sinks, rel_bias)
    return (y_prompt, y_sample, conv_p, pool_p, k_p, v_p, conv_s, pool_s, k_s, v_s)
```

```cpp
#include <hip/hip_runtime.h>
#include <cstdio>
#include <cstdint>

#define LAS __attribute__((address_space(3)))
#define GAS __attribute__((address_space(1)))

namespace pg8 {
typedef unsigned short bf16_t;
typedef short bf16x8 __attribute__((ext_vector_type(8)));
typedef float f32x4 __attribute__((ext_vector_type(4)));
typedef float f32x2 __attribute__((ext_vector_type(2)));
typedef unsigned u32x4 __attribute__((ext_vector_type(4)));
constexpr int BM = 256, BK = 64, HALF = 128, HTB = HALF * BK * 2, STAGE_BYTES = 8 * HTB, NXCD = 8, WGM = 8;

__host__ __device__ __forceinline__ int lds_byte(int r, int c) { const int st = (r >> 4) * 2 + (c >> 5), rr = r & 15, cc = c & 31, ob = rr * 64 + cc * 2; return st * 1024 + (ob ^ (((ob >> 9) & 1) << 5)); }
__host__ __device__ __forceinline__ void stage_rc(int b, int& R, int& C) { const int st = b / 1024, sb = b % 1024, swz = sb ^ (((sb >> 9) & 1) << 5); R = (st >> 1) * 16 + swz / 64; C = (st & 1) * 32 + (swz % 64) / 2; }
__host__ __device__ __forceinline__ int perm32(int rho) { const int n = rho >> 4, i = rho & 15; return 8 * (i >> 2) + 4 * n + (i & 3); }

struct Unit { int pm, pn; };
struct Gemm { const bf16_t* A; const bf16_t* Bt; int M, N, K, lda, ldb, a_grp; };

struct StaticOrder {
    int nM, nN, nwg, G, c;
    __host__ __device__ void init(int M, int N, int G_, int c_) { nM = M / BM; nN = N / BM; nwg = nM * nN; G = G_; c = c_; }
    __host__ __device__ bool next(int i, Unit& u) const {
        const long L = (long)i * G + c; if (L >= nwg) return false;
        int wgid = (int)L; { const int q = nwg / NXCD, r = nwg % NXCD, xcd = wgid % NXCD, off = wgid / NXCD; wgid = (xcd < r ? xcd * (q + 1) : r * (q + 1) + (xcd - r) * q) + off; }
        const int nig = WGM * nN, gid = wgid / nig, fm = gid * WGM, gsz = (nM - fm) < WGM ? (nM - fm) : WGM;
        u.pm = fm + ((wgid % nig) % gsz); u.pn = (wgid % nig) / gsz; return true;
    }
    __device__ __forceinline__ void a_ready(const Unit&) const {}
    __device__ __forceinline__ void done(const Unit&) const {}
};

__device__ __forceinline__ unsigned cvt_pk_bf16(float lo, float hi) { unsigned r; asm volatile("v_cvt_pk_bf16_f32 %0, %1, %2" : "=v"(r) : "v"(lo), "v"(hi)); return r; }

struct EpiF32 {
    static constexpr bool PERM = false, AFTER_DRAIN = false;
    float* C; int ldc;
    __device__ __forceinline__ void operator()(const f32x4 (&acc)[2][2][4][2], const Unit& u, int wr, int wc, int fr, int fq) const {
        const int row0 = u.pm * BM + wr * 64 + fr, col0 = u.pn * BM + wc * 32 + 4 * fq;
#pragma unroll
        for (int ai = 0; ai < 2; ++ai)
#pragma unroll
            for (int m = 0; m < 4; ++m) { float* rowp = C + (size_t)(row0 + ai * HALF + m * 16) * ldc + col0;
#pragma unroll
                for (int bj = 0; bj < 2; ++bj)
#pragma unroll
                    for (int n = 0; n < 2; ++n) *(f32x4*)(rowp + bj * HALF + n * 16) = acc[ai][bj][m][n]; }
    }
};
struct EpiBf16S {
    static constexpr bool PERM = true, AFTER_DRAIN = false;
    bf16_t* O; int ldc; const float* scale; int col_off;
    __device__ __forceinline__ void operator()(const f32x4 (&acc)[2][2][4][2], const Unit& u, int wr, int wc, int fr, int fq) const {
        const int row0 = u.pm * BM + wr * 64 + fr; const int col0 = u.pn * BM + wc * 32 + 8 * fq;
        f32x4 sv[2][2];
#pragma unroll
        for (int bj = 0; bj < 2; ++bj)
#pragma unroll
            for (int n = 0; n < 2; ++n) sv[bj][n] = scale ? *(const f32x4*)(scale + col0 + bj * HALF + 4 * n) : (f32x4){1.f, 1.f, 1.f, 1.f};
#pragma unroll
        for (int ai = 0; ai < 2; ++ai)
#pragma unroll
            for (int m = 0; m < 4; ++m) { bf16_t* rowp = O + (size_t)(row0 + ai * HALF + m * 16) * ldc + col_off + col0;
#pragma unroll
                for (int bj = 0; bj < 2; ++bj) { const f32x4 v0 = acc[ai][bj][m][0] * sv[bj][0], v1 = acc[ai][bj][m][1] * sv[bj][1];
                    u32x4 w; w.x = cvt_pk_bf16(v0[0], v0[1]); w.y = cvt_pk_bf16(v0[2], v0[3]); w.z = cvt_pk_bf16(v1[0], v1[1]); w.w = cvt_pk_bf16(v1[2], v1[3]);
                    *(u32x4*)(rowp + bj * HALF) = w; } }
    }
};
__device__ __forceinline__ float silu_mul(float g, float u) { const float e = __builtin_amdgcn_exp2f(g * -1.44269504089f); return g * __builtin_amdgcn_rcpf(1.0f + e) * u; }
struct EpiSwiGLU {
    static constexpr bool PERM = true, AFTER_DRAIN = false;
    bf16_t* O; int ldc;
    __device__ __forceinline__ void operator()(const f32x4 (&acc)[2][2][4][2], const Unit& u, int wr, int wc, int fr, int fq) const {
        const int row0 = u.pm * BM + wr * 64 + fr; const int col0 = u.pn * HALF + wc * 32 + 8 * fq;
#pragma unroll
        for (int ai = 0; ai < 2; ++ai)
#pragma unroll
            for (int m = 0; m < 4; ++m) { bf16_t* rowp = O + (size_t)(row0 + ai * HALF + m * 16) * ldc + col0;
                const f32x4 g0 = acc[ai][0][m][0], g1 = acc[ai][0][m][1], u0 = acc[ai][1][m][0], u1 = acc[ai][1][m][1];
                u32x4 w; w.x = cvt_pk_bf16(silu_mul(g0[0], u0[0]), silu_mul(g0[1], u0[1])); w.y = cvt_pk_bf16(silu_mul(g0[2], u0[2]), silu_mul(g0[3], u0[3]));
                w.z = cvt_pk_bf16(silu_mul(g1[0], u1[0]), silu_mul(g1[1], u1[1])); w.w = cvt_pk_bf16(silu_mul(g1[2], u1[2]), silu_mul(g1[3], u1[3]));
                *(u32x4*)rowp = w; }
    }
};

template <class Epi, class Sched, bool ALIGN_EPI = false, bool SP2 = false>
__device__ __forceinline__ void gemm_phase(LAS unsigned char* lds, const Gemm g, const Sched& S, const Epi& E) {
    int tid = threadIdx.x; asm volatile("" : "+v"(tid));
    const int wid = __builtin_amdgcn_readfirstlane(tid >> 6), lane = tid & 63, wr = wid >> 2, wc = wid & 3, fr = lane & 15, fq = lane >> 4;
    const int K = g.K, nt = K / BK;
    unsigned voffA[2], voffB[2];
#pragma unroll
    for (int i = 0; i < 2; ++i) { int R, C; stage_rc(tid * 16 + i * 8192, R, C); const int Rb = Epi::PERM ? ((R & ~31) + perm32(R & 31)) : R;
        voffA[i] = (unsigned)(R * g.lda + C) * 2u; voffB[i] = (unsigned)(Rb * g.ldb + C) * 2u; }
    const size_t kstep = (size_t)(BK * 2);
    const size_t hstepA = (size_t)HALF * g.lda * 2, hstepB = (size_t)HALF * g.ldb * 2;
    const size_t tstepA = 2 * hstepA, tstepB = 2 * hstepB;
    const unsigned ldsw = (unsigned)wid * 1024u;
    const int aoff = lds_byte(wr * 64 + fr, fq * 8), boff = lds_byte(wc * 32 + fr, fq * 8);
#define PG8_SA(b, h) (((b) * 2 + (h)) * HTB)
#define PG8_SB(b, h) ((4 + (b) * 2 + (h)) * HTB)
#define PG8_STAGE(bufoff, gbase, voff) do { _Pragma("unroll") for (int _i = 0; _i < 2; ++_i) \
        __builtin_amdgcn_global_load_lds((const unsigned*)((const char*)(gbase) + (voff)[_i]), (LAS unsigned*)(lds + (bufoff) + ldsw + _i * 8192), 16, 0, 0); } while (0)
#define PG8_LDA(dst, b, h) do { _Pragma("unroll") for (int m = 0; m < 4; ++m) _Pragma("unroll") for (int k = 0; k < 2; ++k) dst[m][k] = *(const LAS bf16x8*)(lds + PG8_SA(b, h) + aoff + m * 2048 + k * 1024); } while (0)
#define PG8_LDB(dst, b, h) do { _Pragma("unroll") for (int n = 0; n < 2; ++n) _Pragma("unroll") for (int k = 0; k < 2; ++k) dst[n][k] = *(const LAS bf16x8*)(lds + PG8_SB(b, h) + boff + n * 2048 + k * 1024); } while (0)
#define PG8_MMA(ai, bj, At, Bt) do { __builtin_amdgcn_s_setprio(1); _Pragma("unroll") for (int m = 0; m < 4; ++m) _Pragma("unroll") for (int n = 0; n < 2; ++n) _Pragma("unroll") for (int k = 0; k < 2; ++k) \
        acc[ai][bj][m][n] = __builtin_amdgcn_mfma_f32_16x16x32_bf16(Bt[n][k], At[m][k], acc[ai][bj][m][n], 0, 0, 0); __builtin_amdgcn_s_setprio(0); } while (0)
#define PG8_WAIT_V(n) asm volatile("s_waitcnt vmcnt(" #n ")" ::: "memory")
#define PG8_WAIT_L(n) asm volatile("s_waitcnt lgkmcnt(" #n ")" ::: "memory")
#define PG8_BAR __builtin_amdgcn_s_barrier()
#define PG8_SCHED __builtin_amdgcn_sched_barrier(0)
    Unit cur, nxt; int ui = 0;
    if (!S.next(0, cur)) return;
    f32x4 acc[2][2][4][2];
#pragma unroll
    for (int a = 0; a < 2; ++a)
#pragma unroll
        for (int b = 0; b < 2; ++b)
#pragma unroll
            for (int m = 0; m < 4; ++m)
#pragma unroll
                for (int n = 0; n < 2; ++n) acc[a][b][m][n] = (f32x4){0.f, 0.f, 0.f, 0.f};
    bf16x8 At[4][2], B0[2][2], B1[2][2];
    const char* cA = (const char*)g.A + (size_t)cur.pm * tstepA + (size_t)cur.pn * g.a_grp * 2; const char* cB = (const char*)g.Bt + (size_t)cur.pn * tstepB;
    S.a_ready(cur);
    if constexpr (SP2) {
        PG8_STAGE(PG8_SB(0, 0), cB, voffB); PG8_STAGE(PG8_SB(0, 1), cB + hstepB, voffB); PG8_STAGE(PG8_SA(0, 0), cA, voffA); PG8_STAGE(PG8_SA(0, 1), cA + hstepA, voffA);
        if (wr == 1) PG8_BAR;
        PG8_WAIT_V(2); PG8_BAR;
        PG8_STAGE(PG8_SB(1, 0), cB + kstep, voffB); PG8_STAGE(PG8_SA(1, 0), cA + kstep, voffA); PG8_STAGE(PG8_SB(1, 1), cB + hstepB + kstep, voffB);
        PG8_WAIT_V(6); PG8_BAR;
    } else {
        PG8_STAGE(PG8_SB(0, 0), cB, voffB); PG8_STAGE(PG8_SA(0, 0), cA, voffA); PG8_STAGE(PG8_SB(0, 1), cB + hstepB, voffB); PG8_STAGE(PG8_SA(0, 1), cA + hstepA, voffA);
        if (wr == 1) PG8_BAR;
        PG8_WAIT_V(4); PG8_BAR;
        PG8_STAGE(PG8_SB(1, 0), cB + kstep, voffB); PG8_STAGE(PG8_SA(1, 0), cA + kstep, voffA); PG8_STAGE(PG8_SB(1, 1), cB + hstepB + kstep, voffB);
        PG8_WAIT_V(6); PG8_BAR;
    }
    for (;;) {
        const bool has_next = S.next(ui + 1, nxt);
        const char* nA = has_next ? (const char*)g.A + (size_t)nxt.pm * tstepA + (size_t)nxt.pn * g.a_grp * 2 : cA; const char* nB = has_next ? (const char*)g.Bt + (size_t)nxt.pn * tstepB : cB;
        for (int t = 0; t < nt; t += 2) {
            const bool last = (t == nt - 2);
            const char* a1 = cA + (size_t)(t + 1) * kstep;
            const char* a2 = last ? nA : cA + (size_t)(t + 2) * kstep; const char* b2 = last ? nB : cB + (size_t)(t + 2) * kstep;
            const char* a3 = a2 + kstep; const char* b3 = b2 + kstep;
            if (last && has_next) S.a_ready(nxt);
            if constexpr (SP2) {
            PG8_LDB(B0, 0, 0); PG8_LDB(B1, 0, 1); PG8_SCHED; PG8_LDA(At, 0, 0); PG8_STAGE(PG8_SA(1, 1), a1 + hstepA, voffA);
            PG8_WAIT_V(8); PG8_WAIT_L(0); PG8_BAR; PG8_MMA(0, 0, At, B0); PG8_MMA(0, 1, At, B1); PG8_BAR; PG8_SCHED;
            PG8_LDA(At, 0, 1); PG8_STAGE(PG8_SB(0, 0), b2, voffB); PG8_STAGE(PG8_SB(0, 1), b2 + hstepB, voffB); PG8_STAGE(PG8_SA(0, 0), a2, voffA);
            PG8_WAIT_V(8); PG8_WAIT_L(0); PG8_BAR; PG8_MMA(1, 0, At, B0); PG8_MMA(1, 1, At, B1); PG8_BAR; PG8_SCHED;
            PG8_LDB(B0, 1, 0); PG8_LDB(B1, 1, 1); PG8_SCHED; PG8_LDA(At, 1, 0); PG8_STAGE(PG8_SA(0, 1), a2 + hstepA, voffA);
            PG8_WAIT_V(8); PG8_WAIT_L(0); PG8_BAR; PG8_MMA(0, 0, At, B0); PG8_MMA(0, 1, At, B1); PG8_BAR; PG8_SCHED;
            PG8_LDA(At, 1, 1); PG8_STAGE(PG8_SB(1, 0), b3, voffB); PG8_STAGE(PG8_SB(1, 1), b3 + hstepB, voffB); PG8_STAGE(PG8_SA(1, 0), a3, voffA);
            PG8_WAIT_V(8); PG8_WAIT_L(0); PG8_BAR; PG8_MMA(1, 0, At, B0); PG8_MMA(1, 1, At, B1); PG8_BAR; PG8_SCHED;
            } else {
            PG8_LDB(B0, 0, 0); PG8_SCHED; PG8_LDA(At, 0, 0); PG8_STAGE(PG8_SA(1, 1), a1 + hstepA, voffA);
            PG8_WAIT_L(8); PG8_BAR; PG8_WAIT_L(0); PG8_MMA(0, 0, At, B0); PG8_BAR; PG8_SCHED;
            PG8_LDB(B1, 0, 1); PG8_STAGE(PG8_SB(0, 0), b2, voffB);
            PG8_BAR; PG8_WAIT_L(0); PG8_MMA(0, 1, At, B1); PG8_BAR;
            PG8_LDA(At, 0, 1); PG8_STAGE(PG8_SA(0, 0), a2, voffA);
            PG8_BAR; PG8_WAIT_L(0); PG8_MMA(1, 0, At, B0); PG8_BAR; PG8_SCHED;
            PG8_STAGE(PG8_SB(0, 1), b2 + hstepB, voffB);
            PG8_WAIT_V(6); PG8_BAR; PG8_MMA(1, 1, At, B1); PG8_BAR;
            PG8_LDB(B0, 1, 0); PG8_SCHED; PG8_LDA(At, 1, 0); PG8_STAGE(PG8_SA(0, 1), a2 + hstepA, voffA);
            PG8_WAIT_L(8); PG8_BAR; PG8_WAIT_L(0); PG8_MMA(0, 0, At, B0); PG8_BAR; PG8_SCHED;
            PG8_LDB(B1, 1, 1); PG8_STAGE(PG8_SB(1, 0), b3, voffB);
            PG8_BAR; PG8_WAIT_L(0); PG8_MMA(0, 1, At, B1); PG8_BAR;
            PG8_LDA(At, 1, 1); PG8_STAGE(PG8_SA(1, 0), a3, voffA);
            PG8_BAR; PG8_WAIT_L(0); PG8_MMA(1, 0, At, B0); PG8_BAR; PG8_SCHED;
            PG8_STAGE(PG8_SB(1, 1), b3 + hstepB, voffB);
            PG8_WAIT_V(6); PG8_BAR; PG8_MMA(1, 1, At, B1); PG8_BAR;
            }
        }
        if constexpr (ALIGN_EPI) { if (wr == 0) PG8_BAR; }
        if constexpr (!Epi::AFTER_DRAIN) { E(acc, cur, wr, wc, fr, fq); S.done(cur); }
        if (!has_next) break;
#pragma unroll
        for (int a = 0; a < 2; ++a)
#pragma unroll
            for (int b = 0; b < 2; ++b)
#pragma unroll
                for (int m = 0; m < 4; ++m)
#pragma unroll
                    for (int n = 0; n < 2; ++n) acc[a][b][m][n] = (f32x4){0.f, 0.f, 0.f, 0.f};
        cur = nxt; cA = nA; cB = nB; ++ui;
        if constexpr (ALIGN_EPI) { if (wr == 1) PG8_BAR; }
    }
    PG8_WAIT_V(0);
    if constexpr (!ALIGN_EPI) { if (wr == 0) PG8_BAR; }
    PG8_BAR;
#undef PG8_SA
#undef PG8_SB
#undef PG8_STAGE
#undef PG8_LDA
#undef PG8_LDB
#undef PG8_MMA
#undef PG8_WAIT_V
#undef PG8_WAIT_L
#undef PG8_BAR
#undef PG8_SCHED
}
}

typedef unsigned short bf16;
typedef unsigned v4u __attribute__((ext_vector_type(4)));
typedef unsigned v2u __attribute__((ext_vector_type(2)));
typedef float f32x4 __attribute__((ext_vector_type(4)));
typedef float f32x2 __attribute__((ext_vector_type(2)));
typedef float f32x16 __attribute__((ext_vector_type(16)));
typedef short bf16x8 __attribute__((ext_vector_type(8)));
typedef short s16x4 __attribute__((ext_vector_type(4)));

constexpr int NWAVES = 8;
constexpr int D = 2048, MP = 8192, MS = 256, M = MP + MS, DFF = 5504, NFF = 2 * DFF, NMIX = 4096, NQKV = 2560, DCV = 1024;
constexpr int SEQ = 2048, NB = 4, DB = 32, DS = 8, NHEAD = 32, NKVH = 4, HD = 64, KVB = 128, PCTX = 15;
constexpr float EPS = 1e-6f;
constexpr float LOG2E = 1.4426950408889634f;

constexpr size_t O_Y = 0, O_CONVP = (size_t)M * D, O_POOLP = O_CONVP + 2 * NB * 2 * DCV, O_KP = O_POOLP + 2 * NB * PCTX * DCV, O_VP = O_KP + 2 * NB * KVB * 256,
                 O_CONVS = O_VP + 2 * NB * KVB * 256, O_POOLS = O_CONVS + 2 * DB * 2 * DCV, O_KS = O_POOLS + 2 * DB * PCTX * DCV, O_VS = O_KS + 2 * DB * KVB * 256, O_END = O_VS + 2 * DB * KVB * 256;
static_assert(O_END == 23273472, "output size");

constexpr size_t MiB = 1u << 20;
constexpr size_t WS_CTL = 0, CTL_ZERO_BYTES = 1 * MiB;
constexpr size_t WS_HB = 2 * MiB;
constexpr size_t WS_ACT = 36 * MiB;
constexpr size_t WS_Y = 126 * MiB;
constexpr size_t WS_Z = 192 * MiB;
constexpr size_t WS_CAT = 258 * MiB;
constexpr size_t WS_DP = 292 * MiB;
constexpr size_t WS_W = 320 * MiB;
constexpr size_t SZ_FFNIN = (size_t)NFF * D, SZ_FFNOUT = (size_t)D * DFF, SZ_MIXIN = (size_t)NMIX * D, SZ_MIXOUT = (size_t)D * D, SZ_QKV = (size_t)NQKV * D, SZ_WO = (size_t)D * D, SZ_POOLW = 4 * 256 * 256;
constexpr size_t WO_FFNIN = 0, WO_FFNOUT = WO_FFNIN + 8 * SZ_FFNIN, WO_MIXIN = WO_FFNOUT + 8 * SZ_FFNOUT, WO_MIXOUT = WO_MIXIN + 2 * SZ_MIXIN, WO_QKV = WO_MIXOUT + 2 * SZ_MIXOUT,
                 WO_WO = WO_QKV + 2 * SZ_QKV, WO_POOLW = WO_WO + 2 * SZ_WO, WO_END = WO_POOLW + 2 * SZ_POOLW;
constexpr size_t WS_END = WS_W + WO_END * 2;
static_assert(WS_HB + (size_t)M * D * 2 <= WS_ACT && WS_ACT + (size_t)M * DFF * 2 <= WS_Y && WS_Y + (size_t)M * D * 4 <= WS_Z && WS_Z + (size_t)M * NMIX * 2 <= WS_CAT && WS_CAT + (size_t)M * D * 2 <= WS_DP && WS_DP + (size_t)M * DCV * 2 <= WS_W, "ws map");
constexpr int CW_BAR = 4096;

constexpr int RING_BYTES = 135168;
constexpr int LDSCTL_OFF = RING_BYTES, MISC_OFF = LDSCTL_OFF + 320;
constexpr int LDS_BYTES = 147456;
static_assert(MISC_OFF + 128 <= LDS_BYTES, "LDS map");

#define LDS_WAIT() asm volatile("s_waitcnt lgkmcnt(0)" ::: "memory")
#define VM_WAIT() asm volatile("s_waitcnt vmcnt(0)" ::: "memory")
__device__ __forceinline__ unsigned f2bf(float f) { unsigned u = __builtin_bit_cast(unsigned, f); return (u + 0x7fffu + ((u >> 16) & 1u)) >> 16; }
__device__ __forceinline__ unsigned pk2(float lo, float hi) { return f2bf(lo) | (f2bf(hi) << 16); }
__device__ __forceinline__ float bf_lo(unsigned w) { return __builtin_bit_cast(float, w << 16); }
__device__ __forceinline__ float bf_hi(unsigned w) { return __builtin_bit_cast(float, w & 0xffff0000u); }

#define XB_TMO      128
#define XB_XCNT(j)  (256  + 64 * (j))
#define XB_XSUB(j)  (1280 + 64 * (j))
#define XB_XGEN(j)  (2304 + 64 * (j))
#define XB_TOP      3328
#define XB_TOPGEN   3392
#define XCD_BAR_WORDS 3456
#define XB_SPIN_CAP (1u << 18)
__device__ __forceinline__ unsigned xb_ld(unsigned* p)              { return __hip_atomic_load(p, __ATOMIC_RELAXED, __HIP_MEMORY_SCOPE_AGENT); }
__device__ __forceinline__ unsigned xb_add(unsigned* p, unsigned v) { return __hip_atomic_fetch_add(p, v, __ATOMIC_RELAXED, __HIP_MEMORY_SCOPE_AGENT); }
__device__ __forceinline__ unsigned xb_xcc_id() { return (unsigned)__builtin_amdgcn_s_getreg((3 << 11) | 20) & 0xFu; }
#define XB_SPIN(cond, bar) do { unsigned _sp = 0; while (cond) { __builtin_amdgcn_s_sleep(1); \
    if ((++_sp & 255u) == 0u) { if (xb_ld(&(bar)[XB_TMO])) break; if (_sp > XB_SPIN_CAP) { atomicAdd(&(bar)[XB_TMO], 1u); break; } } } } while (0)
struct XcdBarrier { unsigned* bar; unsigned x; volatile LAS unsigned* st; };
__device__ __forceinline__ XcdBarrier xcd_barrier_post(unsigned* bar, volatile LAS unsigned* st) {
    XcdBarrier b; b.bar = bar; b.x = xb_xcc_id(); b.st = st;
    if (threadIdx.x == 0) (void)xb_add(&bar[XB_XCNT(b.x)], 1u);
    return b;
}
__device__ __forceinline__ void xcd_barrier_complete(unsigned* bar, unsigned x, unsigned& nloc, unsigned& nx) {
    const unsigned G = gridDim.x * gridDim.y * gridDim.z;
    unsigned sum, cnt, mine, sp = 0u;
    for (;;) {
        sum = 0u; cnt = 0u; mine = 0u;
#pragma unroll
        for (unsigned j = 0; j < 16; ++j) { const unsigned c = xb_ld(&bar[XB_XCNT(j)]); sum += c; cnt += (c > 0u) ? 1u : 0u; mine = (j == x) ? c : mine; }
        if (sum == G) break;
        __builtin_amdgcn_s_sleep(1);
        if ((++sp & 255u) == 0u) { if (xb_ld(&bar[XB_TMO])) break; if (sp > XB_SPIN_CAP) { atomicAdd(&bar[XB_TMO], 1u); break; } }
    }
    nloc = mine > 0u ? mine : 1u; nx = cnt > 0u ? cnt : 1u;
}
__device__ __forceinline__ void xcd_barrier(const XcdBarrier& b) {
    asm volatile("s_waitcnt vmcnt(0)" ::: "memory");
    __syncthreads();
    if (threadIdx.x == 0) {
        unsigned* bar = b.bar; asm volatile("" : "+s"(bar));
        __builtin_amdgcn_s_waitcnt(0);
        unsigned nloc = b.st[0], nx = b.st[1];
        const unsigned bx = xb_xcc_id();
        if (nloc == 0u) { xcd_barrier_complete(bar, bx, nloc, nx); b.st[0] = nloc; b.st[1] = nx; }
        const unsigned old = xb_add(&bar[XB_XSUB(bx)], 1u);
        const unsigned gen = old / nloc;
        if (old + 1u == (gen + 1u) * nloc) {
            __builtin_amdgcn_fence(__ATOMIC_RELEASE, "agent");
            asm volatile("s_waitcnt vmcnt(0)" ::: "memory");
            const unsigned og = xb_add(&bar[XB_TOP], 1u);
            const unsigned tg = og / nx;
            if (og + 1u == (tg + 1u) * nx) xb_add(&bar[XB_TOPGEN], 1u);
            else XB_SPIN(xb_ld(&bar[XB_TOPGEN]) == tg, bar);
            __builtin_amdgcn_fence(__ATOMIC_ACQUIRE, "agent");
            xb_add(&bar[XB_XGEN(bx)], 1u);
            asm volatile("s_waitcnt vmcnt(0)" ::: "memory");
        } else {
            XB_SPIN(xb_ld(&bar[XB_XGEN(bx)]) == gen, bar);
            __builtin_amdgcn_fence(__ATOMIC_ACQUIRE, "agent");
            asm volatile("s_waitcnt vmcnt(0)" ::: "memory");
        }
    }
    __syncthreads();
}

__device__ __forceinline__ float wave_sum(float v) {
#pragma unroll
    for (int o = 1; o < 64; o <<= 1) v += __shfl_xor(v, o);
    return v;
}

__device__ __forceinline__ void tr_item(const float* __restrict__ src, int sld, bf16* __restrict__ dst, int K, int k0, LAS float* scr, int lane) {
    const GAS float* s = (const GAS float*)src + (size_t)(k0 + (lane >> 4)) * sld + (lane & 15) * 4;
    f32x4 v[16];
#pragma unroll
    for (int it = 0; it < 16; ++it) v[it] = *(const GAS f32x4*)(s + (size_t)(4 * it) * sld);
#pragma unroll
    for (int it = 0; it < 16; ++it) { LAS float* w = scr + ((lane >> 4) + 4 * it) * 65 + (lane & 15) * 4; w[0] = v[it].x; w[1] = v[it].y; w[2] = v[it].z; w[3] = v[it].w; }
    LDS_WAIT(); asm volatile("" ::: "memory");
    const int c = lane >> 3, n1 = lane & 7;
#pragma unroll
    for (int jj = 0; jj < 8; ++jj) { const int n = n1 + 8 * jj; const LAS float* r = scr + (8 * c) * 65 + n;
        v4u o; o.x = pk2(r[0], r[65]); o.y = pk2(r[2 * 65], r[3 * 65]); o.z = pk2(r[4 * 65], r[5 * 65]); o.w = pk2(r[6 * 65], r[7 * 65]);
        *(GAS v4u*)(dst + (size_t)n * K + k0 + 8 * c) = o; }
    LDS_WAIT(); asm volatile("" ::: "memory");
}

struct Args { const float* in[18]; float* out; unsigned char* ws; };
typedef const __attribute__((address_space(4))) Args CArgs;
__device__ __forceinline__ CArgs* fresh_args() { CArgs* p = (CArgs*)__builtin_amdgcn_kernarg_segment_ptr(); asm volatile("" : "+s"(p)); return p; }

constexpr int IT_FFNIN = 8 * (D / 64) * (NFF / 64), IT_FFNOUT = 8 * (DFF / 64) * (D / 64), IT_MIXIN = 2 * (D / 64) * (NMIX / 64), IT_MIXOUT = 2 * (D / 64) * (D / 64),
              IT_QKV = 2 * (D / 64) * (NQKV / 64), IT_WO = IT_MIXOUT, IT_POOLW = 8 * 4 * 4;
constexpr int IT_TOTAL = IT_FFNIN + IT_FFNOUT + IT_MIXIN + IT_MIXOUT + IT_QKV + IT_WO + IT_POOLW;

__device__ __forceinline__ void prologue(CArgs* ap, LAS unsigned char* lds, int gw, int NGW, int wave, int lane) {
    struct { const float* in[18]; float* out; unsigned char* ws; } a;
    a.in[0] = ap->in[0]; a.in[1] = ap->in[1]; a.in[6] = ap->in[6]; a.in[7] = ap->in[7]; a.in[8] = ap->in[8]; a.in[9] = ap->in[9]; a.in[11] = ap->in[11]; a.in[13] = ap->in[13]; a.in[14] = ap->in[14]; a.in[15] = ap->in[15]; a.out = ap->out; a.ws = ap->ws;
    LAS float* scr = (LAS float*)(lds + wave * 16640);
    bf16* W = (bf16*)(a.ws + WS_W);
    for (int it = gw; it < IT_TOTAL; it += NGW) {
        int r = it;
        if (r < IT_FFNIN) { constexpr int per = (D / 64) * (NFF / 64), nbn = NFF / 64; const int mat = r / per, rr = r % per, kb = rr / nbn, nb = rr % nbn;
            const int n0 = nb * 64, tile = n0 >> 8, w = n0 & 255, scol = (w < 128) ? tile * 128 + w : DFF + tile * 128 + (w - 128);
            tr_item(a.in[7] + (size_t)mat * D * NFF + scol, NFF, W + WO_FFNIN + (size_t)mat * SZ_FFNIN + (size_t)n0 * D, D, kb * 64, scr, lane); continue; }
        r -= IT_FFNIN;
        if (r < IT_FFNOUT) { constexpr int per = (DFF / 64) * (D / 64), nbn = D / 64; const int mat = r / per, rr = r % per, kb = rr / nbn, nb = rr % nbn;
            tr_item(a.in[8] + (size_t)mat * DFF * D + nb * 64, D, W + WO_FFNOUT + (size_t)mat * SZ_FFNOUT + (size_t)(nb * 64) * DFF, DFF, kb * 64, scr, lane); continue; }
        r -= IT_FFNOUT;
        if (r < IT_MIXIN) { constexpr int per = (D / 64) * (NMIX / 64), nbn = NMIX / 64; const int mat = r / per, rr = r % per, kb = rr / nbn, nb = rr % nbn;
            tr_item(a.in[9] + (size_t)mat * D * NMIX + nb * 64, NMIX, W + WO_MIXIN + (size_t)mat * SZ_MIXIN + (size_t)(nb * 64) * D, D, kb * 64, scr, lane); continue; }
        r -= IT_MIXIN;
        if (r < IT_MIXOUT) { constexpr int per = (D / 64) * (D / 64), nbn = D / 64; const int mat = r / per, rr = r % per, kb = rr / nbn, nb = rr % nbn;
            tr_item(a.in[13] + (size_t)mat * D * D + nb * 64, D, W + WO_MIXOUT + (size_t)mat * SZ_MIXOUT + (size_t)(nb * 64) * D, D, kb * 64, scr, lane); continue; }
        r -= IT_MIXOUT;
        if (r < IT_QKV) { constexpr int per = (D / 64) * (NQKV / 64), nbn = NQKV / 64; const int mat = r / per, rr = r % per, kb = rr / nbn, nb = rr % nbn;
            tr_item(a.in[14] + (size_t)mat * D * NQKV + nb * 64, NQKV, W + WO_QKV + (size_t)mat * SZ_QKV + (size_t)(nb * 64) * D, D, kb * 64, scr, lane); continue; }
        r -= IT_QKV;
        if (r < IT_WO) { constexpr int per = (D / 64) * (D / 64), nbn = D / 64; const int mat = r / per, rr = r % per, kb = rr / nbn, nb = rr % nbn;
            tr_item(a.in[15] + (size_t)mat * D * D + nb * 64, D, W + WO_WO + (size_t)mat * SZ_WO + (size_t)(nb * 64) * D, D, kb * 64, scr, lane); continue; }
        r -= IT_WO;
        { const int mat = r >> 4, rr = r & 15, kb = rr >> 2, nb = rr & 3;
            tr_item(a.in[11] + (size_t)mat * 65536 + nb * 64, 256, W + WO_POOLW + (size_t)mat * 65536 + (size_t)(nb * 64) * 256, 256, kb * 64, scr, lane); }
    }
    const GAS f32x4* g4 = (const GAS f32x4*)a.in[6];
    for (int row = gw; row < M; row += NGW) {
        const float* xr = row < MP ? a.in[0] + (size_t)row * D : a.in[1] + (size_t)(row - MP) * D;
        const GAS f32x4* x4 = (const GAS f32x4*)xr + lane;
        f32x4 v[8]; float ss = 0.f;
#pragma unroll
        for (int j = 0; j < 8; ++j) { v[j] = x4[64 * j]; ss += (v[j].x * v[j].x + v[j].y * v[j].y) + (v[j].z * v[j].z + v[j].w * v[j].w); }
        const float rs = 1.0f / sqrtf(wave_sum(ss) * (1.f / D) + EPS);
        GAS f32x4* xo = (GAS f32x4*)(a.out + (size_t)row * D) + lane;
        GAS v2u* ho = (GAS v2u*)((bf16*)(a.ws + WS_HB) + (size_t)row * D) + lane;
#pragma unroll
        for (int j = 0; j < 8; ++j) { xo[64 * j] = v[j]; const f32x4 g = g4[lane + 64 * j];
            v2u o; o.x = pk2(v[j].x * rs * g.x, v[j].y * rs * g.y); o.y = pk2(v[j].z * rs * g.z, v[j].w * rs * g.w); ho[64 * j] = o; }
    }
}

__device__ __forceinline__ void norm_phase(const float* Y, float* X, bf16* HB, float sc, const float* ga, const float* gb, int gw, int NGW, int lane) {
    const GAS f32x4* ga4 = (const GAS f32x4*)ga; const GAS f32x4* gb4 = (const GAS f32x4*)gb;
    for (int row = gw; row < M; row += NGW) {
        const GAS f32x4* y4 = (const GAS f32x4*)(Y + (size_t)row * D) + lane;
        GAS f32x4* x4 = (GAS f32x4*)(X + (size_t)row * D) + lane;
        f32x4 y[8], x[8]; float ss = 0.f;
#pragma unroll
        for (int j = 0; j < 8; ++j) { y[j] = y4[64 * j]; x[j] = x4[64 * j]; }
#pragma unroll
        for (int j = 0; j < 8; ++j) ss += (y[j].x * y[j].x + y[j].y * y[j].y) + (y[j].z * y[j].z + y[j].w * y[j].w);
        const float r1 = sc / sqrtf(wave_sum(ss) * (1.f / D) + EPS);
        float s2 = 0.f;
#pragma unroll
        for (int j = 0; j < 8; ++j) { const f32x4 g = ga4[lane + 64 * j]; x[j] = x[j] + y[j] * g * r1; x4[64 * j] = x[j];
            s2 += (x[j].x * x[j].x + x[j].y * x[j].y) + (x[j].z * x[j].z + x[j].w * x[j].w); }
        if (gb) {
            const float r2 = 1.0f / sqrtf(wave_sum(s2) * (1.f / D) + EPS);
            GAS v2u* ho = (GAS v2u*)(HB + (size_t)row * D) + lane;
#pragma unroll
            for (int j = 0; j < 8; ++j) { const f32x4 g = gb4[lane + 64 * j];
                v2u o; o.x = pk2(x[j].x * r2 * g.x, x[j].y * r2 * g.y); o.y = pk2(x[j].z * r2 * g.z, x[j].w * r2 * g.w); ho[64 * j] = o; }
        }
    }
}

__device__ __forceinline__ unsigned ldz(const bf16* Zb, unsigned off) { return *(const GAS unsigned*)((const GAS char*)Zb + off); }
__device__ __forceinline__ void convpool_phase(CArgs* ap, int j, int bid, int G, int tid) {
    const bf16* Z = (const bf16*)(ap->ws + WS_Z); bf16* CAT = (bf16*)(ap->ws + WS_CAT); bf16* DP = (bf16*)(ap->ws + WS_DP);
    const int c = 2 * tid, gi = tid >> 7, w = 2 << gi;
    const float* cw = ap->in[10] + (size_t)j * 3 * DCV + c;
    const f32x2 w0 = *(const f32x2*)cw, w1 = *(const f32x2*)(cw + DCV), w2 = *(const f32x2*)(cw + 2 * DCV);
    float* out = ap->out;
    for (int u = bid; u < 256 + DB; u += G) {
        if (u < 256) {
            const int b = u >> 6, t0 = (u & 63) * 32; const int rb = b * SEQ;
            const bf16* Zb = Z + (size_t)rb * NMIX; bf16* Cb = CAT + (size_t)rb * D; bf16* Db = DP + (size_t)rb * DCV;
            f32x2 vm2 = {0.f, 0.f}, vm1 = {0.f, 0.f}, S = {0.f, 0.f};
            if (t0 > 0) {
                { const unsigned o = (unsigned)((t0 - 2) * NMIX + c) * 2u; const unsigned h = ldz(Zb, o), g = ldz(Zb, o + 2048u); vm2 = (f32x2){bf_lo(h) * bf_lo(g), bf_hi(h) * bf_hi(g)}; }
                { const unsigned o = (unsigned)((t0 - 1) * NMIX + c) * 2u; const unsigned h = ldz(Zb, o), g = ldz(Zb, o + 2048u); vm1 = (f32x2){bf_lo(h) * bf_lo(g), bf_hi(h) * bf_hi(g)}; }
                for (int i = 1; i <= w; ++i) { const unsigned uu = ldz(Zb, (unsigned)((t0 - i) * NMIX + 3072 + c) * 2u); S.x += bf_lo(uu); S.y += bf_hi(uu); }
            }
            const bool lastc = (t0 == SEQ - 32);
#pragma unroll 2
            for (int t = t0; t < t0 + 32; ++t) {
                const unsigned o = (unsigned)(t * NMIX + c) * 2u;
                const unsigned hh = ldz(Zb, o), gg = ldz(Zb, o + 2048u), bb = ldz(Zb, o + 4096u), uu = ldz(Zb, o + 6144u);
                unsigned uo = 0u; if (t >= w) uo = ldz(Zb, (unsigned)((t - w) * NMIX + 3072 + c) * 2u);
                const f32x2 v = {bf_lo(hh) * bf_lo(gg), bf_hi(hh) * bf_hi(gg)};
                const f32x2 yc = w0 * vm2 + w1 * vm1 + w2 * v; vm2 = vm1; vm1 = v;
                const f32x2 ut = {bf_lo(uu), bf_hi(uu)};
                S.x += ut.x - bf_lo(uo); S.y += ut.y - bf_hi(uo);
                const float cnt = (float)((t + 1 < w) ? (t + 1) : w);
                const f32x2 dd = S / cnt - ut;
                *(GAS unsigned*)((GAS char*)Cb + (unsigned)(t * D + c) * 2u) = pk2(bf_lo(bb) * yc.x, bf_hi(bb) * yc.y);
                *(GAS unsigned*)((GAS char*)Db + (unsigned)(t * DCV + c) * 2u) = pk2(dd.x, dd.y);
                if (lastc) {
                    if (t >= SEQ - 2) *(GAS f32x2*)((GAS char*)(out + O_CONVP + (size_t)(j * NB + b) * 2 * DCV) + (unsigned)((t - (SEQ - 2)) * DCV + c) * 4u) = v;
                    if (t >= SEQ - PCTX) *(GAS f32x2*)((GAS char*)(out + O_POOLP + (size_t)(j * NB + b) * PCTX * DCV) + (unsigned)((t - (SEQ - PCTX)) * DCV + c) * 4u) = ut;
                }
            }
        } else {
            const int b = u - 256; const int rb = MP + b * DS;
            const bf16* Zb = Z + (size_t)rb * NMIX; bf16* Cb = CAT + (size_t)rb * D; bf16* Db = DP + (size_t)rb * DCV;
            const GAS char* cc = (const GAS char*)(ap->in[2] + (size_t)(j * DB + b) * 2 * DCV);
            const GAS char* pc = (const GAS char*)(ap->in[3] + (size_t)(j * DB + b) * PCTX * DCV);
            GAS char* pso = (GAS char*)(out + O_POOLS + (size_t)(j * DB + b) * PCTX * DCV);
            GAS char* cso = (GAS char*)(out + O_CONVS + (size_t)(j * DB + b) * 2 * DCV);
            const unsigned c4 = (unsigned)c * 4u;
            f32x2 vm2 = *(const GAS f32x2*)(cc + c4), vm1 = *(const GAS f32x2*)(cc + c4 + DCV * 4u), S = {0.f, 0.f};
            for (int i = 1; i <= w && i <= PCTX; ++i) { const f32x2 p = *(const GAS f32x2*)(pc + c4 + (unsigned)(PCTX - i) * (DCV * 4u)); S += p; }
            for (int i = 0; i < PCTX - DS; ++i) *(GAS f32x2*)(pso + c4 + (unsigned)i * (DCV * 4u)) = *(const GAS f32x2*)(pc + c4 + (unsigned)(DS + i) * (DCV * 4u));
            for (int t = 0; t < DS; ++t) {
                const unsigned o = (unsigned)(t * NMIX + c) * 2u;
                const unsigned hh = ldz(Zb, o), gg = ldz(Zb, o + 2048u), bb = ldz(Zb, o + 4096u), uu = ldz(Zb, o + 6144u);
                f32x2 uo = {0.f, 0.f};
                if (t - w >= 0) { const unsigned uw = ldz(Zb, (unsigned)((t - w) * NMIX + 3072 + c) * 2u); uo = (f32x2){bf_lo(uw), bf_hi(uw)}; }
                else if (t - w >= -PCTX) uo = *(const GAS f32x2*)(pc + c4 + (unsigned)(PCTX + t - w) * (DCV * 4u));
                const f32x2 v = {bf_lo(hh) * bf_lo(gg), bf_hi(hh) * bf_hi(gg)};
                const f32x2 yc = w0 * vm2 + w1 * vm1 + w2 * v; vm2 = vm1; vm1 = v;
                const f32x2 ut = {bf_lo(uu), bf_hi(uu)};
                S += ut - uo;
                const f32x2 dd = S / (float)w - ut;
                *(GAS unsigned*)((GAS char*)Cb + (unsigned)(t * D + c) * 2u) = pk2(bf_lo(bb) * yc.x, bf_hi(bb) * yc.y);
                *(GAS unsigned*)((GAS char*)Db + (unsigned)(t * DCV + c) * 2u) = pk2(dd.x, dd.y);
                if (t >= DS - 2) *(GAS f32x2*)(cso + c4 + (unsigned)(t - (DS - 2)) * (DCV * 4u)) = v;
                *(GAS f32x2*)(pso + c4 + (unsigned)(PCTX - DS + t) * (DCV * 4u)) = ut;
            }
        }
    }
}

constexpr int AT_KP = 144, AT_VP = 520;
constexpr int AT_K = 0, AT_V = 256 * AT_KP, AT_B = AT_V + 64 * AT_VP, AT_END = AT_B + NHEAD * 192 * 4;
static_assert(AT_END <= RING_BYTES && (AT_V % 16) == 0 && (AT_B % 16) == 0, "attention LDS map");
__device__ __forceinline__ int crow(int r, int hi) { return (r & 3) + 8 * (r >> 2) + 4 * hi; }

__device__ __forceinline__ void attention_phase(CArgs* ap, LAS unsigned char* lds, int j, int bid, int G, int tid, int wave, int lane_in) {
    const bf16* QKV = (const bf16*)(ap->ws + WS_Z); bf16* ATT = (bf16*)(ap->ws + WS_CAT);
    float* out = ap->out; const float* relb = ap->in[17]; const float* ck = ap->in[4]; const float* cv = ap->in[5]; const float* sinks = ap->in[16];
    LAS float* biasL = (LAS float*)(lds + AT_B);
    for (int e = tid; e < NHEAD * 192; e += NWAVES * 64) {
        const int h = e / 192, dist = e % 192 - 32; float v = -1e30f;
        if (dist >= 0 && dist <= 128) { int bk = dist;
            if (dist >= 16) { const float ratio = logf((float)dist / 16.0f) / 2.0794415416798357f; bk = 16 + (int)(ratio * 16.0f); if (bk > 31) bk = 31; }
            v = relb[bk * NHEAD + h] * LOG2E; }
        biasL[e] = v;
    }
    const float CS = 0.125f * LOG2E;
    for (int u = bid; u < 256 + DB * NKVH; u += G) {
        __syncthreads();
        asm volatile("" : "+v"(tid));
        const bool prompt = u < 256;
        int b, kvh, row0; bool first = false, lastb = false;
        if (prompt) { b = u >> 6; kvh = (u >> 4) & 3; const int qb = u & 15; row0 = b * SEQ + qb * 128; first = (qb == 0); lastb = (qb == 15); }
        else { const int su = u - 256; b = su >> 2; kvh = su & 3; row0 = MP + b * DS; }
        if (prompt) {
#pragma unroll
            for (int it = 0; it < 4; ++it) { const int id = it * 512 + tid, row = id >> 3, ch = id & 7;
                v4u kv = {0u, 0u, 0u, 0u}, vv = {0u, 0u, 0u, 0u};
                if (!(first && row < 128)) { const bf16* src = QKV + (size_t)(row0 - 128 + row) * NQKV + 2048 + kvh * 64 + ch * 8; kv = *(const GAS v4u*)src; vv = *(const GAS v4u*)(src + 256); }
                *(LAS v4u*)(lds + AT_K + row * AT_KP + ch * 16) = kv;
                LAS bf16* vt = (LAS bf16*)(lds + AT_V + (ch * 8) * AT_VP) + row;
                vt[0] = (bf16)(vv.x & 0xffff); vt[AT_VP / 2] = (bf16)(vv.x >> 16); vt[2 * (AT_VP / 2)] = (bf16)(vv.y & 0xffff); vt[3 * (AT_VP / 2)] = (bf16)(vv.y >> 16);
                vt[4 * (AT_VP / 2)] = (bf16)(vv.z & 0xffff); vt[5 * (AT_VP / 2)] = (bf16)(vv.z >> 16); vt[6 * (AT_VP / 2)] = (bf16)(vv.w & 0xffff); vt[7 * (AT_VP / 2)] = (bf16)(vv.w >> 16);
                if (lastb && row >= 128) { const size_t o = ((size_t)(j * NB + b) * KVB + (row - 128)) * 256 + kvh * 64 + ch * 8;
                    *(f32x4*)(out + O_KP + o) = (f32x4){bf_lo(kv.x), bf_hi(kv.x), bf_lo(kv.y), bf_hi(kv.y)}; *(f32x4*)(out + O_KP + o + 4) = (f32x4){bf_lo(kv.z), bf_hi(kv.z), bf_lo(kv.w), bf_hi(kv.w)};
                    *(f32x4*)(out + O_VP + o) = (f32x4){bf_lo(vv.x), bf_hi(vv.x), bf_lo(vv.y), bf_hi(vv.y)}; *(f32x4*)(out + O_VP + o + 4) = (f32x4){bf_lo(vv.z), bf_hi(vv.z), bf_lo(vv.w), bf_hi(vv.w)}; }
            }
        } else {
#pragma unroll
            for (int it = 0; it < 3; ++it) { const int id = it * 512 + tid, row = id >> 3, ch = id & 7;
                if (row < 160) {
                    v4u kv = {0u, 0u, 0u, 0u}, vv = {0u, 0u, 0u, 0u};
                    f32x4 k0 = {0.f, 0.f, 0.f, 0.f}, k1 = k0, v0 = k0, v1 = k0;
                    if (row < 128) { const size_t so = ((size_t)(j * DB + b) * KVB + row) * 256 + kvh * 64 + ch * 8;
                        k0 = *(const f32x4*)(ck + so); k1 = *(const f32x4*)(ck + so + 4); v0 = *(const f32x4*)(cv + so); v1 = *(const f32x4*)(cv + so + 4);
                        kv = (v4u){pk2(k0.x, k0.y), pk2(k0.z, k0.w), pk2(k1.x, k1.y), pk2(k1.z, k1.w)}; vv = (v4u){pk2(v0.x, v0.y), pk2(v0.z, v0.w), pk2(v1.x, v1.y), pk2(v1.z, v1.w)}; }
                    else if (row < 128 + DS) { const bf16* src = QKV + (size_t)(row0 + row - 128) * NQKV + 2048 + kvh * 64 + ch * 8; kv = *(const GAS v4u*)src; vv = *(const GAS v4u*)(src + 256);
                        k0 = (f32x4){bf_lo(kv.x), bf_hi(kv.x), bf_lo(kv.y), bf_hi(kv.y)}; k1 = (f32x4){bf_lo(kv.z), bf_hi(kv.z), bf_lo(kv.w), bf_hi(kv.w)};
                        v0 = (f32x4){bf_lo(vv.x), bf_hi(vv.x), bf_lo(vv.y), bf_hi(vv.y)}; v1 = (f32x4){bf_lo(vv.z), bf_hi(vv.z), bf_lo(vv.w), bf_hi(vv.w)}; }
                    *(LAS v4u*)(lds + AT_K + row * AT_KP + ch * 16) = kv;
                    LAS bf16* vt = (LAS bf16*)(lds + AT_V + (ch * 8) * AT_VP) + row;
                    vt[0] = (bf16)(vv.x & 0xffff); vt[AT_VP / 2] = (bf16)(vv.x >> 16); vt[2 * (AT_VP / 2)] = (bf16)(vv.y & 0xffff); vt[3 * (AT_VP / 2)] = (bf16)(vv.y >> 16);
                    vt[4 * (AT_VP / 2)] = (bf16)(vv.z & 0xffff); vt[5 * (AT_VP / 2)] = (bf16)(vv.z >> 16); vt[6 * (AT_VP / 2)] = (bf16)(vv.w & 0xffff); vt[7 * (AT_VP / 2)] = (bf16)(vv.w >> 16);
                    if (row >= DS && row < 128 + DS) { const size_t o = ((size_t)(j * DB + b) * KVB + (row - DS)) * 256 + kvh * 64 + ch * 8;
                        *(f32x4*)(out + O_KS + o) = k0; *(f32x4*)(out + O_KS + o + 4) = k1; *(f32x4*)(out + O_VS + o) = v0; *(f32x4*)(out + O_VS + o + 4) = v1; }
                }
            }
        }
        LDS_WAIT();
        __syncthreads();
        const int lane = tid & 63, l31 = lane & 31, hi = lane >> 5;
        const int h = kvh * 8 + wave;
        const float sink2 = sinks[j * NHEAD + h] * LOG2E;
        const LAS float* bl = biasL + h * 192 + 160 + l31 - 4 * hi;
        const int nsub = prompt ? 4 : 1;
        for (int sub = 0; sub < nsub; ++sub) {
            const int qrow = prompt ? (row0 + 32 * sub + l31) : (row0 + (l31 & 7));
            bf16x8 qr[4];
#pragma unroll
            for (int k0 = 0; k0 < 4; ++k0) qr[k0] = *(const GAS bf16x8*)(QKV + (size_t)qrow * NQKV + h * 64 + 16 * k0 + 8 * hi);
            f32x16 acc[5];
#pragma unroll
            for (int jt = 0; jt < 5; ++jt) {
                const int T = sub + jt;
                f32x16 c = {0.f, 0.f, 0.f, 0.f, 0.f, 0.f, 0.f, 0.f, 0.f, 0.f, 0.f, 0.f, 0.f, 0.f, 0.f, 0.f};
#pragma unroll
                for (int k0 = 0; k0 < 4; ++k0) { const bf16x8 kf = *(const LAS bf16x8*)(lds + AT_K + (32 * T + l31) * AT_KP + (16 * k0 + 8 * hi) * 2);
                    c = __builtin_amdgcn_mfma_f32_32x32x16_bf16(kf, qr[k0], c, 0, 0, 0); }
                acc[jt] = c;
            }
            float mx = -1e30f;
#pragma unroll
            for (int jt = 0; jt < 5; ++jt) {
                const float tm = (first && (sub + jt) < 4) ? -1e30f : 0.f;
#pragma unroll
                for (int r = 0; r < 16; ++r) { const float s = acc[jt][r] * CS + (bl[-32 * jt - ((r & 3) + 8 * (r >> 2))] + tm); acc[jt][r] = s; mx = fmaxf(mx, s); }
            }
            mx = fmaxf(mx, __shfl_xor(mx, 32));
            mx = fmaxf(mx, sink2);
            float ls = 0.f;
#pragma unroll
            for (int jt = 0; jt < 5; ++jt)
#pragma unroll
                for (int r = 0; r < 16; ++r) { const float p = __builtin_amdgcn_exp2f(acc[jt][r] - mx); acc[jt][r] = p; ls += p; }
            ls += __shfl_xor(ls, 32);
            ls += __builtin_amdgcn_exp2f(sink2 - mx);
            f32x16 o0 = {0.f, 0.f, 0.f, 0.f, 0.f, 0.f, 0.f, 0.f, 0.f, 0.f, 0.f, 0.f, 0.f, 0.f, 0.f, 0.f}, o1 = o0;
#pragma unroll
            for (int jt = 0; jt < 5; ++jt) {
                const int T = sub + jt;
#pragma unroll
                for (int c2 = 0; c2 < 2; ++c2) {
                    v4u pw; pw.x = pk2(acc[jt][8 * c2 + 0], acc[jt][8 * c2 + 1]); pw.y = pk2(acc[jt][8 * c2 + 2], acc[jt][8 * c2 + 3]); pw.z = pk2(acc[jt][8 * c2 + 4], acc[jt][8 * c2 + 5]); pw.w = pk2(acc[jt][8 * c2 + 6], acc[jt][8 * c2 + 7]);
                    const bf16x8 pf = __builtin_bit_cast(bf16x8, pw);
                    const LAS unsigned char* vb = lds + AT_V + l31 * AT_VP + (32 * T + 16 * c2 + 4 * hi) * 2;
                    { const s16x4 lo = *(const LAS s16x4*)vb, hh = *(const LAS s16x4*)(vb + 16); const bf16x8 vf = {lo[0], lo[1], lo[2], lo[3], hh[0], hh[1], hh[2], hh[3]};
                      o0 = __builtin_amdgcn_mfma_f32_32x32x16_bf16(vf, pf, o0, 0, 0, 0); }
                    { const s16x4 lo = *(const LAS s16x4*)(vb + 32 * AT_VP), hh = *(const LAS s16x4*)(vb + 32 * AT_VP + 16); const bf16x8 vf = {lo[0], lo[1], lo[2], lo[3], hh[0], hh[1], hh[2], hh[3]};
                      o1 = __builtin_amdgcn_mfma_f32_32x32x16_bf16(vf, pf, o1, 0, 0, 0); }
                }
            }
            const float inv = 1.0f / ls;
            if (prompt || l31 < DS) {
                bf16* orow = ATT + (size_t)(prompt ? qrow : (row0 + l31)) * D + h * 64 + 4 * hi;
#pragma unroll
                for (int rq = 0; rq < 4; ++rq) {
                    v2u w0; w0.x = pk2(o0[4 * rq] * inv, o0[4 * rq + 1] * inv); w0.y = pk2(o0[4 * rq + 2] * inv, o0[4 * rq + 3] * inv); *(GAS v2u*)(orow + 8 * rq) = w0;
                    v2u w1; w1.x = pk2(o1[4 * rq] * inv, o1[4 * rq + 1] * inv); w1.y = pk2(o1[4 * rq + 2] * inv, o1[4 * rq + 3] * inv); *(GAS v2u*)(orow + 32 + 8 * rq) = w1;
                }
            }
        }
    }
    __syncthreads();
}

__global__ void __launch_bounds__(NWAVES * 64, 2) mega_fwd(Args args) {
    extern __shared__ __attribute__((aligned(16))) unsigned char lds_raw[];
    LAS unsigned char* lds = (LAS unsigned char*)lds_raw;
    const int tid = threadIdx.x, lane = tid & 63, wave = __builtin_amdgcn_readfirstlane(tid >> 6);
    const int G = gridDim.x, bid = blockIdx.x;
    const int vcu = (G % 8 == 0) ? (bid % 8) * (G / 8) + bid / 8 : bid;
    const int gw = vcu * NWAVES + wave, NGW = G * NWAVES;
    CArgs* ap0 = fresh_args();
    for (int u = tid; u < (LDS_BYTES - LDSCTL_OFF) / 4; u += NWAVES * 64) ((LAS unsigned*)(lds + LDSCTL_OFF))[u] = 0u;
    __syncthreads();
    XcdBarrier bar = xcd_barrier_post((unsigned*)(ap0->ws + WS_CTL) + CW_BAR, (volatile LAS unsigned*)(lds + MISC_OFF) + 8);
#define GRID_BAR() xcd_barrier(bar)
#define FRESH_TID() int tid_ = threadIdx.x; asm volatile("" : "+v"(tid_)); const int lane_ = tid_ & 63, wave_ = __builtin_amdgcn_readfirstlane(tid_ >> 6), gw_ = vcu * NWAVES + wave_; (void)lane_; (void)gw_

    prologue(ap0, lds, gw, NGW, wave, lane);
    GRID_BAR();

    for (int hl = 0; hl < 8; ++hl) {
        const int l = hl >> 1, f = hl & 1, j = l >> 1;
        const bool odd = (l & 1) != 0;
        {
            CArgs* ap = fresh_args(); unsigned char* ws = ap->ws;
            pg8::Gemm g{(const bf16*)(ws + WS_HB), (const bf16*)(ws + WS_W) + WO_FFNIN + (size_t)hl * SZ_FFNIN, M, NFF, D, D, D, 0}; pg8::StaticOrder S; S.init(M, NFF, G, bid);
            pg8::EpiSwiGLU E{(bf16*)(ws + WS_ACT), DFF};
            pg8::gemm_phase<pg8::EpiSwiGLU, pg8::StaticOrder, true, true>(lds, g, S, E);
        }
        GRID_BAR();
        {
            CArgs* ap = fresh_args(); unsigned char* ws = ap->ws;
            pg8::Gemm g{(const bf16*)(ws + WS_ACT), (const bf16*)(ws + WS_W) + WO_FFNOUT + (size_t)hl * SZ_FFNOUT, M, D, DFF, DFF, DFF, 0}; pg8::StaticOrder S; S.init(M, D, G, bid);
            pg8::EpiF32 E{(float*)(ws + WS_Y), D};
            pg8::gemm_phase<pg8::EpiF32, pg8::StaticOrder, true, true>(lds, g, S, E);
        }
        GRID_BAR();
        {
            CArgs* ap = fresh_args(); unsigned char* ws = ap->ws; const float* NG = ap->in[6];
            const float* ga = NG + (size_t)(l * 6 + (f ? 5 : 1)) * D;
            const float* gb = f == 0 ? NG + (size_t)(l * 6 + 2) * D : (l < 3 ? NG + (size_t)((l + 1) * 6) * D : nullptr);
            FRESH_TID();
            norm_phase((const float*)(ws + WS_Y), ap->out, (bf16*)(ws + WS_HB), 0.5f, ga, gb, gw_, NGW, lane_);
        }
        GRID_BAR();
        if (f == 0) {
            {
                CArgs* ap = fresh_args(); unsigned char* ws = ap->ws;
                const int N = odd ? NQKV : NMIX; const bf16* W = (const bf16*)(ws + WS_W);
                pg8::Gemm g{(const bf16*)(ws + WS_HB), odd ? W + WO_QKV + (size_t)j * SZ_QKV : W + WO_MIXIN + (size_t)j * SZ_MIXIN, M, N, D, D, D, 0}; pg8::StaticOrder S; S.init(M, N, G, bid);
                pg8::EpiBf16S E{(bf16*)(ws + WS_Z), N, nullptr, 0};
                pg8::gemm_phase<pg8::EpiBf16S, pg8::StaticOrder, true, true>(lds, g, S, E);
            }
            GRID_BAR();
            if (odd) {
                FRESH_TID();
                attention_phase(fresh_args(), lds, j, bid, G, tid_, wave_, lane_);
                GRID_BAR();
            } else {
                { FRESH_TID();
                  convpool_phase(fresh_args(), j, bid, G, tid_); }
                GRID_BAR();
                {
                    CArgs* ap = fresh_args(); unsigned char* ws = ap->ws;
                    pg8::Gemm g{(const bf16*)(ws + WS_DP), (const bf16*)(ws + WS_W) + WO_POOLW + (size_t)j * SZ_POOLW, M, DCV, 256, DCV, 256, 256}; pg8::StaticOrder S; S.init(M, DCV, G, bid);
                    pg8::EpiBf16S E{(bf16*)(ws + WS_CAT), D, ap->in[12] + (size_t)j * DCV, DCV};
                    pg8::gemm_phase<pg8::EpiBf16S, pg8::StaticOrder, true, true>(lds, g, S, E);
                }
                GRID_BAR();
            }
            {
                CArgs* ap = fresh_args(); unsigned char* ws = ap->ws; const bf16* W = (const bf16*)(ws + WS_W);
                pg8::Gemm g{(const bf16*)(ws + WS_CAT), odd ? W + WO_WO + (size_t)j * SZ_WO : W + WO_MIXOUT + (size_t)j * SZ_MIXOUT, M, D, D, D, D, 0}; pg8::StaticOrder S; S.init(M, D, G, bid);
                pg8::EpiF32 E{(float*)(ws + WS_Y), D};
                pg8::gemm_phase<pg8::EpiF32, pg8::StaticOrder, true, true>(lds, g, S, E);
            }
            GRID_BAR();
            {   CArgs* ap = fresh_args(); unsigned char* ws = ap->ws; const float* NG = ap->in[6];
                FRESH_TID();
                norm_phase((const float*)(ws + WS_Y), ap->out, (bf16*)(ws + WS_HB), 1.0f, NG + (size_t)(l * 6 + 3) * D, NG + (size_t)(l * 6 + 4) * D, gw_, NGW, lane_); }
            GRID_BAR();
        }
    }
}

extern "C" void kernel_launch(void* const* d_in, const int* in_sizes, int n_in, void* d_out, int out_size, void* d_ws, size_t ws_size, hipStream_t stream) {
    static int grid = 0;
    if (grid == 0) {
        if (n_in != 18 || out_size != (int)O_END || ws_size < WS_END) { fprintf(stderr, "kernel_launch: unexpected shapes (n_in %d, out %d, ws %zu; need ws >= %zu)\n", n_in, out_size, ws_size, (size_t)WS_END); grid = -1; return; }
        int dev = 0, cus = 0, per_cu = 0;
        if (hipGetDevice(&dev) != hipSuccess || hipDeviceGetAttribute(&cus, hipDeviceAttributeMultiprocessorCount, dev) != hipSuccess) { grid = -1; return; }
        if (hipFuncSetAttribute((const void*)mega_fwd, hipFuncAttributeMaxDynamicSharedMemorySize, LDS_BYTES) != hipSuccess) { fprintf(stderr, "kernel_launch: hipFuncSetAttribute failed\n"); grid = -1; return; }
        if (hipOccupancyMaxActiveBlocksPerMultiprocessor(&per_cu, (const void*)mega_fwd, NWAVES * 64, LDS_BYTES) != hipSuccess || per_cu < 1)
            fprintf(stderr, "kernel_launch: occupancy query reports %d\n", per_cu);
        (void)hipGetLastError();
        grid = cus;
    }
    if (grid < 0) return;
    if (hipMemsetAsync((char*)d_ws + WS_CTL, 0, CTL_ZERO_BYTES, stream) != hipSuccess) return;
    Args a{};
    for (int i = 0; i < 18; ++i) a.in[i] = (const float*)d_in[i];
    a.out = (float*)d_out; a.ws = (unsigned char*)d_ws;
    hipLaunchKernelGGL(mega_fwd, dim3(grid), dim3(NWAVES * 64), LDS_BYTES, stream, a);
}
```

```cpp
#include <hip/hip_runtime.h>
#include <cstdio>
#include <cstdint>

#define LAS __attribute__((address_space(3)))
#define GAS __attribute__((address_space(1)))

namespace pg8 {
typedef unsigned short bf16_t;
typedef short bf16x8 __attribute__((ext_vector_type(8)));
typedef float f32x4 __attribute__((ext_vector_type(4)));
typedef float f32x2 __attribute__((ext_vector_type(2)));
typedef unsigned u32x4 __attribute__((ext_vector_type(4)));
constexpr int BM = 256, BK = 64, HALF = 128, HTB = HALF * BK * 2, STAGE_BYTES = 8 * HTB, NXCD = 8, WGM = 8;

__host__ __device__ __forceinline__ int lds_byte(int r, int c) { const int st = (r >> 4) * 2 + (c >> 5), rr = r & 15, cc = c & 31, ob = rr * 64 + cc * 2; return st * 1024 + (ob ^ (((ob >> 9) & 1) << 5)); }
__host__ __device__ __forceinline__ void stage_rc(int b, int& R, int& C) { const int st = b / 1024, sb = b % 1024, swz = sb ^ (((sb >> 9) & 1) << 5); R = (st >> 1) * 16 + swz / 64; C = (st & 1) * 32 + (swz % 64) / 2; }
__host__ __device__ __forceinline__ int perm32(int rho) { const int n = rho >> 4, i = rho & 15; return 8 * (i >> 2) + 4 * n + (i & 3); }

struct Unit { int pm, pn; };
struct Gemm { const bf16_t* A; const bf16_t* Bt; int K, lda, ldb; size_t a_pm, a_pn, b_pn, b_pm; };
__device__ __forceinline__ Gemm plain_gemm(const bf16_t* A, const bf16_t* Bt, int K, int lda, int ldb) { return Gemm{A, Bt, K, lda, ldb, (size_t)BM * lda * 2, 0, (size_t)BM * ldb * 2, 0}; }

struct StaticOrder {
    int nM, nN, nwg, G, c;
    __host__ __device__ void init(int M, int N, int G_, int c_) { nM = M / BM; nN = N / BM; nwg = nM * nN; G = G_; c = c_; }
    __host__ __device__ bool next(int i, Unit& u) const {
        const long L = (long)i * G + c; if (L >= nwg) return false;
        int wgid = (int)L; { const int q = nwg / NXCD, r = nwg % NXCD, xcd = wgid % NXCD, off = wgid / NXCD; wgid = (xcd < r ? xcd * (q + 1) : r * (q + 1) + (xcd - r) * q) + off; }
        const int nig = WGM * nN, gid = wgid / nig, fm = gid * WGM, gsz = (nM - fm) < WGM ? (nM - fm) : WGM;
        u.pm = fm + ((wgid % nig) % gsz); u.pn = (wgid % nig) / gsz; return true;
    }
    __device__ __forceinline__ void a_ready(const Unit&) const {}
    __device__ __forceinline__ void done(const Unit&) const {}
};

__device__ __forceinline__ unsigned cvt_pk_bf16(float lo, float hi) { unsigned r; asm volatile("v_cvt_pk_bf16_f32 %0, %1, %2" : "=v"(r) : "v"(lo), "v"(hi)); return r; }

struct EpiF32 {
    static constexpr bool PERM = false, AFTER_DRAIN = false;
    float* C; int ldc;
    __device__ __forceinline__ void operator()(const f32x4 (&acc)[2][2][4][2], const Unit& u, int wr, int wc, int fr, int fq) const {
        const int row0 = u.pm * BM + wr * 64 + fr, col0 = u.pn * BM + wc * 32 + 4 * fq;
#pragma unroll
        for (int ai = 0; ai < 2; ++ai)
#pragma unroll
            for (int m = 0; m < 4; ++m) { float* rowp = C + (size_t)(row0 + ai * HALF + m * 16) * ldc + col0;
#pragma unroll
                for (int bj = 0; bj < 2; ++bj)
#pragma unroll
                    for (int n = 0; n < 2; ++n) *(f32x4*)(rowp + bj * HALF + n * 16) = acc[ai][bj][m][n]; }
    }
};
struct EpiBf16S {
    static constexpr bool PERM = true, AFTER_DRAIN = false;
    bf16_t* O; int ldc; const float* scale; int col_off;
    __device__ __forceinline__ void operator()(const f32x4 (&acc)[2][2][4][2], const Unit& u, int wr, int wc, int fr, int fq) const {
        const int row0 = u.pm * BM + wr * 64 + fr; const int col0 = u.pn * BM + wc * 32 + 8 * fq;
        f32x4 sv[2][2];
#pragma unroll
        for (int bj = 0; bj < 2; ++bj)
#pragma unroll
            for (int n = 0; n < 2; ++n) sv[bj][n] = scale ? *(const f32x4*)(scale + col0 + bj * HALF + 4 * n) : (f32x4){1.f, 1.f, 1.f, 1.f};
#pragma unroll
        for (int ai = 0; ai < 2; ++ai)
#pragma unroll
            for (int m = 0; m < 4; ++m) { bf16_t* rowp = O + (size_t)(row0 + ai * HALF + m * 16) * ldc + col_off + col0;
#pragma unroll
                for (int bj = 0; bj < 2; ++bj) { const f32x4 v0 = acc[ai][bj][m][0] * sv[bj][0], v1 = acc[ai][bj][m][1] * sv[bj][1];
                    u32x4 w; w.x = cvt_pk_bf16(v0[0], v0[1]); w.y = cvt_pk_bf16(v0[2], v0[3]); w.z = cvt_pk_bf16(v1[0], v1[1]); w.w = cvt_pk_bf16(v1[2], v1[3]);
                    *(u32x4*)(rowp + bj * HALF) = w; } }
    }
};
__device__ __forceinline__ float silu_mul(float g, float u) { const float e = __builtin_amdgcn_exp2f(g * -1.44269504089f); return g * __builtin_amdgcn_rcpf(1.0f + e) * u; }
struct EpiSwiGLU {
    static constexpr bool PERM = true, AFTER_DRAIN = false;
    bf16_t* O; int ldc;
    __device__ __forceinline__ void operator()(const f32x4 (&acc)[2][2][4][2], const Unit& u, int wr, int wc, int fr, int fq) const {
        const int row0 = u.pm * BM + wr * 64 + fr; const int col0 = u.pn * HALF + wc * 32 + 8 * fq;
#pragma unroll
        for (int ai = 0; ai < 2; ++ai)
#pragma unroll
            for (int m = 0; m < 4; ++m) { bf16_t* rowp = O + (size_t)(row0 + ai * HALF + m * 16) * ldc + col0;
                const f32x4 g0 = acc[ai][0][m][0], g1 = acc[ai][0][m][1], u0 = acc[ai][1][m][0], u1 = acc[ai][1][m][1];
                u32x4 w; w.x = cvt_pk_bf16(silu_mul(g0[0], u0[0]), silu_mul(g0[1], u0[1])); w.y = cvt_pk_bf16(silu_mul(g0[2], u0[2]), silu_mul(g0[3], u0[3]));
                w.z = cvt_pk_bf16(silu_mul(g1[0], u1[0]), silu_mul(g1[1], u1[1])); w.w = cvt_pk_bf16(silu_mul(g1[2], u1[2]), silu_mul(g1[3], u1[3]));
                *(u32x4*)rowp = w; }
    }
};

template <class Epi, class Sched, bool ALIGN_EPI = false, bool SP2 = false>
__device__ __forceinline__ void gemm_phase(LAS unsigned char* lds, const Gemm g, const Sched& S, const Epi& E) {
    int tid = threadIdx.x; asm volatile("" : "+v"(tid));
    const int wid = __builtin_amdgcn_readfirstlane(tid >> 6), lane = tid & 63, wr = wid >> 2, wc = wid & 3, fr = lane & 15, fq = lane >> 4;
    const int K = g.K, nt = K / BK;
    unsigned voffA[2], voffB[2];
#pragma unroll
    for (int i = 0; i < 2; ++i) { int R, C; stage_rc(tid * 16 + i * 8192, R, C); const int Rb = Epi::PERM ? ((R & ~31) + perm32(R & 31)) : R;
        voffA[i] = (unsigned)(R * g.lda + C) * 2u; voffB[i] = (unsigned)(Rb * g.ldb + C) * 2u; }
    const size_t kstep = (size_t)(BK * 2);
    const size_t hstepA = (size_t)HALF * g.lda * 2, hstepB = (size_t)HALF * g.ldb * 2;
    const unsigned ldsw = (unsigned)wid * 1024u;
    const int aoff = lds_byte(wr * 64 + fr, fq * 8), boff = lds_byte(wc * 32 + fr, fq * 8);
#define PG8_SA(b, h) (((b) * 2 + (h)) * HTB)
#define PG8_SB(b, h) ((4 + (b) * 2 + (h)) * HTB)
#define PG8_STAGE(bufoff, gbase, voff) do { _Pragma("unroll") for (int _i = 0; _i < 2; ++_i) \
        __builtin_amdgcn_global_load_lds((const unsigned*)((const char*)(gbase) + (voff)[_i]), (LAS unsigned*)(lds + (bufoff) + ldsw + _i * 8192), 16, 0, 0); } while (0)
#define PG8_LDA(dst, b, h) do { _Pragma("unroll") for (int m = 0; m < 4; ++m) _Pragma("unroll") for (int k = 0; k < 2; ++k) dst[m][k] = *(const LAS bf16x8*)(lds + PG8_SA(b, h) + aoff + m * 2048 + k * 1024); } while (0)
#define PG8_LDB(dst, b, h) do { _Pragma("unroll") for (int n = 0; n < 2; ++n) _Pragma("unroll") for (int k = 0; k < 2; ++k) dst[n][k] = *(const LAS bf16x8*)(lds + PG8_SB(b, h) + boff + n * 2048 + k * 1024); } while (0)
#define PG8_MMA(ai, bj, At, Bt) do { __builtin_amdgcn_s_setprio(1); _Pragma("unroll") for (int m = 0; m < 4; ++m) _Pragma("unroll") for (int n = 0; n < 2; ++n) _Pragma("unroll") for (int k = 0; k < 2; ++k) \
        acc[ai][bj][m][n] = __builtin_amdgcn_mfma_f32_16x16x32_bf16(Bt[n][k], At[m][k], acc[ai][bj][m][n], 0, 0, 0); __builtin_amdgcn_s_setprio(0); } while (0)
#define PG8_WAIT_V(n) asm volatile("s_waitcnt vmcnt(" #n ")" ::: "memory")
#define PG8_WAIT_L(n) asm volatile("s_waitcnt lgkmcnt(" #n ")" ::: "memory")
#define PG8_BAR __builtin_amdgcn_s_barrier()
#define PG8_SCHED __builtin_amdgcn_sched_barrier(0)
    Unit cur, nxt; int ui = 0;
    if (!S.next(0, cur)) return;
    f32x4 acc[2][2][4][2];
#pragma unroll
    for (int a = 0; a < 2; ++a)
#pragma unroll
        for (int b = 0; b < 2; ++b)
#pragma unroll
            for (int m = 0; m < 4; ++m)
#pragma unroll
                for (int n = 0; n < 2; ++n) acc[a][b][m][n] = (f32x4){0.f, 0.f, 0.f, 0.f};
    bf16x8 At[4][2], B0[2][2], B1[2][2];
    const char* cA = (const char*)g.A + (size_t)cur.pm * g.a_pm + (size_t)cur.pn * g.a_pn; const char* cB = (const char*)g.Bt + (size_t)cur.pn * g.b_pn + (size_t)cur.pm * g.b_pm;
    S.a_ready(cur);
    if constexpr (SP2) {
        PG8_STAGE(PG8_SB(0, 0), cB, voffB); PG8_STAGE(PG8_SB(0, 1), cB + hstepB, voffB); PG8_STAGE(PG8_SA(0, 0), cA, voffA); PG8_STAGE(PG8_SA(0, 1), cA + hstepA, voffA);
        if (wr == 1) PG8_BAR;
        PG8_WAIT_V(2); PG8_BAR;
        PG8_STAGE(PG8_SB(1, 0), cB + kstep, voffB); PG8_STAGE(PG8_SA(1, 0), cA + kstep, voffA); PG8_STAGE(PG8_SB(1, 1), cB + hstepB + kstep, voffB);
        PG8_WAIT_V(6); PG8_BAR;
    } else {
        PG8_STAGE(PG8_SB(0, 0), cB, voffB); PG8_STAGE(PG8_SA(0, 0), cA, voffA); PG8_STAGE(PG8_SB(0, 1), cB + hstepB, voffB); PG8_STAGE(PG8_SA(0, 1), cA + hstepA, voffA);
        if (wr == 1) PG8_BAR;
        PG8_WAIT_V(4); PG8_BAR;
        PG8_STAGE(PG8_SB(1, 0), cB + kstep, voffB); PG8_STAGE(PG8_SA(1, 0), cA + kstep, voffA); PG8_STAGE(PG8_SB(1, 1), cB + hstepB + kstep, voffB);
        PG8_WAIT_V(6); PG8_BAR;
    }
    for (;;) {
        const bool has_next = S.next(ui + 1, nxt);
        const char* nA = has_next ? (const char*)g.A + (size_t)nxt.pm * g.a_pm + (size_t)nxt.pn * g.a_pn : cA; const char* nB = has_next ? (const char*)g.Bt + (size_t)nxt.pn * g.b_pn + (size_t)nxt.pm * g.b_pm : cB;
        for (int t = 0; t < nt; t += 2) {
            const bool last = (t == nt - 2);
            const char* a1 = cA + (size_t)(t + 1) * kstep;
            const char* a2 = last ? nA : cA + (size_t)(t + 2) * kstep; const char* b2 = last ? nB : cB + (size_t)(t + 2) * kstep;
            const char* a3 = a2 + kstep; const char* b3 = b2 + kstep;
            if (last && has_next) S.a_ready(nxt);
            if constexpr (SP2) {
            PG8_LDB(B0, 0, 0); PG8_LDB(B1, 0, 1); PG8_SCHED; PG8_LDA(At, 0, 0); PG8_STAGE(PG8_SA(1, 1), a1 + hstepA, voffA);
            PG8_WAIT_V(8); PG8_WAIT_L(0); PG8_BAR; PG8_MMA(0, 0, At, B0); PG8_MMA(0, 1, At, B1); PG8_BAR; PG8_SCHED;
            PG8_LDA(At, 0, 1); PG8_STAGE(PG8_SB(0, 0), b2, voffB); PG8_STAGE(PG8_SB(0, 1), b2 + hstepB, voffB); PG8_STAGE(PG8_SA(0, 0), a2, voffA);
            PG8_WAIT_V(8); PG8_WAIT_L(0); PG8_BAR; PG8_MMA(1, 0, At, B0); PG8_MMA(1, 1, At, B1); PG8_BAR; PG8_SCHED;
            PG8_LDB(B0, 1, 0); PG8_LDB(B1, 1, 1); PG8_SCHED; PG8_LDA(At, 1, 0); PG8_STAGE(PG8_SA(0, 1), a2 + hstepA, voffA);
            PG8_WAIT_V(8); PG8_WAIT_L(0); PG8_BAR; PG8_MMA(0, 0, At, B0); PG8_MMA(0, 1, At, B1); PG8_BAR; PG8_SCHED;
            PG8_LDA(At, 1, 1); PG8_STAGE(PG8_SB(1, 0), b3, voffB); PG8_STAGE(PG8_SB(1, 1), b3 + hstepB, voffB); PG8_STAGE(PG8_SA(1, 0), a3, voffA);
            PG8_WAIT_V(8); PG8_WAIT_L(0); PG8_BAR; PG8_MMA(1, 0, At, B0); PG8_MMA(1, 1, At, B1); PG8_BAR; PG8_SCHED;
            } else {
            PG8_LDB(B0, 0, 0); PG8_SCHED; PG8_LDA(At, 0, 0); PG8_STAGE(PG8_SA(1, 1), a1 + hstepA, voffA);
            PG8_WAIT_L(8); PG8_BAR; PG8_WAIT_L(0); PG8_MMA(0, 0, At, B0); PG8_BAR; PG8_SCHED;
            PG8_LDB(B1, 0, 1); PG8_STAGE(PG8_SB(0, 0), b2, voffB);
            PG8_BAR; PG8_WAIT_L(0); PG8_MMA(0, 1, At, B1); PG8_BAR;
            PG8_LDA(At, 0, 1); PG8_STAGE(PG8_SA(0, 0), a2, voffA);
            PG8_BAR; PG8_WAIT_L(0); PG8_MMA(1, 0, At, B0); PG8_BAR; PG8_SCHED;
            PG8_STAGE(PG8_SB(0, 1), b2 + hstepB, voffB);
            PG8_WAIT_V(6); PG8_BAR; PG8_MMA(1, 1, At, B1); PG8_BAR;
            PG8_LDB(B0, 1, 0); PG8_SCHED; PG8_LDA(At, 1, 0); PG8_STAGE(PG8_SA(0, 1), a2 + hstepA, voffA);
            PG8_WAIT_L(8); PG8_BAR; PG8_WAIT_L(0); PG8_MMA(0, 0, At, B0); PG8_BAR; PG8_SCHED;
            PG8_LDB(B1, 1, 1); PG8_STAGE(PG8_SB(1, 0), b3, voffB);
            PG8_BAR; PG8_WAIT_L(0); PG8_MMA(0, 1, At, B1); PG8_BAR;
            PG8_LDA(At, 1, 1); PG8_STAGE(PG8_SA(1, 0), a3, voffA);
            PG8_BAR; PG8_WAIT_L(0); PG8_MMA(1, 0, At, B0); PG8_BAR; PG8_SCHED;
            PG8_STAGE(PG8_SB(1, 1), b3 + hstepB, voffB);
            PG8_WAIT_V(6); PG8_BAR; PG8_MMA(1, 1, At, B1); PG8_BAR;
            }
        }
        if constexpr (ALIGN_EPI) { if (wr == 0) PG8_BAR; }
        if constexpr (!Epi::AFTER_DRAIN) { E(acc, cur, wr, wc, fr, fq); S.done(cur); }
        if (!has_next) break;
#pragma unroll
        for (int a = 0; a < 2; ++a)
#pragma unroll
            for (int b = 0; b < 2; ++b)
#pragma unroll
                for (int m = 0; m < 4; ++m)
#pragma unroll
                    for (int n = 0; n < 2; ++n) acc[a][b][m][n] = (f32x4){0.f, 0.f, 0.f, 0.f};
        cur = nxt; cA = nA; cB = nB; ++ui;
        if constexpr (ALIGN_EPI) { if (wr == 1) PG8_BAR; }
    }
    PG8_WAIT_V(0);
    if constexpr (!ALIGN_EPI) { if (wr == 0) PG8_BAR; }
    PG8_BAR;
#undef PG8_SA
#undef PG8_SB
#undef PG8_STAGE
#undef PG8_LDA
#undef PG8_LDB
#undef PG8_MMA
#undef PG8_WAIT_V
#undef PG8_WAIT_L
#undef PG8_BAR
#undef PG8_SCHED
}
}

typedef unsigned short bf16;
typedef unsigned v4u __attribute__((ext_vector_type(4)));
typedef unsigned v2u __attribute__((ext_vector_type(2)));
typedef float f32x4 __attribute__((ext_vector_type(4)));
typedef float f32x2 __attribute__((ext_vector_type(2)));
typedef float f32x16 __attribute__((ext_vector_type(16)));
typedef short bf16x8 __attribute__((ext_vector_type(8)));
typedef short s16x4 __attribute__((ext_vector_type(4)));

constexpr int NWAVES = 8;
constexpr int D = 2048, MP = 8192, MS = 256, M = MP + MS, DFF = 5504, NFF = 2 * DFF, NMIX = 4096, NQKV = 2560, DCV = 1024;
constexpr int DFFP = 5632;
constexpr int NSL_FFN = DFFP / 256, NSL_MIX = D / 256;
constexpr int SEQ = 2048, NB = 4, DB = 32, DS = 8, NHEAD = 32, NKVH = 4, HD = 64, KVB = 128, PCTX = 15;
constexpr float EPS = 1e-6f;
constexpr float LOG2E = 1.4426950408889634f;

constexpr size_t O_Y = 0, O_CONVP = (size_t)M * D, O_POOLP = O_CONVP + 2 * NB * 2 * DCV, O_KP = O_POOLP + 2 * NB * PCTX * DCV, O_VP = O_KP + 2 * NB * KVB * 256,
                 O_CONVS = O_VP + 2 * NB * KVB * 256, O_POOLS = O_CONVS + 2 * DB * 2 * DCV, O_KS = O_POOLS + 2 * DB * PCTX * DCV, O_VS = O_KS + 2 * DB * KVB * 256, O_END = O_VS + 2 * DB * KVB * 256;
static_assert(O_END == 23273472, "output size");

constexpr size_t MiB = 1u << 20;
constexpr size_t WS_CTL = 0, CTL_ZERO_BYTES = 1 * MiB;
constexpr size_t WS_HB = 2 * MiB;
constexpr size_t WS_ACT = 36 * MiB;
constexpr size_t WS_Y = 128 * MiB;
constexpr size_t WS_Z = 194 * MiB;
constexpr size_t WS_CAT = 260 * MiB;
constexpr size_t WS_DP = 294 * MiB;
constexpr size_t WS_YP = 312 * MiB;
constexpr size_t WS_W = 360 * MiB;
constexpr size_t SZ_FFNIN = (size_t)NFF * D, SZ_FFNOUT = (size_t)D * DFFP, SZ_MIXIN = (size_t)NMIX * D, SZ_MIXOUT = (size_t)D * D, SZ_QKV = (size_t)NQKV * D, SZ_WO = (size_t)D * D, SZ_POOLW = 4 * 256 * 256;
constexpr size_t WO_FFNIN = 0, WO_FFNOUT = WO_FFNIN + 8 * SZ_FFNIN, WO_MIXIN = WO_FFNOUT + 8 * SZ_FFNOUT, WO_MIXOUT = WO_MIXIN + 2 * SZ_MIXIN, WO_QKV = WO_MIXOUT + 2 * SZ_MIXOUT,
                 WO_WO = WO_QKV + 2 * SZ_QKV, WO_POOLW = WO_WO + 2 * SZ_WO, WO_END = WO_POOLW + 2 * SZ_POOLW;
constexpr size_t WS_END = WS_W + WO_END * 2;
static_assert(WS_HB + (size_t)M * D * 2 <= WS_ACT && WS_ACT + (size_t)M * DFFP * 2 <= WS_Y && WS_Y + (size_t)M * D * 4 <= WS_Z && WS_Z + (size_t)M * NMIX * 2 <= WS_CAT && WS_CAT + (size_t)M * D * 2 <= WS_DP && WS_DP + (size_t)M * DCV * 2 <= WS_YP && WS_YP + (size_t)NSL_FFN * 256 * D * 4 <= WS_W, "ws map");
constexpr int CW_BAR = 4096;

constexpr int RING_BYTES = 135168;
constexpr int LDSCTL_OFF = RING_BYTES, MISC_OFF = LDSCTL_OFF + 320;
constexpr int LDS_BYTES = 147456;
static_assert(MISC_OFF + 128 <= LDS_BYTES, "LDS map");

#define LDS_WAIT() asm volatile("s_waitcnt lgkmcnt(0)" ::: "memory")
#define VM_WAIT() asm volatile("s_waitcnt vmcnt(0)" ::: "memory")
__device__ __forceinline__ unsigned f2bf(float f) { unsigned u = __builtin_bit_cast(unsigned, f); return (u + 0x7fffu + ((u >> 16) & 1u)) >> 16; }
__device__ __forceinline__ unsigned pk2(float lo, float hi) { return f2bf(lo) | (f2bf(hi) << 16); }
__device__ __forceinline__ float bf_lo(unsigned w) { return __builtin_bit_cast(float, w << 16); }
__device__ __forceinline__ float bf_hi(unsigned w) { return __builtin_bit_cast(float, w & 0xffff0000u); }

#define XB_TMO      128
#define XB_XCNT(j)  (256  + 64 * (j))
#define XB_XSUB(j)  (1280 + 64 * (j))
#define XB_XGEN(j)  (2304 + 64 * (j))
#define XB_TOP      3328
#define XB_TOPGEN   3392
#define XCD_BAR_WORDS 3456
#define XB_SPIN_CAP (1u << 18)
__device__ __forceinline__ unsigned xb_ld(unsigned* p)              { return __hip_atomic_load(p, __ATOMIC_RELAXED, __HIP_MEMORY_SCOPE_AGENT); }
__device__ __forceinline__ unsigned xb_add(unsigned* p, unsigned v) { return __hip_atomic_fetch_add(p, v, __ATOMIC_RELAXED, __HIP_MEMORY_SCOPE_AGENT); }
__device__ __forceinline__ unsigned xb_xcc_id() { return (unsigned)__builtin_amdgcn_s_getreg((3 << 11) | 20) & 0xFu; }
#define XB_SPIN(cond, bar) do { unsigned _sp = 0; while (cond) { __builtin_amdgcn_s_sleep(1); \
    if ((++_sp & 255u) == 0u) { if (xb_ld(&(bar)[XB_TMO])) break; if (_sp > XB_SPIN_CAP) { atomicAdd(&(bar)[XB_TMO], 1u); break; } } } } while (0)
struct XcdBarrier { unsigned* bar; unsigned x; volatile LAS unsigned* st; };
__device__ __forceinline__ XcdBarrier xcd_barrier_post(unsigned* bar, volatile LAS unsigned* st) {
    XcdBarrier b; b.bar = bar; b.x = xb_xcc_id(); b.st = st;
    if (threadIdx.x == 0) (void)xb_add(&bar[XB_XCNT(b.x)], 1u);
    return b;
}
__device__ __forceinline__ void xcd_barrier_complete(unsigned* bar, unsigned x, unsigned& nloc, unsigned& nx) {
    const unsigned G = gridDim.x * gridDim.y * gridDim.z;
    unsigned sum, cnt, mine, sp = 0u;
    for (;;) {
        sum = 0u; cnt = 0u; mine = 0u;
#pragma unroll
        for (unsigned j = 0; j < 16; ++j) { const unsigned c = xb_ld(&bar[XB_XCNT(j)]); sum += c; cnt += (c > 0u) ? 1u : 0u; mine = (j == x) ? c : mine; }
        if (sum == G) break;
        __builtin_amdgcn_s_sleep(1);
        if ((++sp & 255u) == 0u) { if (xb_ld(&bar[XB_TMO])) break; if (sp > XB_SPIN_CAP) { atomicAdd(&bar[XB_TMO], 1u); break; } }
    }
    nloc = mine > 0u ? mine : 1u; nx = cnt > 0u ? cnt : 1u;
}
__device__ __forceinline__ void xcd_barrier(const XcdBarrier& b) {
    asm volatile("s_waitcnt vmcnt(0)" ::: "memory");
    __syncthreads();
    if (threadIdx.x == 0) {
        unsigned* bar = b.bar; asm volatile("" : "+s"(bar));
        __builtin_amdgcn_s_waitcnt(0);
        unsigned nloc = b.st[0], nx = b.st[1];
        const unsigned bx = xb_xcc_id();
        if (nloc == 0u) { xcd_barrier_complete(bar, bx, nloc, nx); b.st[0] = nloc; b.st[1] = nx; }
        const unsigned old = xb_add(&bar[XB_XSUB(bx)], 1u);
        const unsigned gen = old / nloc;
        if (old + 1u == (gen + 1u) * nloc) {
            __builtin_amdgcn_fence(__ATOMIC_RELEASE, "agent");
            asm volatile("s_waitcnt vmcnt(0)" ::: "memory");
            const unsigned og = xb_add(&bar[XB_TOP], 1u);
            const unsigned tg = og / nx;
            if (og + 1u == (tg + 1u) * nx) xb_add(&bar[XB_TOPGEN], 1u);
            else XB_SPIN(xb_ld(&bar[XB_TOPGEN]) == tg, bar);
            __builtin_amdgcn_fence(__ATOMIC_ACQUIRE, "agent");
            xb_add(&bar[XB_XGEN(bx)], 1u);
            asm volatile("s_waitcnt vmcnt(0)" ::: "memory");
        } else {
            XB_SPIN(xb_ld(&bar[XB_XGEN(bx)]) == gen, bar);
            __builtin_amdgcn_fence(__ATOMIC_ACQUIRE, "agent");
            asm volatile("s_waitcnt vmcnt(0)" ::: "memory");
        }
    }
    __syncthreads();
}

__device__ __forceinline__ float wave_sum(float v) {
#pragma unroll
    for (int o = 1; o < 64; o <<= 1) v += __shfl_xor(v, o);
    return v;
}

__device__ __forceinline__ void tr_item(const float* __restrict__ src, int sld, bf16* __restrict__ dst, int K  , int k0, LAS float* scr, int lane) {
    const GAS float* s = (const GAS float*)src + (size_t)(k0 + (lane >> 4)) * sld + (lane & 15) * 4;
    f32x4 v[16];
#pragma unroll
    for (int it = 0; it < 16; ++it) v[it] = *(const GAS f32x4*)(s + (size_t)(4 * it) * sld);
#pragma unroll
    for (int it = 0; it < 16; ++it) { LAS float* w = scr + ((lane >> 4) + 4 * it) * 65 + (lane & 15) * 4; w[0] = v[it].x; w[1] = v[it].y; w[2] = v[it].z; w[3] = v[it].w; }
    LDS_WAIT(); asm volatile("" ::: "memory");
    const int c = lane >> 3, n1 = lane & 7;
#pragma unroll
    for (int jj = 0; jj < 8; ++jj) { const int n = n1 + 8 * jj; const LAS float* r = scr + (8 * c) * 65 + n;
        v4u o; o.x = pk2(r[0], r[65]); o.y = pk2(r[2 * 65], r[3 * 65]); o.z = pk2(r[4 * 65], r[5 * 65]); o.w = pk2(r[6 * 65], r[7 * 65]);
        *(GAS v4u*)(dst + (size_t)n * K + k0 + 8 * c) = o; }
    LDS_WAIT(); asm volatile("" ::: "memory");
}

struct Args { const float* in[18]; float* out; unsigned char* ws; };
typedef const __attribute__((address_space(4))) Args CArgs;
__device__ __forceinline__ CArgs* fresh_args() { CArgs* p = (CArgs*)__builtin_amdgcn_kernarg_segment_ptr(); asm volatile("" : "+s"(p)); return p; }

constexpr int IT_FFNIN = 8 * (D / 64) * (NFF / 64), IT_FFNOUT = 8 * (DFF / 64) * (D / 64), IT_MIXIN = 2 * (D / 64) * (NMIX / 64), IT_MIXOUT = 2 * (D / 64) * (D / 64),
              IT_QKV = 2 * (D / 64) * (NQKV / 64), IT_WO = IT_MIXOUT, IT_POOLW = 8 * 4 * 4;
constexpr int IT_TOTAL = IT_FFNIN + IT_FFNOUT + IT_MIXIN + IT_MIXOUT + IT_QKV + IT_WO + IT_POOLW;

__device__ __forceinline__ void prologue(CArgs* ap, LAS unsigned char* lds, int gw, int NGW, int wave, int lane) {
    struct { const float* in[18]; float* out; unsigned char* ws; } a;
    a.in[0] = ap->in[0]; a.in[1] = ap->in[1]; a.in[6] = ap->in[6]; a.in[7] = ap->in[7]; a.in[8] = ap->in[8]; a.in[9] = ap->in[9]; a.in[11] = ap->in[11]; a.in[13] = ap->in[13]; a.in[14] = ap->in[14]; a.in[15] = ap->in[15]; a.out = ap->out; a.ws = ap->ws;
    LAS float* scr = (LAS float*)(lds + wave * 16640);
    bf16* W = (bf16*)(a.ws + WS_W);
    for (int it = gw; it < IT_TOTAL; it += NGW) {
        int r = it;
        if (r < IT_FFNIN) { constexpr int per = (D / 64) * (NFF / 64), nbn = NFF / 64; const int mat = r / per, rr = r % per, kb = rr / nbn, nb = rr % nbn;
            const int n0 = nb * 64, tile = n0 >> 8, w = n0 & 255, scol = (w < 128) ? tile * 128 + w : DFF + tile * 128 + (w - 128);
            tr_item(a.in[7] + (size_t)mat * D * NFF + scol, NFF, W + WO_FFNIN + (size_t)mat * SZ_FFNIN + (size_t)n0 * D, D, kb * 64, scr, lane); continue; }
        r -= IT_FFNIN;
        if (r < IT_FFNOUT) { constexpr int per = (DFF / 64) * (D / 64), nbn = D / 64; const int mat = r / per, rr = r % per, kb = rr / nbn, nb = rr % nbn;
            tr_item(a.in[8] + (size_t)mat * DFF * D + nb * 64, D, W + WO_FFNOUT + (size_t)mat * SZ_FFNOUT + (size_t)(nb * 64) * DFFP, DFFP, kb * 64, scr, lane); continue; }
        r -= IT_FFNOUT;
        if (r < IT_MIXIN) { constexpr int per = (D / 64) * (NMIX / 64), nbn = NMIX / 64; const int mat = r / per, rr = r % per, kb = rr / nbn, nb = rr % nbn;
            tr_item(a.in[9] + (size_t)mat * D * NMIX + nb * 64, NMIX, W + WO_MIXIN + (size_t)mat * SZ_MIXIN + (size_t)(nb * 64) * D, D, kb * 64, scr, lane); continue; }
        r -= IT_MIXIN;
        if (r < IT_MIXOUT) { constexpr int per = (D / 64) * (D / 64), nbn = D / 64; const int mat = r / per, rr = r % per, kb = rr / nbn, nb = rr % nbn;
            tr_item(a.in[13] + (size_t)mat * D * D + nb * 64, D, W + WO_MIXOUT + (size_t)mat * SZ_MIXOUT + (size_t)(nb * 64) * D, D, kb * 64, scr, lane); continue; }
        r -= IT_MIXOUT;
        if (r < IT_QKV) { constexpr int per = (D / 64) * (NQKV / 64), nbn = NQKV / 64; const int mat = r / per, rr = r % per, kb = rr / nbn, nb = rr % nbn;
            tr_item(a.in[14] + (size_t)mat * D * NQKV + nb * 64, NQKV, W + WO_QKV + (size_t)mat * SZ_QKV + (size_t)(nb * 64) * D, D, kb * 64, scr, lane); continue; }
        r -= IT_QKV;
        if (r < IT_WO) { constexpr int per = (D / 64) * (D / 64), nbn = D / 64; const int mat = r / per, rr = r % per, kb = rr / nbn, nb = rr % nbn;
            tr_item(a.in[15] + (size_t)mat * D * D + nb * 64, D, W + WO_WO + (size_t)mat * SZ_WO + (size_t)(nb * 64) * D, D, kb * 64, scr, lane); continue; }
        r -= IT_WO;
        { const int mat = r >> 4, rr = r & 15, kb = rr >> 2, nb = rr & 3;
            tr_item(a.in[11] + (size_t)mat * 65536 + nb * 64, 256, W + WO_POOLW + (size_t)mat * 65536 + (size_t)(nb * 64) * 256, 256, kb * 64, scr, lane); }
    }
    for (int r = gw * 4 + (lane >> 4); r < 8 * D + M; r += NGW * 4) {
        bf16* p = r < 8 * D ? W + WO_FFNOUT + (size_t)r * DFFP + DFF : (bf16*)(a.ws + WS_ACT) + (size_t)(r - 8 * D) * DFFP + DFF;
        *(GAS v4u*)(p + (lane & 15) * 8) = (v4u){0u, 0u, 0u, 0u}; }
    const GAS f32x4* g4 = (const GAS f32x4*)a.in[6];
    for (int row = gw; row < M; row += NGW) {
        const float* xr = row < MP ? a.in[0] + (size_t)row * D : a.in[1] + (size_t)(row - MP) * D;
        const GAS f32x4* x4 = (const GAS f32x4*)xr + lane;
        f32x4 v[8]; float ss = 0.f;
#pragma unroll
        for (int j = 0; j < 8; ++j) { v[j] = x4[64 * j]; ss += (v[j].x * v[j].x + v[j].y * v[j].y) + (v[j].z * v[j].z + v[j].w * v[j].w); }
        const float rs = 1.0f / sqrtf(wave_sum(ss) * (1.f / D) + EPS);
        GAS f32x4* xo = (GAS f32x4*)(a.out + (size_t)row * D) + lane;
        GAS v2u* ho = (GAS v2u*)((bf16*)(a.ws + WS_HB) + (size_t)row * D) + lane;
#pragma unroll
        for (int j = 0; j < 8; ++j) { xo[64 * j] = v[j]; const f32x4 g = g4[lane + 64 * j];
            v2u o; o.x = pk2(v[j].x * rs * g.x, v[j].y * rs * g.y); o.y = pk2(v[j].z * rs * g.z, v[j].w * rs * g.w); ho[64 * j] = o; }
    }
}

__device__ __forceinline__ void norm_row(f32x4 (&y)[8], float* X, bf16* HB, float sc, const GAS f32x4* ga4, const GAS f32x4* gb4, int row, int lane) {
    GAS f32x4* x4 = (GAS f32x4*)(X + (size_t)row * D) + lane;
    f32x4 x[8]; float ss = 0.f;
#pragma unroll
    for (int j = 0; j < 8; ++j) x[j] = x4[64 * j];
#pragma unroll
    for (int j = 0; j < 8; ++j) ss += (y[j].x * y[j].x + y[j].y * y[j].y) + (y[j].z * y[j].z + y[j].w * y[j].w);
    const float r1 = sc / sqrtf(wave_sum(ss) * (1.f / D) + EPS);
    float s2 = 0.f;
#pragma unroll
    for (int j = 0; j < 8; ++j) { const f32x4 g = ga4[lane + 64 * j]; x[j] = x[j] + y[j] * g * r1; x4[64 * j] = x[j];
        s2 += (x[j].x * x[j].x + x[j].y * x[j].y) + (x[j].z * x[j].z + x[j].w * x[j].w); }
    if (gb4) {
        const float r2 = 1.0f / sqrtf(wave_sum(s2) * (1.f / D) + EPS);
        GAS v2u* ho = (GAS v2u*)(HB + (size_t)row * D) + lane;
#pragma unroll
        for (int j = 0; j < 8; ++j) { const f32x4 g = gb4[lane + 64 * j];
            v2u o; o.x = pk2(x[j].x * r2 * g.x, x[j].y * r2 * g.y); o.y = pk2(x[j].z * r2 * g.z, x[j].w * r2 * g.w); ho[64 * j] = o; }
    }
}
template <int NSL>
__device__ __forceinline__ void norm_phase(const float* Y, const float* YP, float* X, bf16* HB, float sc, const float* ga, const float* gb, int gw, int NGW, int lane) {
    const GAS f32x4* ga4 = (const GAS f32x4*)ga; const GAS f32x4* gb4 = (const GAS f32x4*)gb;
    if ((gw & 7) == 0) {
        for (int r = gw >> 3; r < MS; r += (NGW >> 3)) {
            const GAS f32x4* p4 = (const GAS f32x4*)(YP + (size_t)r * D) + lane;
            f32x4 y[8];
#pragma unroll
            for (int j = 0; j < 8; ++j) { f32x4 pv[NSL];
#pragma unroll
                for (int i = 0; i < NSL; ++i) pv[i] = p4[(size_t)i * (256 * D / 4) + 64 * j];
                f32x4 a = pv[0];
#pragma unroll
                for (int i = 1; i < NSL; ++i) a = a + pv[i];
                y[j] = a; }
            norm_row(y, X, HB, sc, ga4, gb4, MP + r, lane);
        }
    }
    for (int row = gw; row < MP; row += NGW) {
        const GAS f32x4* y4 = (const GAS f32x4*)(Y + (size_t)row * D) + lane;
        f32x4 y[8];
#pragma unroll
        for (int j = 0; j < 8; ++j) y[j] = y4[64 * j];
        norm_row(y, X, HB, sc, ga4, gb4, row, lane);
    }
}

__device__ __forceinline__ unsigned ldz(const bf16* Zb, unsigned off) { return *(const GAS unsigned*)((const GAS char*)Zb + off); }
__device__ __forceinline__ void convpool_phase(CArgs* ap, int j, int bid, int G, int tid) {
    const bf16* Z = (const bf16*)(ap->ws + WS_Z); bf16* CAT = (bf16*)(ap->ws + WS_CAT); bf16* DP = (bf16*)(ap->ws + WS_DP);
    const int c = 2 * tid, gi = tid >> 7, w = 2 << gi;
    const float* cw = ap->in[10] + (size_t)j * 3 * DCV + c;
    const f32x2 w0 = *(const f32x2*)cw, w1 = *(const f32x2*)(cw + DCV), w2 = *(const f32x2*)(cw + 2 * DCV);
    float* out = ap->out;
    for (int u = bid; u < 256 + DB; u += G) {
        if (u < 256) {
            const int b = u >> 6, t0 = (u & 63) * 32; const int rb = b * SEQ;
            const bf16* Zb = Z + (size_t)rb * NMIX; bf16* Cb = CAT + (size_t)rb * D; bf16* Db = DP + (size_t)rb * DCV;
            f32x2 vm2 = {0.f, 0.f}, vm1 = {0.f, 0.f}, S = {0.f, 0.f};
            if (t0 > 0) {
                { const unsigned o = (unsigned)((t0 - 2) * NMIX + c) * 2u; const unsigned h = ldz(Zb, o), g = ldz(Zb, o + 2048u); vm2 = (f32x2){bf_lo(h) * bf_lo(g), bf_hi(h) * bf_hi(g)}; }
                { const unsigned o = (unsigned)((t0 - 1) * NMIX + c) * 2u; const unsigned h = ldz(Zb, o), g = ldz(Zb, o + 2048u); vm1 = (f32x2){bf_lo(h) * bf_lo(g), bf_hi(h) * bf_hi(g)}; }
                for (int i = 1; i <= w; ++i) { const unsigned uu = ldz(Zb, (unsigned)((t0 - i) * NMIX + 3072 + c) * 2u); S.x += bf_lo(uu); S.y += bf_hi(uu); }
            }
            const bool lastc = (t0 == SEQ - 32);
#pragma unroll 2
            for (int t = t0; t < t0 + 32; ++t) {
                const unsigned o = (unsigned)(t * NMIX + c) * 2u;
                const unsigned hh = ldz(Zb, o), gg = ldz(Zb, o + 2048u), bb = ldz(Zb, o + 4096u), uu = ldz(Zb, o + 6144u);
                unsigned uo = 0u; if (t >= w) uo = ldz(Zb, (unsigned)((t - w) * NMIX + 3072 + c) * 2u);
                const f32x2 v = {bf_lo(hh) * bf_lo(gg), bf_hi(hh) * bf_hi(gg)};
                const f32x2 yc = w0 * vm2 + w1 * vm1 + w2 * v; vm2 = vm1; vm1 = v;
                const f32x2 ut = {bf_lo(uu), bf_hi(uu)};
                S.x += ut.x - bf_lo(uo); S.y += ut.y - bf_hi(uo);
                const float cnt = (float)((t + 1 < w) ? (t + 1) : w);
                const f32x2 dd = S / cnt - ut;
                *(GAS unsigned*)((GAS char*)Cb + (unsigned)(t * D + c) * 2u) = pk2(bf_lo(bb) * yc.x, bf_hi(bb) * yc.y);
                *(GAS unsigned*)((GAS char*)Db + (unsigned)(t * DCV + c) * 2u) = pk2(dd.x, dd.y);
                if (lastc) {
                    if (t >= SEQ - 2) *(GAS f32x2*)((GAS char*)(out + O_CONVP + (size_t)(j * NB + b) * 2 * DCV) + (unsigned)((t - (SEQ - 2)) * DCV + c) * 4u) = v;
                    if (t >= SEQ - PCTX) *(GAS f32x2*)((GAS char*)(out + O_POOLP + (size_t)(j * NB + b) * PCTX * DCV) + (unsigned)((t - (SEQ - PCTX)) * DCV + c) * 4u) = ut;
                }
            }
        } else {
            const int b = u - 256; const int rb = MP + b * DS;
            const bf16* Zb = Z + (size_t)rb * NMIX; bf16* Cb = CAT + (size_t)rb * D; bf16* Db = DP + (size_t)rb * DCV;
            const GAS char* cc = (const GAS char*)(ap->in[2] + (size_t)(j * DB + b) * 2 * DCV);
            const GAS char* pc = (const GAS char*)(ap->in[3] + (size_t)(j * DB + b) * PCTX * DCV);
            GAS char* pso = (GAS char*)(out + O_POOLS + (size_t)(j * DB + b) * PCTX * DCV);
            GAS char* cso = (GAS char*)(out + O_CONVS + (size_t)(j * DB + b) * 2 * DCV);
            const unsigned c4 = (unsigned)c * 4u;
            f32x2 vm2 = *(const GAS f32x2*)(cc + c4), vm1 = *(const GAS f32x2*)(cc + c4 + DCV * 4u), S = {0.f, 0.f};
            for (int i = 1; i <= w && i <= PCTX; ++i) { const f32x2 p = *(const GAS f32x2*)(pc + c4 + (unsigned)(PCTX - i) * (DCV * 4u)); S += p; }
            for (int i = 0; i < PCTX - DS; ++i) *(GAS f32x2*)(pso + c4 + (unsigned)i * (DCV * 4u)) = *(const GAS f32x2*)(pc + c4 + (unsigned)(DS + i) * (DCV * 4u));
            for (int t = 0; t < DS; ++t) {
                const unsigned o = (unsigned)(t * NMIX + c) * 2u;
                const unsigned hh = ldz(Zb, o), gg = ldz(Zb, o + 2048u), bb = ldz(Zb, o + 4096u), uu = ldz(Zb, o + 6144u);
                f32x2 uo = {0.f, 0.f};
                if (t - w >= 0) { const unsigned uw = ldz(Zb, (unsigned)((t - w) * NMIX + 3072 + c) * 2u); uo = (f32x2){bf_lo(uw), bf_hi(uw)}; }
                else if (t - w >= -PCTX) uo = *(const GAS f32x2*)(pc + c4 + (unsigned)(PCTX + t - w) * (DCV * 4u));
                const f32x2 v = {bf_lo(hh) * bf_lo(gg), bf_hi(hh) * bf_hi(gg)};
                const f32x2 yc = w0 * vm2 + w1 * vm1 + w2 * v; vm2 = vm1; vm1 = v;
                const f32x2 ut = {bf_lo(uu), bf_hi(uu)};
                S += ut - uo;
                const f32x2 dd = S / (float)w - ut;
                *(GAS unsigned*)((GAS char*)Cb + (unsigned)(t * D + c) * 2u) = pk2(bf_lo(bb) * yc.x, bf_hi(bb) * yc.y);
                *(GAS unsigned*)((GAS char*)Db + (unsigned)(t * DCV + c) * 2u) = pk2(dd.x, dd.y);
                if (t >= DS - 2) *(GAS f32x2*)(cso + c4 + (unsigned)(t - (DS - 2)) * (DCV * 4u)) = v;
                *(GAS f32x2*)(pso + c4 + (unsigned)(PCTX - DS + t) * (DCV * 4u)) = ut;
            }
        }
    }
}

constexpr int AT_KP = 144, AT_VP = 520;
constexpr int AT_K = 0, AT_V = 256 * AT_KP, AT_B = AT_V + 64 * AT_VP, AT_END = AT_B + NHEAD * 192 * 4;
static_assert(AT_END <= RING_BYTES && (AT_V % 16) == 0 && (AT_B % 16) == 0, "attention LDS map");
__device__ __forceinline__ int crow(int r, int hi) { return (r & 3) + 8 * (r >> 2) + 4 * hi; }

__device__ __forceinline__ void attention_phase(CArgs* ap, LAS unsigned char* lds, int j, int bid, int G, int tid, int wave, int lane_in) {
    const bf16* QKV = (const bf16*)(ap->ws + WS_Z); bf16* ATT = (bf16*)(ap->ws + WS_CAT);
    float* out = ap->out; const float* relb = ap->in[17]; const float* ck = ap->in[4]; const float* cv = ap->in[5]; const float* sinks = ap->in[16];
    LAS float* biasL = (LAS float*)(lds + AT_B);
    for (int e = tid; e < NHEAD * 192; e += NWAVES * 64) {
        const int h = e / 192, dist = e % 192 - 32; float v = -1e30f;
        if (dist >= 0 && dist <= 128) { int bk = dist;
            if (dist >= 16) { const float ratio = logf((float)dist / 16.0f) / 2.0794415416798357f; bk = 16 + (int)(ratio * 16.0f); if (bk > 31) bk = 31; }
            v = relb[bk * NHEAD + h] * LOG2E; }
        biasL[e] = v;
    }
    const float CS = 0.125f * LOG2E;
    for (int u = bid; u < 256 + DB * NKVH; u += G) {
        __syncthreads();
        asm volatile("" : "+v"(tid));
        const bool prompt = u < 256;
        int b, kvh, row0; bool first = false, lastb = false;
        if (prompt) { b = u >> 6; kvh = (u >> 4) & 3; const int qb = u & 15; row0 = b * SEQ + qb * 128; first = (qb == 0); lastb = (qb == 15); }
        else { const int su = u - 256; b = su >> 2; kvh = su & 3; row0 = MP + b * DS; }
        if (prompt) {
#pragma unroll
            for (int it = 0; it < 4; ++it) { const int id = it * 512 + tid, row = id >> 3, ch = id & 7;
                v4u kv = {0u, 0u, 0u, 0u}, vv = {0u, 0u, 0u, 0u};
                if (!(first && row < 128)) { const bf16* src = QKV + (size_t)(row0 - 128 + row) * NQKV + 2048 + kvh * 64 + ch * 8; kv = *(const GAS v4u*)src; vv = *(const GAS v4u*)(src + 256); }
                *(LAS v4u*)(lds + AT_K + row * AT_KP + ch * 16) = kv;
                LAS bf16* vt = (LAS bf16*)(lds + AT_V + (ch * 8) * AT_VP) + row;
                vt[0] = (bf16)(vv.x & 0xffff); vt[AT_VP / 2] = (bf16)(vv.x >> 16); vt[2 * (AT_VP / 2)] = (bf16)(vv.y & 0xffff); vt[3 * (AT_VP / 2)] = (bf16)(vv.y >> 16);
                vt[4 * (AT_VP / 2)] = (bf16)(vv.z & 0xffff); vt[5 * (AT_VP / 2)] = (bf16)(vv.z >> 16); vt[6 * (AT_VP / 2)] = (bf16)(vv.w & 0xffff); vt[7 * (AT_VP / 2)] = (bf16)(vv.w >> 16);
                if (lastb && row >= 128) { const size_t o = ((size_t)(j * NB + b) * KVB + (row - 128)) * 256 + kvh * 64 + ch * 8;
                    *(f32x4*)(out + O_KP + o) = (f32x4){bf_lo(kv.x), bf_hi(kv.x), bf_lo(kv.y), bf_hi(kv.y)}; *(f32x4*)(out + O_KP + o + 4) = (f32x4){bf_lo(kv.z), bf_hi(kv.z), bf_lo(kv.w), bf_hi(kv.w)};
                    *(f32x4*)(out + O_VP + o) = (f32x4){bf_lo(vv.x), bf_hi(vv.x), bf_lo(vv.y), bf_hi(vv.y)}; *(f32x4*)(out + O_VP + o + 4) = (f32x4){bf_lo(vv.z), bf_hi(vv.z), bf_lo(vv.w), bf_hi(vv.w)}; }
            }
        } else {
#pragma unroll
            for (int it = 0; it < 3; ++it) { const int id = it * 512 + tid, row = id >> 3, ch = id & 7;
                if (row < 160) {
                    v4u kv = {0u, 0u, 0u, 0u}, vv = {0u, 0u, 0u, 0u};
                    f32x4 k0 = {0.f, 0.f, 0.f, 0.f}, k1 = k0, v0 = k0, v1 = k0;
                    if (row < 128) { const size_t so = ((size_t)(j * DB + b) * KVB + row) * 256 + kvh * 64 + ch * 8;
                        k0 = *(const f32x4*)(ck + so); k1 = *(const f32x4*)(ck + so + 4); v0 = *(const f32x4*)(cv + so); v1 = *(const f32x4*)(cv + so + 4);
                        kv = (v4u){pk2(k0.x, k0.y), pk2(k0.z, k0.w), pk2(k1.x, k1.y), pk2(k1.z, k1.w)}; vv = (v4u){pk2(v0.x, v0.y), pk2(v0.z, v0.w), pk2(v1.x, v1.y), pk2(v1.z, v1.w)}; }
                    else if (row < 128 + DS) { const bf16* src = QKV + (size_t)(row0 + row - 128) * NQKV + 2048 + kvh * 64 + ch * 8; kv = *(const GAS v4u*)src; vv = *(const GAS v4u*)(src + 256);
                        k0 = (f32x4){bf_lo(kv.x), bf_hi(kv.x), bf_lo(kv.y), bf_hi(kv.y)}; k1 = (f32x4){bf_lo(kv.z), bf_hi(kv.z), bf_lo(kv.w), bf_hi(kv.w)};
                        v0 = (f32x4){bf_lo(vv.x), bf_hi(vv.x), bf_lo(vv.y), bf_hi(vv.y)}; v1 = (f32x4){bf_lo(vv.z), bf_hi(vv.z), bf_lo(vv.w), bf_hi(vv.w)}; }
                    *(LAS v4u*)(lds + AT_K + row * AT_KP + ch * 16) = kv;
                    LAS bf16* vt = (LAS bf16*)(lds + AT_V + (ch * 8) * AT_VP) + row;
                    vt[0] = (bf16)(vv.x & 0xffff); vt[AT_VP / 2] = (bf16)(vv.x >> 16); vt[2 * (AT_VP / 2)] = (bf16)(vv.y & 0xffff); vt[3 * (AT_VP / 2)] = (bf16)(vv.y >> 16);
                    vt[4 * (AT_VP / 2)] = (bf16)(vv.z & 0xffff); vt[5 * (AT_VP / 2)] = (bf16)(vv.z >> 16); vt[6 * (AT_VP / 2)] = (bf16)(vv.w & 0xffff); vt[7 * (AT_VP / 2)] = (bf16)(vv.w >> 16);
                    if (row >= DS && row < 128 + DS) { const size_t o = ((size_t)(j * DB + b) * KVB + (row - DS)) * 256 + kvh * 64 + ch * 8;
                        *(f32x4*)(out + O_KS + o) = k0; *(f32x4*)(out + O_KS + o + 4) = k1; *(f32x4*)(out + O_VS + o) = v0; *(f32x4*)(out + O_VS + o + 4) = v1; }
                }
            }
        }
        LDS_WAIT();
        __syncthreads();
        const int lane = tid & 63, l31 = lane & 31, hi = lane >> 5;
        const int h = kvh * 8 + wave;
        const float sink2 = sinks[j * NHEAD + h] * LOG2E;
        const LAS float* bl = biasL + h * 192 + 160 + l31 - 4 * hi;
        const int nsub = prompt ? 4 : 1;
        for (int sub = 0; sub < nsub; ++sub) {
            const int qrow = prompt ? (row0 + 32 * sub + l31) : (row0 + (l31 & 7));
            bf16x8 qr[4];
#pragma unroll
            for (int k0 = 0; k0 < 4; ++k0) qr[k0] = *(const GAS bf16x8*)(QKV + (size_t)qrow * NQKV + h * 64 + 16 * k0 + 8 * hi);
            f32x16 acc[5];
#pragma unroll
            for (int jt = 0; jt < 5; ++jt) {
                const int T = sub + jt;
                f32x16 c = {0.f, 0.f, 0.f, 0.f, 0.f, 0.f, 0.f, 0.f, 0.f, 0.f, 0.f, 0.f, 0.f, 0.f, 0.f, 0.f};
#pragma unroll
                for (int k0 = 0; k0 < 4; ++k0) { const bf16x8 kf = *(const LAS bf16x8*)(lds + AT_K + (32 * T + l31) * AT_KP + (16 * k0 + 8 * hi) * 2);
                    c = __builtin_amdgcn_mfma_f32_32x32x16_bf16(kf, qr[k0], c, 0, 0, 0); }
                acc[jt] = c;
            }
            float mx = -1e30f;
#pragma unroll
            for (int jt = 0; jt < 5; ++jt) {
                const float tm = (first && (sub + jt) < 4) ? -1e30f : 0.f;
#pragma unroll
                for (int r = 0; r < 16; ++r) { const float s = acc[jt][r] * CS + (bl[-32 * jt - ((r & 3) + 8 * (r >> 2))] + tm); acc[jt][r] = s; mx = fmaxf(mx, s); }
            }
            mx = fmaxf(mx, __shfl_xor(mx, 32));
            mx = fmaxf(mx, sink2);
            float ls = 0.f;
#pragma unroll
            for (int jt = 0; jt < 5; ++jt)
#pragma unroll
                for (int r = 0; r < 16; ++r) { const float p = __builtin_amdgcn_exp2f(acc[jt][r] - mx); acc[jt][r] = p; ls += p; }
            ls += __shfl_xor(ls, 32);
            ls += __builtin_amdgcn_exp2f(sink2 - mx);
            f32x16 o0 = {0.f, 0.f, 0.f, 0.f, 0.f, 0.f, 0.f, 0.f, 0.f, 0.f, 0.f, 0.f, 0.f, 0.f, 0.f, 0.f}, o1 = o0;
#pragma unroll
            for (int jt = 0; jt < 5; ++jt) {
                const int T = sub + jt;
#pragma unroll
                for (int c2 = 0; c2 < 2; ++c2) {
                    v4u pw; pw.x = pk2(acc[jt][8 * c2 + 0], acc[jt][8 * c2 + 1]); pw.y = pk2(acc[jt][8 * c2 + 2], acc[jt][8 * c2 + 3]); pw.z = pk2(acc[jt][8 * c2 + 4], acc[jt][8 * c2 + 5]); pw.w = pk2(acc[jt][8 * c2 + 6], acc[jt][8 * c2 + 7]);
                    const bf16x8 pf = __builtin_bit_cast(bf16x8, pw);
                    const LAS unsigned char* vb = lds + AT_V + l31 * AT_VP + (32 * T + 16 * c2 + 4 * hi) * 2;
                    { const s16x4 lo = *(const LAS s16x4*)vb, hh = *(const LAS s16x4*)(vb + 16); const bf16x8 vf = {lo[0], lo[1], lo[2], lo[3], hh[0], hh[1], hh[2], hh[3]};
                      o0 = __builtin_amdgcn_mfma_f32_32x32x16_bf16(vf, pf, o0, 0, 0, 0); }
                    { const s16x4 lo = *(const LAS s16x4*)(vb + 32 * AT_VP), hh = *(const LAS s16x4*)(vb + 32 * AT_VP + 16); const bf16x8 vf = {lo[0], lo[1], lo[2], lo[3], hh[0], hh[1], hh[2], hh[3]};
                      o1 = __builtin_amdgcn_mfma_f32_32x32x16_bf16(vf, pf, o1, 0, 0, 0); }
                }
            }
            const float inv = 1.0f / ls;
            if (prompt || l31 < DS) {
                bf16* orow = ATT + (size_t)(prompt ? qrow : (row0 + l31)) * D + h * 64 + 4 * hi;
#pragma unroll
                for (int rq = 0; rq < 4; ++rq) {
                    v2u w0; w0.x = pk2(o0[4 * rq] * inv, o0[4 * rq + 1] * inv); w0.y = pk2(o0[4 * rq + 2] * inv, o0[4 * rq + 3] * inv); *(GAS v2u*)(orow + 8 * rq) = w0;
                    v2u w1; w1.x = pk2(o1[4 * rq] * inv, o1[4 * rq + 1] * inv); w1.y = pk2(o1[4 * rq + 2] * inv, o1[4 * rq + 3] * inv); *(GAS v2u*)(orow + 32 + 8 * rq) = w1;
                }
            }
        }
    }
    __syncthreads();
}

__global__ void __launch_bounds__(NWAVES * 64, 2) mega_fwd(Args args) {
    extern __shared__ __attribute__((aligned(16))) unsigned char lds_raw[];
    LAS unsigned char* lds = (LAS unsigned char*)lds_raw;
    const int tid = threadIdx.x, lane = tid & 63, wave = __builtin_amdgcn_readfirstlane(tid >> 6);
    const int G = gridDim.x, bid = blockIdx.x;
    const int vcu = (G % 8 == 0) ? (bid % 8) * (G / 8) + bid / 8 : bid;
    const int gw = vcu * NWAVES + wave, NGW = G * NWAVES;
    CArgs* ap0 = fresh_args();
    for (int u = tid; u < (LDS_BYTES - LDSCTL_OFF) / 4; u += NWAVES * 64) ((LAS unsigned*)(lds + LDSCTL_OFF))[u] = 0u;
    __syncthreads();
    XcdBarrier bar = xcd_barrier_post((unsigned*)(ap0->ws + WS_CTL) + CW_BAR, (volatile LAS unsigned*)(lds + MISC_OFF) + 8);
#define GRID_BAR() xcd_barrier(bar)
#define FRESH_TID() int tid_ = threadIdx.x; asm volatile("" : "+v"(tid_)); const int lane_ = tid_ & 63, wave_ = __builtin_amdgcn_readfirstlane(tid_ >> 6), gw_ = vcu * NWAVES + wave_; (void)lane_; (void)gw_

    prologue(ap0, lds, gw, NGW, wave, lane);
    GRID_BAR();

    for (int hl = 0; hl < 8; ++hl) {
        const int l = hl >> 1, f = hl & 1, j = l >> 1;
        const bool odd = (l & 1) != 0;
        {
            CArgs* ap = fresh_args(); unsigned char* ws = ap->ws;
            const pg8::Gemm g = pg8::plain_gemm((const bf16*)(ws + WS_HB), (const bf16*)(ws + WS_W) + WO_FFNIN + (size_t)hl * SZ_FFNIN, D, D, D); pg8::StaticOrder S; S.init(M, NFF, G, bid);
            pg8::EpiSwiGLU E{(bf16*)(ws + WS_ACT), DFFP};
            pg8::gemm_phase<pg8::EpiSwiGLU, pg8::StaticOrder, true, true>(lds, g, S, E);
        }
        GRID_BAR();
        {
            CArgs* ap = fresh_args(); unsigned char* ws = ap->ws;
            const bf16* Wo_ = (const bf16*)(ws + WS_W) + WO_FFNOUT + (size_t)hl * SZ_FFNOUT;
            { const pg8::Gemm g = pg8::plain_gemm((const bf16*)(ws + WS_ACT), Wo_, DFF, DFFP, DFFP); pg8::StaticOrder S; S.init(MP, D, G, bid);
              pg8::EpiF32 E{(float*)(ws + WS_Y), D};
              pg8::gemm_phase<pg8::EpiF32, pg8::StaticOrder, true, true>(lds, g, S, E); }
            { const pg8::Gemm g{(const bf16*)(ws + WS_ACT) + (size_t)MP * DFFP, Wo_, 256, DFFP, DFFP, 512, 0, (size_t)256 * DFFP * 2, 512}; pg8::StaticOrder S; S.init(NSL_FFN * 256, D, G, bid);
              pg8::EpiF32 E{(float*)(ws + WS_YP), D};
              pg8::gemm_phase<pg8::EpiF32, pg8::StaticOrder, true, true>(lds, g, S, E); }
        }
        GRID_BAR();
        {
            CArgs* ap = fresh_args(); unsigned char* ws = ap->ws; const float* NG = ap->in[6];
            const float* ga = NG + (size_t)(l * 6 + (f ? 5 : 1)) * D;
            const float* gb = f == 0 ? NG + (size_t)(l * 6 + 2) * D : (l < 3 ? NG + (size_t)((l + 1) * 6) * D : nullptr);
            FRESH_TID();
            norm_phase<NSL_FFN>((const float*)(ws + WS_Y), (const float*)(ws + WS_YP), ap->out, (bf16*)(ws + WS_HB), 0.5f, ga, gb, gw_, NGW, lane_);
        }
        GRID_BAR();
        if (f == 0) {
            {
                CArgs* ap = fresh_args(); unsigned char* ws = ap->ws;
                const int N = odd ? NQKV : NMIX; const bf16* W = (const bf16*)(ws + WS_W);
                const pg8::Gemm g = pg8::plain_gemm((const bf16*)(ws + WS_HB), odd ? W + WO_QKV + (size_t)j * SZ_QKV : W + WO_MIXIN + (size_t)j * SZ_MIXIN, D, D, D); pg8::StaticOrder S; S.init(M, N, G, bid);
                pg8::EpiBf16S E{(bf16*)(ws + WS_Z), N, nullptr, 0};
                pg8::gemm_phase<pg8::EpiBf16S, pg8::StaticOrder, true, true>(lds, g, S, E);
            }
            GRID_BAR();
            if (odd) {
                FRESH_TID();
                attention_phase(fresh_args(), lds, j, bid, G, tid_, wave_, lane_);
                GRID_BAR();
            } else {
                { FRESH_TID();
                  convpool_phase(fresh_args(), j, bid, G, tid_); }
                GRID_BAR();
                {
                    CArgs* ap = fresh_args(); unsigned char* ws = ap->ws;
                    const pg8::Gemm g{(const bf16*)(ws + WS_DP), (const bf16*)(ws + WS_W) + WO_POOLW + (size_t)j * SZ_POOLW, 256, DCV, 256, (size_t)256 * DCV * 2, 512, (size_t)256 * 256 * 2, 0}; pg8::StaticOrder S; S.init(M, DCV, G, bid);
                    pg8::EpiBf16S E{(bf16*)(ws + WS_CAT), D, ap->in[12] + (size_t)j * DCV, DCV};
                    pg8::gemm_phase<pg8::EpiBf16S, pg8::StaticOrder, true, true>(lds, g, S, E);
                }
                GRID_BAR();
            }
            {
                CArgs* ap = fresh_args(); unsigned char* ws = ap->ws; const bf16* W = (const bf16*)(ws + WS_W);
                const bf16* Wm = odd ? W + WO_WO + (size_t)j * SZ_WO : W + WO_MIXOUT + (size_t)j * SZ_MIXOUT;
                { const pg8::Gemm g = pg8::plain_gemm((const bf16*)(ws + WS_CAT), Wm, D, D, D); pg8::StaticOrder S; S.init(MP, D, G, bid);
                  pg8::EpiF32 E{(float*)(ws + WS_Y), D};
                  pg8::gemm_phase<pg8::EpiF32, pg8::StaticOrder, true, true>(lds, g, S, E); }
                { const pg8::Gemm g{(const bf16*)(ws + WS_CAT) + (size_t)MP * D, Wm, 256, D, D, 512, 0, (size_t)256 * D * 2, 512}; pg8::StaticOrder S; S.init(NSL_MIX * 256, D, G, bid);
                  pg8::EpiF32 E{(float*)(ws + WS_YP), D};
                  pg8::gemm_phase<pg8::EpiF32, pg8::StaticOrder, true, true>(lds, g, S, E); }
            }
            GRID_BAR();
            {   CArgs* ap = fresh_args(); unsigned char* ws = ap->ws; const float* NG = ap->in[6];
                FRESH_TID();
                norm_phase<NSL_MIX>((const float*)(ws + WS_Y), (const float*)(ws + WS_YP), ap->out, (bf16*)(ws + WS_HB), 1.0f, NG + (size_t)(l * 6 + 3) * D, NG + (size_t)(l * 6 + 4) * D, gw_, NGW, lane_); }
            GRID_BAR();
        }
    }
}

extern "C" void kernel_launch(void* const* d_in, const int* in_sizes, int n_in, void* d_out, int out_size, void* d_ws, size_t ws_size, hipStream_t stream) {
    static int grid = 0;
    if (grid == 0) {
        if (n_in != 18 || out_size != (int)O_END || ws_size < WS_END) { fprintf(stderr, "kernel_launch: unexpected shapes (n_in %d, out %d, ws %zu; need ws >= %zu)\n", n_in, out_size, ws_size, (size_t)WS_END); grid = -1; return; }
        int dev = 0, cus = 0, per_cu = 0;
        if (hipGetDevice(&dev) != hipSuccess || hipDeviceGetAttribute(&cus, hipDeviceAttributeMultiprocessorCount, dev) != hipSuccess) { grid = -1; return; }
        if (hipFuncSetAttribute((const void*)mega_fwd, hipFuncAttributeMaxDynamicSharedMemorySize, LDS_BYTES) != hipSuccess) { fprintf(stderr, "kernel_launch: hipFuncSetAttribute failed\n"); grid = -1; return; }
        if (hipOccupancyMaxActiveBlocksPerMultiprocessor(&per_cu, (const void*)mega_fwd, NWAVES * 64, LDS_BYTES) != hipSuccess || per_cu < 1)
            fprintf(stderr, "kernel_launch: occupancy query reports %d\n", per_cu);
        (void)hipGetLastError();
        grid = cus;
    }
    if (grid < 0) return;
    if (hipMemsetAsync((char*)d_ws + WS_CTL, 0, CTL_ZERO_BYTES, stream) != hipSuccess) return;
    Args a{};
    for (int i = 0; i < 18; ++i) a.in[i] = (const float*)d_in[i];
    a.out = (float*)d_out; a.ws = (unsigned char*)d_ws;
    hipLaunchKernelGGL(mega_fwd, dim3(grid), dim3(NWAVES * 64), LDS_BYTES, stream, a);
}
```

```cpp
#include <hip/hip_runtime.h>
#include <cstdio>
#include <cstdint>

#define LAS __attribute__((address_space(3)))
#define GAS __attribute__((address_space(1)))

namespace pg8 {
typedef unsigned short bf16_t;
typedef short bf16x8 __attribute__((ext_vector_type(8)));
typedef float f32x4 __attribute__((ext_vector_type(4)));
typedef float f32x2 __attribute__((ext_vector_type(2)));
typedef unsigned u32x4 __attribute__((ext_vector_type(4)));
constexpr int BM = 256, BK = 64, HALF = 128, HTB = HALF * BK * 2, STAGE_BYTES = 8 * HTB, NXCD = 8, WGM = 8;

__host__ __device__ __forceinline__ int lds_byte(int r, int c) { const int st = (r >> 4) * 2 + (c >> 5), rr = r & 15, cc = c & 31, ob = rr * 64 + cc * 2; return st * 1024 + (ob ^ (((ob >> 9) & 1) << 5)); }
__host__ __device__ __forceinline__ void stage_rc(int b, int& R, int& C) { const int st = b / 1024, sb = b % 1024, swz = sb ^ (((sb >> 9) & 1) << 5); R = (st >> 1) * 16 + swz / 64; C = (st & 1) * 32 + (swz % 64) / 2; }
__host__ __device__ __forceinline__ int perm32(int rho) { const int n = rho >> 4, i = rho & 15; return 8 * (i >> 2) + 4 * n + (i & 3); }

struct Unit { int pm, pn; };
struct Gemm { const bf16_t* A; const bf16_t* Bt; int K, lda, ldb; size_t a_pm, a_pn, b_pn, b_pm; };
__device__ __forceinline__ Gemm plain_gemm(const bf16_t* A, const bf16_t* Bt, int K, int lda, int ldb) { return Gemm{A, Bt, K, lda, ldb, (size_t)BM * lda * 2, 0, (size_t)BM * ldb * 2, 0}; }

struct StaticOrder {
    int nM, nN, nwg, G, c;
    __host__ __device__ void init(int M, int N, int G_, int c_) { nM = M / BM; nN = N / BM; nwg = nM * nN; G = G_; c = c_; }
    __host__ __device__ bool next(int i, Unit& u) const {
        const long L = (long)i * G + c; if (L >= nwg) return false;
        int wgid = (int)L; { const int q = nwg / NXCD, r = nwg % NXCD, xcd = wgid % NXCD, off = wgid / NXCD; wgid = (xcd < r ? xcd * (q + 1) : r * (q + 1) + (xcd - r) * q) + off; }
        const int nig = WGM * nN, gid = wgid / nig, fm = gid * WGM, gsz = (nM - fm) < WGM ? (nM - fm) : WGM;
        u.pm = fm + ((wgid % nig) % gsz); u.pn = (wgid % nig) / gsz; return true;
    }
    __device__ __forceinline__ void a_ready(const Unit&) const {}
    __device__ __forceinline__ void done(const Unit&) const {}
};

__device__ __forceinline__ unsigned cvt_pk_bf16(float lo, float hi) { unsigned r; asm volatile("v_cvt_pk_bf16_f32 %0, %1, %2" : "=v"(r) : "v"(lo), "v"(hi)); return r; }

struct EpiF32 {
    static constexpr bool PERM = false, AFTER_DRAIN = false;
    float* C; int ldc;
    __device__ __forceinline__ void operator()(const f32x4 (&acc)[2][2][4][2], const Unit& u, int wr, int wc, int fr, int fq) const {
        const int row0 = u.pm * BM + wr * 64 + fr, col0 = u.pn * BM + wc * 32 + 4 * fq;
#pragma unroll
        for (int ai = 0; ai < 2; ++ai)
#pragma unroll
            for (int m = 0; m < 4; ++m) { float* rowp = C + (size_t)(row0 + ai * HALF + m * 16) * ldc + col0;
#pragma unroll
                for (int bj = 0; bj < 2; ++bj)
#pragma unroll
                    for (int n = 0; n < 2; ++n) *(f32x4*)(rowp + bj * HALF + n * 16) = acc[ai][bj][m][n]; }
    }
};
struct EpiBf16S {
    static constexpr bool PERM = true, AFTER_DRAIN = false;
    bf16_t* O; int ldc; const float* scale; int col_off;
    __device__ __forceinline__ void operator()(const f32x4 (&acc)[2][2][4][2], const Unit& u, int wr, int wc, int fr, int fq) const {
        const int row0 = u.pm * BM + wr * 64 + fr; const int col0 = u.pn * BM + wc * 32 + 8 * fq;
        f32x4 sv[2][2];
#pragma unroll
        for (int bj = 0; bj < 2; ++bj)
#pragma unroll
            for (int n = 0; n < 2; ++n) sv[bj][n] = scale ? *(const f32x4*)(scale + col0 + bj * HALF + 4 * n) : (f32x4){1.f, 1.f, 1.f, 1.f};
#pragma unroll
        for (int ai = 0; ai < 2; ++ai)
#pragma unroll
            for (int m = 0; m < 4; ++m) { bf16_t* rowp = O + (size_t)(row0 + ai * HALF + m * 16) * ldc + col_off + col0;
#pragma unroll
                for (int bj = 0; bj < 2; ++bj) { const f32x4 v0 = acc[ai][bj][m][0] * sv[bj][0], v1 = acc[ai][bj][m][1] * sv[bj][1];
                    u32x4 w; w.x = cvt_pk_bf16(v0[0], v0[1]); w.y = cvt_pk_bf16(v0[2], v0[3]); w.z = cvt_pk_bf16(v1[0], v1[1]); w.w = cvt_pk_bf16(v1[2], v1[3]);
                    *(u32x4*)(rowp + bj * HALF) = w; } }
    }
};
__device__ __forceinline__ float silu_mul(float g, float u) { const float e = __builtin_amdgcn_exp2f(g * -1.44269504089f); return g * __builtin_amdgcn_rcpf(1.0f + e) * u; }
struct EpiSwiGLU {
    static constexpr bool PERM = true, AFTER_DRAIN = false;
    bf16_t* O; int ldc;
    __device__ __forceinline__ void operator()(const f32x4 (&acc)[2][2][4][2], const Unit& u, int wr, int wc, int fr, int fq) const {
        const int row0 = u.pm * BM + wr * 64 + fr; const int col0 = u.pn * HALF + wc * 32 + 8 * fq;
#pragma unroll
        for (int ai = 0; ai < 2; ++ai)
#pragma unroll
            for (int m = 0; m < 4; ++m) { bf16_t* rowp = O + (size_t)(row0 + ai * HALF + m * 16) * ldc + col0;
                const f32x4 g0 = acc[ai][0][m][0], g1 = acc[ai][0][m][1], u0 = acc[ai][1][m][0], u1 = acc[ai][1][m][1];
                u32x4 w; w.x = cvt_pk_bf16(silu_mul(g0[0], u0[0]), silu_mul(g0[1], u0[1])); w.y = cvt_pk_bf16(silu_mul(g0[2], u0[2]), silu_mul(g0[3], u0[3]));
                w.z = cvt_pk_bf16(silu_mul(g1[0], u1[0]), silu_mul(g1[1], u1[1])); w.w = cvt_pk_bf16(silu_mul(g1[2], u1[2]), silu_mul(g1[3], u1[3]));
                *(u32x4*)rowp = w; }
    }
};

template <class Epi, class Sched, bool ALIGN_EPI = false, bool SP2 = false>
__device__ __forceinline__ void gemm_phase(LAS unsigned char* lds, const Gemm g, const Sched& S, const Epi& E) {
    int tid = threadIdx.x; asm volatile("" : "+v"(tid));
    const int wid = __builtin_amdgcn_readfirstlane(tid >> 6), lane = tid & 63, wr = wid >> 2, wc = wid & 3, fr = lane & 15, fq = lane >> 4;
    const int K = g.K, nt = K / BK;
    unsigned voffA[2], voffB[2];
#pragma unroll
    for (int i = 0; i < 2; ++i) { int R, C; stage_rc(tid * 16 + i * 8192, R, C); const int Rb = Epi::PERM ? ((R & ~31) + perm32(R & 31)) : R;
        voffA[i] = (unsigned)(R * g.lda + C) * 2u; voffB[i] = (unsigned)(Rb * g.ldb + C) * 2u; }
    const size_t kstep = (size_t)(BK * 2);
    const size_t hstepA = (size_t)HALF * g.lda * 2, hstepB = (size_t)HALF * g.ldb * 2;
    const unsigned ldsw = (unsigned)wid * 1024u;
    const int aoff = lds_byte(wr * 64 + fr, fq * 8), boff = lds_byte(wc * 32 + fr, fq * 8);
#define PG8_SA(b, h) (((b) * 2 + (h)) * HTB)
#define PG8_SB(b, h) ((4 + (b) * 2 + (h)) * HTB)
#define PG8_STAGE(bufoff, gbase, voff) do { _Pragma("unroll") for (int _i = 0; _i < 2; ++_i) \
        __builtin_amdgcn_global_load_lds((const unsigned*)((const char*)(gbase) + (voff)[_i]), (LAS unsigned*)(lds + (bufoff) + ldsw + _i * 8192), 16, 0, 0); } while (0)
#define PG8_LDA(dst, b, h) do { _Pragma("unroll") for (int m = 0; m < 4; ++m) _Pragma("unroll") for (int k = 0; k < 2; ++k) dst[m][k] = *(const LAS bf16x8*)(lds + PG8_SA(b, h) + aoff + m * 2048 + k * 1024); } while (0)
#define PG8_LDB(dst, b, h) do { _Pragma("unroll") for (int n = 0; n < 2; ++n) _Pragma("unroll") for (int k = 0; k < 2; ++k) dst[n][k] = *(const LAS bf16x8*)(lds + PG8_SB(b, h) + boff + n * 2048 + k * 1024); } while (0)
#define PG8_MMA(ai, bj, At, Bt) do { __builtin_amdgcn_s_setprio(1); _Pragma("unroll") for (int m = 0; m < 4; ++m) _Pragma("unroll") for (int n = 0; n < 2; ++n) _Pragma("unroll") for (int k = 0; k < 2; ++k) \
        acc[ai][bj][m][n] = __builtin_amdgcn_mfma_f32_16x16x32_bf16(Bt[n][k], At[m][k], acc[ai][bj][m][n], 0, 0, 0); __builtin_amdgcn_s_setprio(0); } while (0)
#define PG8_WAIT_V(n) asm volatile("s_waitcnt vmcnt(" #n ")" ::: "memory")
#define PG8_WAIT_L(n) asm volatile("s_waitcnt lgkmcnt(" #n ")" ::: "memory")
#define PG8_BAR __builtin_amdgcn_s_barrier()
#define PG8_SCHED __builtin_amdgcn_sched_barrier(0)
    Unit cur, nxt; int ui = 0;
    if (!S.next(0, cur)) return;
    f32x4 acc[2][2][4][2];
#pragma unroll
    for (int a = 0; a < 2; ++a)
#pragma unroll
        for (int b = 0; b < 2; ++b)
#pragma unroll
            for (int m = 0; m < 4; ++m)
#pragma unroll
                for (int n = 0; n < 2; ++n) acc[a][b][m][n] = (f32x4){0.f, 0.f, 0.f, 0.f};
    bf16x8 At[4][2], B0[2][2], B1[2][2];
    const char* cA = (const char*)g.A + (size_t)cur.pm * g.a_pm + (size_t)cur.pn * g.a_pn; const char* cB = (const char*)g.Bt + (size_t)cur.pn * g.b_pn + (size_t)cur.pm * g.b_pm;
    S.a_ready(cur);
    if constexpr (SP2) {
        PG8_STAGE(PG8_SB(0, 0), cB, voffB); PG8_STAGE(PG8_SB(0, 1), cB + hstepB, voffB); PG8_STAGE(PG8_SA(0, 0), cA, voffA); PG8_STAGE(PG8_SA(0, 1), cA + hstepA, voffA);
        if (wr == 1) PG8_BAR;
        PG8_WAIT_V(2); PG8_BAR;
        PG8_STAGE(PG8_SB(1, 0), cB + kstep, voffB); PG8_STAGE(PG8_SA(1, 0), cA + kstep, voffA); PG8_STAGE(PG8_SB(1, 1), cB + hstepB + kstep, voffB);
        PG8_WAIT_V(6); PG8_BAR;
    } else {
        PG8_STAGE(PG8_SB(0, 0), cB, voffB); PG8_STAGE(PG8_SA(0, 0), cA, voffA); PG8_STAGE(PG8_SB(0, 1), cB + hstepB, voffB); PG8_STAGE(PG8_SA(0, 1), cA + hstepA, voffA);
        if (wr == 1) PG8_BAR;
        PG8_WAIT_V(4); PG8_BAR;
        PG8_STAGE(PG8_SB(1, 0), cB + kstep, voffB); PG8_STAGE(PG8_SA(1, 0), cA + kstep, voffA); PG8_STAGE(PG8_SB(1, 1), cB + hstepB + kstep, voffB);
        PG8_WAIT_V(6); PG8_BAR;
    }
    for (;;) {
        const bool has_next = S.next(ui + 1, nxt);
        const char* nA = has_next ? (const char*)g.A + (size_t)nxt.pm * g.a_pm + (size_t)nxt.pn * g.a_pn : cA; const char* nB = has_next ? (const char*)g.Bt + (size_t)nxt.pn * g.b_pn + (size_t)nxt.pm * g.b_pm : cB;
        for (int t = 0; t < nt; t += 2) {
            const bool last = (t == nt - 2);
            const char* a1 = cA + (size_t)(t + 1) * kstep;
            const char* a2 = last ? nA : cA + (size_t)(t + 2) * kstep; const char* b2 = last ? nB : cB + (size_t)(t + 2) * kstep;
            const char* a3 = a2 + kstep; const char* b3 = b2 + kstep;
            if (last && has_next) S.a_ready(nxt);
            if constexpr (SP2) {
            PG8_LDB(B0, 0, 0); PG8_LDB(B1, 0, 1); PG8_SCHED; PG8_LDA(At, 0, 0); PG8_STAGE(PG8_SA(1, 1), a1 + hstepA, voffA);
            PG8_WAIT_V(8); PG8_WAIT_L(0); PG8_BAR; PG8_MMA(0, 0, At, B0); PG8_MMA(0, 1, At, B1); PG8_BAR; PG8_SCHED;
            PG8_LDA(At, 0, 1); PG8_STAGE(PG8_SB(0, 0), b2, voffB); PG8_STAGE(PG8_SB(0, 1), b2 + hstepB, voffB); PG8_STAGE(PG8_SA(0, 0), a2, voffA);
            PG8_WAIT_V(8); PG8_WAIT_L(0); PG8_BAR; PG8_MMA(1, 0, At, B0); PG8_MMA(1, 1, At, B1); PG8_BAR; PG8_SCHED;
            PG8_LDB(B0, 1, 0); PG8_LDB(B1, 1, 1); PG8_SCHED; PG8_LDA(At, 1, 0); PG8_STAGE(PG8_SA(0, 1), a2 + hstepA, voffA);
            PG8_WAIT_V(8); PG8_WAIT_L(0); PG8_BAR; PG8_MMA(0, 0, At, B0); PG8_MMA(0, 1, At, B1); PG8_BAR; PG8_SCHED;
            PG8_LDA(At, 1, 1); PG8_STAGE(PG8_SB(1, 0), b3, voffB); PG8_STAGE(PG8_SB(1, 1), b3 + hstepB, voffB); PG8_STAGE(PG8_SA(1, 0), a3, voffA);
            PG8_WAIT_V(8); PG8_WAIT_L(0); PG8_BAR; PG8_MMA(1, 0, At, B0); PG8_MMA(1, 1, At, B1); PG8_BAR; PG8_SCHED;
            } else {
            PG8_LDB(B0, 0, 0); PG8_SCHED; PG8_LDA(At, 0, 0); PG8_STAGE(PG8_SA(1, 1), a1 + hstepA, voffA);
            PG8_WAIT_L(8); PG8_BAR; PG8_WAIT_L(0); PG8_MMA(0, 0, At, B0); PG8_BAR; PG8_SCHED;
            PG8_LDB(B1, 0, 1); PG8_STAGE(PG8_SB(0, 0), b2, voffB);
            PG8_BAR; PG8_WAIT_L(0); PG8_MMA(0, 1, At, B1); PG8_BAR;
            PG8_LDA(At, 0, 1); PG8_STAGE(PG8_SA(0, 0), a2, voffA);
            PG8_BAR; PG8_WAIT_L(0); PG8_MMA(1, 0, At, B0); PG8_BAR; PG8_SCHED;
            PG8_STAGE(PG8_SB(0, 1), b2 + hstepB, voffB);
            PG8_WAIT_V(6); PG8_BAR; PG8_MMA(1, 1, At, B1); PG8_BAR;
            PG8_LDB(B0, 1, 0); PG8_SCHED; PG8_LDA(At, 1, 0); PG8_STAGE(PG8_SA(0, 1), a2 + hstepA, voffA);
            PG8_WAIT_L(8); PG8_BAR; PG8_WAIT_L(0); PG8_MMA(0, 0, At, B0); PG8_BAR; PG8_SCHED;
            PG8_LDB(B1, 1, 1); PG8_STAGE(PG8_SB(1, 0), b3, voffB);
            PG8_BAR; PG8_WAIT_L(0); PG8_MMA(0, 1, At, B1); PG8_BAR;
            PG8_LDA(At, 1, 1); PG8_STAGE(PG8_SA(1, 0), a3, voffA);
            PG8_BAR; PG8_WAIT_L(0); PG8_MMA(1, 0, At, B0); PG8_BAR; PG8_SCHED;
            PG8_STAGE(PG8_SB(1, 1), b3 + hstepB, voffB);
            PG8_WAIT_V(6); PG8_BAR; PG8_MMA(1, 1, At, B1); PG8_BAR;
            }
        }
        if constexpr (ALIGN_EPI) { if (wr == 0) PG8_BAR; }
        if constexpr (!Epi::AFTER_DRAIN) { E(acc, cur, wr, wc, fr, fq); S.done(cur); }
        if (!has_next) break;
#pragma unroll
        for (int a = 0; a < 2; ++a)
#pragma unroll
            for (int b = 0; b < 2; ++b)
#pragma unroll
                for (int m = 0; m < 4; ++m)
#pragma unroll
                    for (int n = 0; n < 2; ++n) acc[a][b][m][n] = (f32x4){0.f, 0.f, 0.f, 0.f};
        cur = nxt; cA = nA; cB = nB; ++ui;
        if constexpr (ALIGN_EPI) { if (wr == 1) PG8_BAR; }
    }
    PG8_WAIT_V(0);
    if constexpr (!ALIGN_EPI) { if (wr == 0) PG8_BAR; }
    PG8_BAR;
#undef PG8_SA
#undef PG8_SB
#undef PG8_STAGE
#undef PG8_LDA
#undef PG8_LDB
#undef PG8_MMA
#undef PG8_WAIT_V
#undef PG8_WAIT_L
#undef PG8_BAR
#undef PG8_SCHED
}
}

typedef unsigned short bf16;
typedef unsigned v4u __attribute__((ext_vector_type(4)));
typedef unsigned v2u __attribute__((ext_vector_type(2)));
typedef float f32x4 __attribute__((ext_vector_type(4)));
typedef float f32x2 __attribute__((ext_vector_type(2)));
typedef float f32x16 __attribute__((ext_vector_type(16)));
typedef short bf16x8 __attribute__((ext_vector_type(8)));
typedef short s16x4 __attribute__((ext_vector_type(4)));

constexpr int NWAVES = 8;
constexpr int CONV_PER_IDLE_WAVE = 6;
constexpr int D = 2048, MP = 8192, MS = 256, M = MP + MS, DFF = 5504, NFF = 2 * DFF, NMIX = 4096, NQKV = 2560, DCV = 1024;
constexpr int DFFP = 5632;
constexpr int NSL_FFN = DFFP / 256, NSL_MIX = D / 256;
constexpr int SEQ = 2048, NB = 4, DB = 32, DS = 8, NHEAD = 32, NKVH = 4, HD = 64, KVB = 128, PCTX = 15;
constexpr float EPS = 1e-6f;
constexpr float LOG2E = 1.4426950408889634f;

constexpr size_t O_Y = 0, O_CONVP = (size_t)M * D, O_POOLP = O_CONVP + 2 * NB * 2 * DCV, O_KP = O_POOLP + 2 * NB * PCTX * DCV, O_VP = O_KP + 2 * NB * KVB * 256,
                 O_CONVS = O_VP + 2 * NB * KVB * 256, O_POOLS = O_CONVS + 2 * DB * 2 * DCV, O_KS = O_POOLS + 2 * DB * PCTX * DCV, O_VS = O_KS + 2 * DB * KVB * 256, O_END = O_VS + 2 * DB * KVB * 256;
static_assert(O_END == 23273472, "output size");

constexpr size_t MiB = 1u << 20;
constexpr size_t WS_CTL = 0, CTL_ZERO_BYTES = 1 * MiB;
constexpr size_t WS_HB = 2 * MiB;
constexpr size_t WS_ACT = 36 * MiB;
constexpr size_t WS_Y = 128 * MiB;
constexpr size_t WS_Z = 194 * MiB;
constexpr size_t WS_CAT = 260 * MiB;
constexpr size_t WS_DP = 294 * MiB;
constexpr size_t WS_YP = 312 * MiB;
constexpr size_t WS_W = 360 * MiB;
constexpr size_t SZ_FFNIN = (size_t)NFF * D, SZ_FFNOUT = (size_t)D * DFFP, SZ_MIXIN = (size_t)NMIX * D, SZ_MIXOUT = (size_t)D * D, SZ_QKV = (size_t)NQKV * D, SZ_WO = (size_t)D * D, SZ_POOLW = 4 * 256 * 256;
constexpr size_t WO_FFNIN = 0, WO_FFNOUT = WO_FFNIN + 8 * SZ_FFNIN, WO_MIXIN = WO_FFNOUT + 8 * SZ_FFNOUT, WO_MIXOUT = WO_MIXIN + 2 * SZ_MIXIN, WO_QKV = WO_MIXOUT + 2 * SZ_MIXOUT,
                 WO_WO = WO_QKV + 2 * SZ_QKV, WO_POOLW = WO_WO + 2 * SZ_WO, WO_END = WO_POOLW + 2 * SZ_POOLW;
constexpr size_t WS_END = WS_W + WO_END * 2;
static_assert(WS_HB + (size_t)M * D * 2 <= WS_ACT && WS_ACT + (size_t)M * DFFP * 2 <= WS_Y && WS_Y + (size_t)M * D * 4 <= WS_Z && WS_Z + (size_t)M * NMIX * 2 <= WS_CAT && WS_CAT + (size_t)M * D * 2 <= WS_DP && WS_DP + (size_t)M * DCV * 2 <= WS_YP && WS_YP + (size_t)NSL_FFN * 256 * D * 4 <= WS_W, "ws map");
constexpr int CW_BAR = 4096;

constexpr int RING_BYTES = 135168;
constexpr int LDSCTL_OFF = RING_BYTES, MISC_OFF = LDSCTL_OFF + 320;
constexpr int LDS_BYTES = 147456;
static_assert(MISC_OFF + 128 <= LDS_BYTES, "LDS map");

#define LDS_WAIT() asm volatile("s_waitcnt lgkmcnt(0)" ::: "memory")
#define VM_WAIT() asm volatile("s_waitcnt vmcnt(0)" ::: "memory")
__device__ __forceinline__ unsigned f2bf(float f) { unsigned u = __builtin_bit_cast(unsigned, f); return (u + 0x7fffu + ((u >> 16) & 1u)) >> 16; }
__device__ __forceinline__ unsigned pk2(float lo, float hi) { return f2bf(lo) | (f2bf(hi) << 16); }
__device__ __forceinline__ float bf_lo(unsigned w) { return __builtin_bit_cast(float, w << 16); }
__device__ __forceinline__ float bf_hi(unsigned w) { return __builtin_bit_cast(float, w & 0xffff0000u); }

#define XB_TMO      128
#define XB_XCNT(j)  (256  + 64 * (j))
#define XB_XSUB(j)  (1280 + 64 * (j))
#define XB_XGEN(j)  (2304 + 64 * (j))
#define XB_TOP      3328
#define XB_TOPGEN   3392
#define XCD_BAR_WORDS 3456
#define XB_SPIN_CAP (1u << 18)
__device__ __forceinline__ unsigned xb_ld(unsigned* p)              { return __hip_atomic_load(p, __ATOMIC_RELAXED, __HIP_MEMORY_SCOPE_AGENT); }
__device__ __forceinline__ unsigned xb_add(unsigned* p, unsigned v) { return __hip_atomic_fetch_add(p, v, __ATOMIC_RELAXED, __HIP_MEMORY_SCOPE_AGENT); }
__device__ __forceinline__ unsigned xb_xcc_id() { return (unsigned)__builtin_amdgcn_s_getreg((3 << 11) | 20) & 0xFu; }
#define XB_SPIN(cond, bar) do { unsigned _sp = 0; while (cond) { __builtin_amdgcn_s_sleep(1); \
    if ((++_sp & 255u) == 0u) { if (xb_ld(&(bar)[XB_TMO])) break; if (_sp > XB_SPIN_CAP) { atomicAdd(&(bar)[XB_TMO], 1u); break; } } } } while (0)
struct XcdBarrier { unsigned* bar; unsigned x; volatile LAS unsigned* st; };
__device__ __forceinline__ XcdBarrier xcd_barrier_post(unsigned* bar, volatile LAS unsigned* st) {
    XcdBarrier b; b.bar = bar; b.x = xb_xcc_id(); b.st = st;
    if (threadIdx.x == 0) (void)xb_add(&bar[XB_XCNT(b.x)], 1u);
    return b;
}
__device__ __forceinline__ void xcd_barrier_complete(unsigned* bar, unsigned x, unsigned& nloc, unsigned& nx) {
    const unsigned G = gridDim.x * gridDim.y * gridDim.z;
    unsigned sum, cnt, mine, sp = 0u;
    for (;;) {
        sum = 0u; cnt = 0u; mine = 0u;
#pragma unroll
        for (unsigned j = 0; j < 16; ++j) { const unsigned c = xb_ld(&bar[XB_XCNT(j)]); sum += c; cnt += (c > 0u) ? 1u : 0u; mine = (j == x) ? c : mine; }
        if (sum == G) break;
        __builtin_amdgcn_s_sleep(1);
        if ((++sp & 255u) == 0u) { if (xb_ld(&bar[XB_TMO])) break; if (sp > XB_SPIN_CAP) { atomicAdd(&bar[XB_TMO], 1u); break; } }
    }
    nloc = mine > 0u ? mine : 1u; nx = cnt > 0u ? cnt : 1u;
}
__device__ __forceinline__ void xcd_barrier(const XcdBarrier& b) {
    asm volatile("s_waitcnt vmcnt(0)" ::: "memory");
    __syncthreads();
    if (threadIdx.x == 0) {
        unsigned* bar = b.bar; asm volatile("" : "+s"(bar));
        __builtin_amdgcn_s_waitcnt(0);
        unsigned nloc = b.st[0], nx = b.st[1];
        const unsigned bx = xb_xcc_id();
        if (nloc == 0u) { xcd_barrier_complete(bar, bx, nloc, nx); b.st[0] = nloc; b.st[1] = nx; }
        const unsigned old = xb_add(&bar[XB_XSUB(bx)], 1u);
        const unsigned gen = old / nloc;
        if (old + 1u == (gen + 1u) * nloc) {
            __builtin_amdgcn_fence(__ATOMIC_RELEASE, "agent");
            asm volatile("s_waitcnt vmcnt(0)" ::: "memory");
            const unsigned og = xb_add(&bar[XB_TOP], 1u);
            const unsigned tg = og / nx;
            if (og + 1u == (tg + 1u) * nx) xb_add(&bar[XB_TOPGEN], 1u);
            else XB_SPIN(xb_ld(&bar[XB_TOPGEN]) == tg, bar);
            __builtin_amdgcn_fence(__ATOMIC_ACQUIRE, "agent");
            xb_add(&bar[XB_XGEN(bx)], 1u);
            asm volatile("s_waitcnt vmcnt(0)" ::: "memory");
        } else {
            XB_SPIN(xb_ld(&bar[XB_XGEN(bx)]) == gen, bar);
            __builtin_amdgcn_fence(__ATOMIC_ACQUIRE, "agent");
            asm volatile("s_waitcnt vmcnt(0)" ::: "memory");
        }
    }
    __syncthreads();
}

__device__ __forceinline__ float wave_sum(float v) {
#pragma unroll
    for (int o = 1; o < 64; o <<= 1) v += __shfl_xor(v, o);
    return v;
}

__device__ __forceinline__ void tr_item(const float* __restrict__ src, int sld, bf16* __restrict__ dst, int K  , int k0, LAS float* scr, int lane) {
    const GAS float* s = (const GAS float*)src + (size_t)(k0 + (lane >> 4)) * sld + (lane & 15) * 4;
    f32x4 v[16];
#pragma unroll
    for (int it = 0; it < 16; ++it) v[it] = *(const GAS f32x4*)(s + (size_t)(4 * it) * sld);
#pragma unroll
    for (int it = 0; it < 16; ++it) { LAS float* w = scr + ((lane >> 4) + 4 * it) * 65 + (lane & 15) * 4; w[0] = v[it].x; w[1] = v[it].y; w[2] = v[it].z; w[3] = v[it].w; }
    LDS_WAIT(); asm volatile("" ::: "memory");
    const int c = lane >> 3, n1 = lane & 7;
#pragma unroll
    for (int jj = 0; jj < 8; ++jj) { const int n = n1 + 8 * jj; const LAS float* r = scr + (8 * c) * 65 + n;
        v4u o; o.x = pk2(r[0], r[65]); o.y = pk2(r[2 * 65], r[3 * 65]); o.z = pk2(r[4 * 65], r[5 * 65]); o.w = pk2(r[6 * 65], r[7 * 65]);
        *(GAS v4u*)(dst + (size_t)n * K + k0 + 8 * c) = o; }
    LDS_WAIT(); asm volatile("" ::: "memory");
}

struct Args { const float* in[18]; float* out; unsigned char* ws; };
typedef const __attribute__((address_space(4))) Args CArgs;
__device__ __forceinline__ CArgs* fresh_args() { CArgs* p = (CArgs*)__builtin_amdgcn_kernarg_segment_ptr(); asm volatile("" : "+s"(p)); return p; }

constexpr int CI_FFNIN = (D / 64) * (NFF / 64), CI_FFNOUT = (DFF / 64) * (D / 64), CI_MIXIN = (D / 64) * (NMIX / 64), CI_QKV = (D / 64) * (NQKV / 64), CI_SQ = (D / 64) * (D / 64), CI_POOLW = 4 * 16;
constexpr int CI_EVEN = 2 * (CI_FFNIN + CI_FFNOUT) + CI_MIXIN + CI_POOLW + CI_SQ, CI_ODD = 2 * (CI_FFNIN + CI_FFNOUT) + CI_QKV + CI_SQ, CI_PAIR = CI_EVEN + CI_ODD, IT_TOTAL = 2 * CI_PAIR;
__device__ __forceinline__ int conv_seg_start(int l, int seg) {
    const int odd = l & 1; int o = (l >> 1) * CI_PAIR + (odd ? CI_EVEN : 0);
    const int sz[7] = {CI_FFNIN, CI_FFNOUT, odd ? CI_QKV : CI_MIXIN, odd ? 0 : CI_POOLW, CI_SQ, CI_FFNIN, CI_FFNOUT};
#pragma unroll
    for (int i = 0; i < 7; ++i) o += (i < seg) ? sz[i] : 0;
    return o;
}
__device__ __forceinline__ void conv_item(CArgs* ap, int it, LAS float* scr, int lane) {
    bf16* W = (bf16*)(ap->ws + WS_W);
    int l = 2 * (it / CI_PAIR), r = it % CI_PAIR; if (r >= CI_EVEN) { r -= CI_EVEN; l += 1; }
    const int odd = l & 1, j = l >> 1;
    int hl = 2 * l, kind;
    if (r < CI_FFNIN) kind = 0;
    else if ((r -= CI_FFNIN) < CI_FFNOUT) kind = 1;
    else if ((r -= CI_FFNOUT) < (odd ? CI_QKV : CI_MIXIN)) kind = odd ? 3 : 2;
    else if ((r -= (odd ? CI_QKV : CI_MIXIN)) < (odd ? 0 : CI_POOLW)) kind = 4;
    else if ((r -= (odd ? 0 : CI_POOLW)) < CI_SQ) kind = odd ? 6 : 5;
    else if ((r -= CI_SQ) < CI_FFNIN) { kind = 0; hl += 1; }
    else { r -= CI_FFNIN; kind = 1; hl += 1; }
    if (kind == 0) { constexpr int nbn = NFF / 64; const int kb = r / nbn, nb = r % nbn;
        const int n0 = nb * 64, tile = n0 >> 8, w = n0 & 255, scol = (w < 128) ? tile * 128 + w : DFF + tile * 128 + (w - 128);
        tr_item(ap->in[7] + (size_t)hl * D * NFF + scol, NFF, W + WO_FFNIN + (size_t)hl * SZ_FFNIN + (size_t)n0 * D, D, kb * 64, scr, lane); }
    else if (kind == 1) { constexpr int nbn = D / 64; const int kb = r / nbn, nb = r % nbn;
        tr_item(ap->in[8] + (size_t)hl * DFF * D + nb * 64, D, W + WO_FFNOUT + (size_t)hl * SZ_FFNOUT + (size_t)(nb * 64) * DFFP, DFFP, kb * 64, scr, lane); }
    else if (kind == 2) { constexpr int nbn = NMIX / 64; const int kb = r / nbn, nb = r % nbn;
        tr_item(ap->in[9] + (size_t)j * D * NMIX + nb * 64, NMIX, W + WO_MIXIN + (size_t)j * SZ_MIXIN + (size_t)(nb * 64) * D, D, kb * 64, scr, lane); }
    else if (kind == 3) { constexpr int nbn = NQKV / 64; const int kb = r / nbn, nb = r % nbn;
        tr_item(ap->in[14] + (size_t)j * D * NQKV + nb * 64, NQKV, W + WO_QKV + (size_t)j * SZ_QKV + (size_t)(nb * 64) * D, D, kb * 64, scr, lane); }
    else if (kind == 4) { const int mat = j * 4 + (r >> 4), rr = r & 15, kb = rr >> 2, nb = rr & 3;
        tr_item(ap->in[11] + (size_t)mat * 65536 + nb * 64, 256, W + WO_POOLW + (size_t)mat * 65536 + (size_t)(nb * 64) * 256, 256, kb * 64, scr, lane); }
    else { constexpr int nbn = D / 64; const int kb = r / nbn, nb = r % nbn;
        if (kind == 5) tr_item(ap->in[13] + (size_t)j * D * D + nb * 64, D, W + WO_MIXOUT + (size_t)j * SZ_MIXOUT + (size_t)(nb * 64) * D, D, kb * 64, scr, lane);
        else tr_item(ap->in[15] + (size_t)j * D * D + nb * 64, D, W + WO_WO + (size_t)j * SZ_WO + (size_t)(nb * 64) * D, D, kb * 64, scr, lane); }
}
__device__ __forceinline__ void conv_range(CArgs* ap, LAS unsigned char* lds, int lo, int hi, int w, int nworkers, int wave, int lane) {
    LAS float* scr = (LAS float*)(lds + wave * 16640);
    for (int it = lo + w; it < hi; it += nworkers) conv_item(ap, it, scr, lane);
}

__device__ __forceinline__ void prologue(CArgs* ap, LAS unsigned char* lds, int gw, int NGW, int wave, int lane) {
    struct { const float* in[18]; float* out; unsigned char* ws; } a;
    a.in[0] = ap->in[0]; a.in[1] = ap->in[1]; a.in[6] = ap->in[6]; a.out = ap->out; a.ws = ap->ws;
    bf16* W = (bf16*)(a.ws + WS_W);
    for (int r = gw * 4 + (lane >> 4); r < 8 * D + M; r += NGW * 4) {
        bf16* p = r < 8 * D ? W + WO_FFNOUT + (size_t)r * DFFP + DFF : (bf16*)(a.ws + WS_ACT) + (size_t)(r - 8 * D) * DFFP + DFF;
        *(GAS v4u*)(p + (lane & 15) * 8) = (v4u){0u, 0u, 0u, 0u}; }
    const GAS f32x4* g4 = (const GAS f32x4*)a.in[6];
    for (int row = gw; row < M; row += NGW) {
        const float* xr = row < MP ? a.in[0] + (size_t)row * D : a.in[1] + (size_t)(row - MP) * D;
        const GAS f32x4* x4 = (const GAS f32x4*)xr + lane;
        f32x4 v[8]; float ss = 0.f;
#pragma unroll
        for (int j = 0; j < 8; ++j) { v[j] = x4[64 * j]; ss += (v[j].x * v[j].x + v[j].y * v[j].y) + (v[j].z * v[j].z + v[j].w * v[j].w); }
        const float rs = 1.0f / sqrtf(wave_sum(ss) * (1.f / D) + EPS);
        GAS f32x4* xo = (GAS f32x4*)(a.out + (size_t)row * D) + lane;
        GAS v2u* ho = (GAS v2u*)((bf16*)(a.ws + WS_HB) + (size_t)row * D) + lane;
#pragma unroll
        for (int j = 0; j < 8; ++j) { xo[64 * j] = v[j]; const f32x4 g = g4[lane + 64 * j];
            v2u o; o.x = pk2(v[j].x * rs * g.x, v[j].y * rs * g.y); o.y = pk2(v[j].z * rs * g.z, v[j].w * rs * g.w); ho[64 * j] = o; }
    }
}

__device__ __forceinline__ void norm_row(f32x4 (&y)[8], float* X, bf16* HB, float sc, const GAS f32x4* ga4, const GAS f32x4* gb4, int row, int lane) {
    GAS f32x4* x4 = (GAS f32x4*)(X + (size_t)row * D) + lane;
    f32x4 x[8]; float ss = 0.f;
#pragma unroll
    for (int j = 0; j < 8; ++j) x[j] = x4[64 * j];
#pragma unroll
    for (int j = 0; j < 8; ++j) ss += (y[j].x * y[j].x + y[j].y * y[j].y) + (y[j].z * y[j].z + y[j].w * y[j].w);
    const float r1 = sc / sqrtf(wave_sum(ss) * (1.f / D) + EPS);
    float s2 = 0.f;
#pragma unroll
    for (int j = 0; j < 8; ++j) { const f32x4 g = ga4[lane + 64 * j]; x[j] = x[j] + y[j] * g * r1; x4[64 * j] = x[j];
        s2 += (x[j].x * x[j].x + x[j].y * x[j].y) + (x[j].z * x[j].z + x[j].w * x[j].w); }
    if (gb4) {
        const float r2 = 1.0f / sqrtf(wave_sum(s2) * (1.f / D) + EPS);
        GAS v2u* ho = (GAS v2u*)(HB + (size_t)row * D) + lane;
#pragma unroll
        for (int j = 0; j < 8; ++j) { const f32x4 g = gb4[lane + 64 * j];
            v2u o; o.x = pk2(x[j].x * r2 * g.x, x[j].y * r2 * g.y); o.y = pk2(x[j].z * r2 * g.z, x[j].w * r2 * g.w); ho[64 * j] = o; }
    }
}
template <int NSL>
__device__ __forceinline__ void norm_phase(const bf16* Y, const float* YP, float* X, bf16* HB, float sc, const float* ga, const float* gb, int gw, int NGW, int lane) {
    const GAS f32x4* ga4 = (const GAS f32x4*)ga; const GAS f32x4* gb4 = (const GAS f32x4*)gb;
    if ((gw & 7) == 0) {
        for (int r = gw >> 3; r < MS; r += (NGW >> 3)) {
            const GAS f32x4* p4 = (const GAS f32x4*)(YP + (size_t)r * D) + lane;
            f32x4 y[8];
#pragma unroll
            for (int j = 0; j < 8; ++j) { f32x4 pv[NSL];
#pragma unroll
                for (int i = 0; i < NSL; ++i) pv[i] = p4[(size_t)i * (256 * D / 4) + 64 * j];
                f32x4 a = pv[0];
#pragma unroll
                for (int i = 1; i < NSL; ++i) a = a + pv[i];
                y[j] = a; }
            norm_row(y, X, HB, sc, ga4, gb4, MP + r, lane);
        }
    }
    for (int row = gw; row < MP; row += NGW) {
        const GAS v2u* y2 = (const GAS v2u*)(Y + (size_t)row * D) + lane;
        f32x4 y[8];
#pragma unroll
        for (int j = 0; j < 8; ++j) { const v2u w = y2[64 * j]; y[j] = (f32x4){bf_lo(w.x), bf_hi(w.x), bf_lo(w.y), bf_hi(w.y)}; }
        norm_row(y, X, HB, sc, ga4, gb4, row, lane);
    }
}

__device__ __forceinline__ unsigned ldz(const bf16* Zb, unsigned off) { return *(const GAS unsigned*)((const GAS char*)Zb + off); }
__device__ __forceinline__ void convpool_phase(CArgs* ap, int j, int bid, int G, int tid) {
    const bf16* Z = (const bf16*)(ap->ws + WS_Z); bf16* CAT = (bf16*)(ap->ws + WS_CAT); bf16* DP = (bf16*)(ap->ws + WS_DP);
    const int c = 2 * tid, gi = tid >> 7, w = 2 << gi;
    const float* cw = ap->in[10] + (size_t)j * 3 * DCV + c;
    const f32x2 w0 = *(const f32x2*)cw, w1 = *(const f32x2*)(cw + DCV), w2 = *(const f32x2*)(cw + 2 * DCV);
    float* out = ap->out;
    for (int u = bid; u < 256 + DB; u += G) {
        if (u < 256) {
            const int b = u >> 6, t0 = (u & 63) * 32; const int rb = b * SEQ;
            const bf16* Zb = Z + (size_t)rb * NMIX; bf16* Cb = CAT + (size_t)rb * D; bf16* Db = DP + (size_t)rb * DCV;
            f32x2 vm2 = {0.f, 0.f}, vm1 = {0.f, 0.f}, S = {0.f, 0.f};
            if (t0 > 0) {
                { const unsigned o = (unsigned)((t0 - 2) * NMIX + c) * 2u; const unsigned h = ldz(Zb, o), g = ldz(Zb, o + 2048u); vm2 = (f32x2){bf_lo(h) * bf_lo(g), bf_hi(h) * bf_hi(g)}; }
                { const unsigned o = (unsigned)((t0 - 1) * NMIX + c) * 2u; const unsigned h = ldz(Zb, o), g = ldz(Zb, o + 2048u); vm1 = (f32x2){bf_lo(h) * bf_lo(g), bf_hi(h) * bf_hi(g)}; }
                for (int i = 1; i <= w; ++i) { const unsigned uu = ldz(Zb, (unsigned)((t0 - i) * NMIX + 3072 + c) * 2u); S.x += bf_lo(uu); S.y += bf_hi(uu); }
            }
            const bool lastc = (t0 == SEQ - 32);
#pragma unroll 2
            for (int t = t0; t < t0 + 32; ++t) {
                const unsigned o = (unsigned)(t * NMIX + c) * 2u;
                const unsigned hh = ldz(Zb, o), gg = ldz(Zb, o + 2048u), bb = ldz(Zb, o + 4096u), uu = ldz(Zb, o + 6144u);
                unsigned uo = 0u; if (t >= w) uo = ldz(Zb, (unsigned)((t - w) * NMIX + 3072 + c) * 2u);
                const f32x2 v = {bf_lo(hh) * bf_lo(gg), bf_hi(hh) * bf_hi(gg)};
                const f32x2 yc = w0 * vm2 + w1 * vm1 + w2 * v; vm2 = vm1; vm1 = v;
                const f32x2 ut = {bf_lo(uu), bf_hi(uu)};
                S.x += ut.x - bf_lo(uo); S.y += ut.y - bf_hi(uo);
                const float cnt = (float)((t + 1 < w) ? (t + 1) : w);
                const f32x2 dd = S / cnt - ut;
                *(GAS unsigned*)((GAS char*)Cb + (unsigned)(t * D + c) * 2u) = pk2(bf_lo(bb) * yc.x, bf_hi(bb) * yc.y);
                *(GAS unsigned*)((GAS char*)Db + (unsigned)(t * DCV + c) * 2u) = pk2(dd.x, dd.y);
                if (lastc) {
                    if (t >= SEQ - 2) *(GAS f32x2*)((GAS char*)(out + O_CONVP + (size_t)(j * NB + b) * 2 * DCV) + (unsigned)((t - (SEQ - 2)) * DCV + c) * 4u) = v;
                    if (t >= SEQ - PCTX) *(GAS f32x2*)((GAS char*)(out + O_POOLP + (size_t)(j * NB + b) * PCTX * DCV) + (unsigned)((t - (SEQ - PCTX)) * DCV + c) * 4u) = ut;
                }
            }
        } else {
            const int b = u - 256; const int rb = MP + b * DS;
            const bf16* Zb = Z + (size_t)rb * NMIX; bf16* Cb = CAT + (size_t)rb * D; bf16* Db = DP + (size_t)rb * DCV;
            const GAS char* cc = (const GAS char*)(ap->in[2] + (size_t)(j * DB + b) * 2 * DCV);
            const GAS char* pc = (const GAS char*)(ap->in[3] + (size_t)(j * DB + b) * PCTX * DCV);
            GAS char* pso = (GAS char*)(out + O_POOLS + (size_t)(j * DB + b) * PCTX * DCV);
            GAS char* cso = (GAS char*)(out + O_CONVS + (size_t)(j * DB + b) * 2 * DCV);
            const unsigned c4 = (unsigned)c * 4u;
            f32x2 vm2 = *(const GAS f32x2*)(cc + c4), vm1 = *(const GAS f32x2*)(cc + c4 + DCV * 4u), S = {0.f, 0.f};
            for (int i = 1; i <= w && i <= PCTX; ++i) { const f32x2 p = *(const GAS f32x2*)(pc + c4 + (unsigned)(PCTX - i) * (DCV * 4u)); S += p; }
            for (int i = 0; i < PCTX - DS; ++i) *(GAS f32x2*)(pso + c4 + (unsigned)i * (DCV * 4u)) = *(const GAS f32x2*)(pc + c4 + (unsigned)(DS + i) * (DCV * 4u));
            for (int t = 0; t < DS; ++t) {
                const unsigned o = (unsigned)(t * NMIX + c) * 2u;
                const unsigned hh = ldz(Zb, o), gg = ldz(Zb, o + 2048u), bb = ldz(Zb, o + 4096u), uu = ldz(Zb, o + 6144u);
                f32x2 uo = {0.f, 0.f};
                if (t - w >= 0) { const unsigned uw = ldz(Zb, (unsigned)((t - w) * NMIX + 3072 + c) * 2u); uo = (f32x2){bf_lo(uw), bf_hi(uw)}; }
                else if (t - w >= -PCTX) uo = *(const GAS f32x2*)(pc + c4 + (unsigned)(PCTX + t - w) * (DCV * 4u));
                const f32x2 v = {bf_lo(hh) * bf_lo(gg), bf_hi(hh) * bf_hi(gg)};
                const f32x2 yc = w0 * vm2 + w1 * vm1 + w2 * v; vm2 = vm1; vm1 = v;
                const f32x2 ut = {bf_lo(uu), bf_hi(uu)};
                S += ut - uo;
                const f32x2 dd = S / (float)w - ut;
                *(GAS unsigned*)((GAS char*)Cb + (unsigned)(t * D + c) * 2u) = pk2(bf_lo(bb) * yc.x, bf_hi(bb) * yc.y);
                *(GAS unsigned*)((GAS char*)Db + (unsigned)(t * DCV + c) * 2u) = pk2(dd.x, dd.y);
                if (t >= DS - 2) *(GAS f32x2*)(cso + c4 + (unsigned)(t - (DS - 2)) * (DCV * 4u)) = v;
                *(GAS f32x2*)(pso + c4 + (unsigned)(PCTX - DS + t) * (DCV * 4u)) = ut;
            }
        }
    }
}

constexpr int AT_KP = 144, AT_VP = 520;
constexpr int AT_K = 0, AT_V = 256 * AT_KP, AT_B = AT_V + 64 * AT_VP, AT_END = AT_B + NHEAD * 192 * 4;
static_assert(AT_END <= RING_BYTES && (AT_V % 16) == 0 && (AT_B % 16) == 0, "attention LDS map");
__device__ __forceinline__ int crow(int r, int hi) { return (r & 3) + 8 * (r >> 2) + 4 * hi; }

__device__ __forceinline__ void attention_phase(CArgs* ap, LAS unsigned char* lds, int j, int bid, int G, int tid, int wave, int lane_in) {
    const bf16* QKV = (const bf16*)(ap->ws + WS_Z); bf16* ATT = (bf16*)(ap->ws + WS_CAT);
    float* out = ap->out; const float* relb = ap->in[17]; const float* ck = ap->in[4]; const float* cv = ap->in[5]; const float* sinks = ap->in[16];
    LAS float* biasL = (LAS float*)(lds + AT_B);
    for (int e = tid; e < NHEAD * 192; e += NWAVES * 64) {
        const int h = e / 192, dist = e % 192 - 32; float v = -1e30f;
        if (dist >= 0 && dist <= 128) { int bk = dist;
            if (dist >= 16) { const float ratio = logf((float)dist / 16.0f) / 2.0794415416798357f; bk = 16 + (int)(ratio * 16.0f); if (bk > 31) bk = 31; }
            v = relb[bk * NHEAD + h] * LOG2E; }
        biasL[e] = v;
    }
    const float CS = 0.125f * LOG2E;
    for (int u = bid; u < 256 + DB * NKVH; u += G) {
        __syncthreads();
        asm volatile("" : "+v"(tid));
        const bool prompt = u < 256;
        int b, kvh, row0; bool first = false, lastb = false;
        if (prompt) { b = u >> 6; kvh = (u >> 4) & 3; const int qb = u & 15; row0 = b * SEQ + qb * 128; first = (qb == 0); lastb = (qb == 15); }
        else { const int su = u - 256; b = su >> 2; kvh = su & 3; row0 = MP + b * DS; }
        if (prompt) {
#pragma unroll
            for (int it = 0; it < 4; ++it) { const int id = it * 512 + tid, row = id >> 3, ch = id & 7;
                v4u kv = {0u, 0u, 0u, 0u}, vv = {0u, 0u, 0u, 0u};
                if (!(first && row < 128)) { const bf16* src = QKV + (size_t)(row0 - 128 + row) * NQKV + 2048 + kvh * 64 + ch * 8; kv = *(const GAS v4u*)src; vv = *(const GAS v4u*)(src + 256); }
                *(LAS v4u*)(lds + AT_K + row * AT_KP + ch * 16) = kv;
                LAS bf16* vt = (LAS bf16*)(lds + AT_V + (ch * 8) * AT_VP) + row;
                vt[0] = (bf16)(vv.x & 0xffff); vt[AT_VP / 2] = (bf16)(vv.x >> 16); vt[2 * (AT_VP / 2)] = (bf16)(vv.y & 0xffff); vt[3 * (AT_VP / 2)] = (bf16)(vv.y >> 16);
                vt[4 * (AT_VP / 2)] = (bf16)(vv.z & 0xffff); vt[5 * (AT_VP / 2)] = (bf16)(vv.z >> 16); vt[6 * (AT_VP / 2)] = (bf16)(vv.w & 0xffff); vt[7 * (AT_VP / 2)] = (bf16)(vv.w >> 16);
                if (lastb && row >= 128) { const size_t o = ((size_t)(j * NB + b) * KVB + (row - 128)) * 256 + kvh * 64 + ch * 8;
                    *(f32x4*)(out + O_KP + o) = (f32x4){bf_lo(kv.x), bf_hi(kv.x), bf_lo(kv.y), bf_hi(kv.y)}; *(f32x4*)(out + O_KP + o + 4) = (f32x4){bf_lo(kv.z), bf_hi(kv.z), bf_lo(kv.w), bf_hi(kv.w)};
                    *(f32x4*)(out + O_VP + o) = (f32x4){bf_lo(vv.x), bf_hi(vv.x), bf_lo(vv.y), bf_hi(vv.y)}; *(f32x4*)(out + O_VP + o + 4) = (f32x4){bf_lo(vv.z), bf_hi(vv.z), bf_lo(vv.w), bf_hi(vv.w)}; }
            }
        } else {
#pragma unroll
            for (int it = 0; it < 3; ++it) { const int id = it * 512 + tid, row = id >> 3, ch = id & 7;
                if (row < 160) {
                    v4u kv = {0u, 0u, 0u, 0u}, vv = {0u, 0u, 0u, 0u};
                    f32x4 k0 = {0.f, 0.f, 0.f, 0.f}, k1 = k0, v0 = k0, v1 = k0;
                    if (row < 128) { const size_t so = ((size_t)(j * DB + b) * KVB + row) * 256 + kvh * 64 + ch * 8;
                        k0 = *(const f32x4*)(ck + so); k1 = *(const f32x4*)(ck + so + 4); v0 = *(const f32x4*)(cv + so); v1 = *(const f32x4*)(cv + so + 4);
                        kv = (v4u){pk2(k0.x, k0.y), pk2(k0.z, k0.w), pk2(k1.x, k1.y), pk2(k1.z, k1.w)}; vv = (v4u){pk2(v0.x, v0.y), pk2(v0.z, v0.w), pk2(v1.x, v1.y), pk2(v1.z, v1.w)}; }
                    else if (row < 128 + DS) { const bf16* src = QKV + (size_t)(row0 + row - 128) * NQKV + 2048 + kvh * 64 + ch * 8; kv = *(const GAS v4u*)src; vv = *(const GAS v4u*)(src + 256);
                        k0 = (f32x4){bf_lo(kv.x), bf_hi(kv.x), bf_lo(kv.y), bf_hi(kv.y)}; k1 = (f32x4){bf_lo(kv.z), bf_hi(kv.z), bf_lo(kv.w), bf_hi(kv.w)};
                        v0 = (f32x4){bf_lo(vv.x), bf_hi(vv.x), bf_lo(vv.y), bf_hi(vv.y)}; v1 = (f32x4){bf_lo(vv.z), bf_hi(vv.z), bf_lo(vv.w), bf_hi(vv.w)}; }
                    *(LAS v4u*)(lds + AT_K + row * AT_KP + ch * 16) = kv;
                    LAS bf16* vt = (LAS bf16*)(lds + AT_V + (ch * 8) * AT_VP) + row;
                    vt[0] = (bf16)(vv.x & 0xffff); vt[AT_VP / 2] = (bf16)(vv.x >> 16); vt[2 * (AT_VP / 2)] = (bf16)(vv.y & 0xffff); vt[3 * (AT_VP / 2)] = (bf16)(vv.y >> 16);
                    vt[4 * (AT_VP / 2)] = (bf16)(vv.z & 0xffff); vt[5 * (AT_VP / 2)] = (bf16)(vv.z >> 16); vt[6 * (AT_VP / 2)] = (bf16)(vv.w & 0xffff); vt[7 * (AT_VP / 2)] = (bf16)(vv.w >> 16);
                    if (row >= DS && row < 128 + DS) { const size_t o = ((size_t)(j * DB + b) * KVB + (row - DS)) * 256 + kvh * 64 + ch * 8;
                        *(f32x4*)(out + O_KS + o) = k0; *(f32x4*)(out + O_KS + o + 4) = k1; *(f32x4*)(out + O_VS + o) = v0; *(f32x4*)(out + O_VS + o + 4) = v1; }
                }
            }
        }
        LDS_WAIT();
        __syncthreads();
        const int lane = tid & 63, l31 = lane & 31, hi = lane >> 5;
        const int h = kvh * 8 + wave;
        const float sink2 = sinks[j * NHEAD + h] * LOG2E;
        const LAS float* bl = biasL + h * 192 + 160 + l31 - 4 * hi;
        const int nsub = prompt ? 4 : 1;
        for (int sub = 0; sub < nsub; ++sub) {
            const int qrow = prompt ? (row0 + 32 * sub + l31) : (row0 + (l31 & 7));
            bf16x8 qr[4];
#pragma unroll
            for (int k0 = 0; k0 < 4; ++k0) qr[k0] = *(const GAS bf16x8*)(QKV + (size_t)qrow * NQKV + h * 64 + 16 * k0 + 8 * hi);
            f32x16 acc[5];
#pragma unroll
            for (int jt = 0; jt < 5; ++jt) {
                const int T = sub + jt;
                f32x16 c = {0.f, 0.f, 0.f, 0.f, 0.f, 0.f, 0.f, 0.f, 0.f, 0.f, 0.f, 0.f, 0.f, 0.f, 0.f, 0.f};
#pragma unroll
                for (int k0 = 0; k0 < 4; ++k0) { const bf16x8 kf = *(const LAS bf16x8*)(lds + AT_K + (32 * T + l31) * AT_KP + (16 * k0 + 8 * hi) * 2);
                    c = __builtin_amdgcn_mfma_f32_32x32x16_bf16(kf, qr[k0], c, 0, 0, 0); }
                acc[jt] = c;
            }
            float mx = -1e30f;
#pragma unroll
            for (int jt = 0; jt < 5; ++jt) {
                const float tm = (first && (sub + jt) < 4) ? -1e30f : 0.f;
#pragma unroll
                for (int r = 0; r < 16; ++r) { const float s = acc[jt][r] * CS + (bl[-32 * jt - ((r & 3) + 8 * (r >> 2))] + tm); acc[jt][r] = s; mx = fmaxf(mx, s); }
            }
            mx = fmaxf(mx, __shfl_xor(mx, 32));
            mx = fmaxf(mx, sink2);
            float ls = 0.f;
#pragma unroll
            for (int jt = 0; jt < 5; ++jt)
#pragma unroll
                for (int r = 0; r < 16; ++r) { const float p = __builtin_amdgcn_exp2f(acc[jt][r] - mx); acc[jt][r] = p; ls += p; }
            ls += __shfl_xor(ls, 32);
            ls += __builtin_amdgcn_exp2f(sink2 - mx);
            f32x16 o0 = {0.f, 0.f, 0.f, 0.f, 0.f, 0.f, 0.f, 0.f, 0.f, 0.f, 0.f, 0.f, 0.f, 0.f, 0.f, 0.f}, o1 = o0;
#pragma unroll
            for (int jt = 0; jt < 5; ++jt) {
                const int T = sub + jt;
#pragma unroll
                for (int c2 = 0; c2 < 2; ++c2) {
                    v4u pw; pw.x = pk2(acc[jt][8 * c2 + 0], acc[jt][8 * c2 + 1]); pw.y = pk2(acc[jt][8 * c2 + 2], acc[jt][8 * c2 + 3]); pw.z = pk2(acc[jt][8 * c2 + 4], acc[jt][8 * c2 + 5]); pw.w = pk2(acc[jt][8 * c2 + 6], acc[jt][8 * c2 + 7]);
                    const bf16x8 pf = __builtin_bit_cast(bf16x8, pw);
                    const LAS unsigned char* vb = lds + AT_V + l31 * AT_VP + (32 * T + 16 * c2 + 4 * hi) * 2;
                    { const s16x4 lo = *(const LAS s16x4*)vb, hh = *(const LAS s16x4*)(vb + 16); const bf16x8 vf = {lo[0], lo[1], lo[2], lo[3], hh[0], hh[1], hh[2], hh[3]};
                      o0 = __builtin_amdgcn_mfma_f32_32x32x16_bf16(vf, pf, o0, 0, 0, 0); }
                    { const s16x4 lo = *(const LAS s16x4*)(vb + 32 * AT_VP), hh = *(const LAS s16x4*)(vb + 32 * AT_VP + 16); const bf16x8 vf = {lo[0], lo[1], lo[2], lo[3], hh[0], hh[1], hh[2], hh[3]};
                      o1 = __builtin_amdgcn_mfma_f32_32x32x16_bf16(vf, pf, o1, 0, 0, 0); }
                }
            }
            const float inv = 1.0f / ls;
            if (prompt || l31 < DS) {
                bf16* orow = ATT + (size_t)(prompt ? qrow : (row0 + l31)) * D + h * 64 + 4 * hi;
#pragma unroll
                for (int rq = 0; rq < 4; ++rq) {
                    v2u w0; w0.x = pk2(o0[4 * rq] * inv, o0[4 * rq + 1] * inv); w0.y = pk2(o0[4 * rq + 2] * inv, o0[4 * rq + 3] * inv); *(GAS v2u*)(orow + 8 * rq) = w0;
                    v2u w1; w1.x = pk2(o1[4 * rq] * inv, o1[4 * rq + 1] * inv); w1.y = pk2(o1[4 * rq + 2] * inv, o1[4 * rq + 3] * inv); *(GAS v2u*)(orow + 32 + 8 * rq) = w1;
                }
            }
        }
    }
    __syncthreads();
}

__global__ void __launch_bounds__(NWAVES * 64, 2) mega_fwd(Args args) {
    extern __shared__ __attribute__((aligned(16))) unsigned char lds_raw[];
    LAS unsigned char* lds = (LAS unsigned char*)lds_raw;
    const int tid = threadIdx.x, lane = tid & 63, wave = __builtin_amdgcn_readfirstlane(tid >> 6);
    const int G = gridDim.x, bid = blockIdx.x;
    const int vcu = (G % 8 == 0) ? (bid % 8) * (G / 8) + bid / 8 : bid;
    const int gw = vcu * NWAVES + wave, NGW = G * NWAVES;
    CArgs* ap0 = fresh_args();
    for (int u = tid; u < (LDS_BYTES - LDSCTL_OFF) / 4; u += NWAVES * 64) ((LAS unsigned*)(lds + LDSCTL_OFF))[u] = 0u;
    __syncthreads();
    XcdBarrier bar = xcd_barrier_post((unsigned*)(ap0->ws + WS_CTL) + CW_BAR, (volatile LAS unsigned*)(lds + MISC_OFF) + 8);
#define GRID_BAR() xcd_barrier(bar)
#define FRESH_TID() int tid_ = threadIdx.x; asm volatile("" : "+v"(tid_)); const int lane_ = tid_ & 63, wave_ = __builtin_amdgcn_readfirstlane(tid_ >> 6), gw_ = vcu * NWAVES + wave_; (void)lane_; (void)gw_

    int cursor = 0;
#define ENSURE(need) do { const int need_ = (need); if (cursor < need_) { FRESH_TID(); conv_range(fresh_args(), lds, cursor, need_, gw_, NGW, wave_, lane_); cursor = need_; } } while (0)
#define IDLE_CONV(first_idle) do { if (cursor < IT_TOTAL) { const int nid_ = G - (first_idle); int hi_ = cursor + nid_ * NWAVES * CONV_PER_IDLE_WAVE; if (hi_ > IT_TOTAL) hi_ = IT_TOTAL; \
        if (bid >= (first_idle)) { FRESH_TID(); conv_range(fresh_args(), lds, cursor, hi_, (bid - (first_idle)) * NWAVES + wave_, nid_ * NWAVES, wave_, lane_); } cursor = hi_; } } while (0)
    prologue(ap0, lds, gw, NGW, wave, lane);
    ENSURE(conv_seg_start(0, 1));
    GRID_BAR();

    for (int hl = 0; hl < 8; ++hl) {
        const int l = hl >> 1, f = hl & 1, j = l >> 1;
        const bool odd = (l & 1) != 0;
        {
            CArgs* ap = fresh_args(); unsigned char* ws = ap->ws;
            const pg8::Gemm g = pg8::plain_gemm((const bf16*)(ws + WS_HB), (const bf16*)(ws + WS_W) + WO_FFNIN + (size_t)hl * SZ_FFNIN, D, D, D); pg8::StaticOrder S; S.init(M, NFF, G, bid);
            pg8::EpiSwiGLU E{(bf16*)(ws + WS_ACT), DFFP};
            pg8::gemm_phase<pg8::EpiSwiGLU, pg8::StaticOrder, true, true>(lds, g, S, E);
        }
        IDLE_CONV((M / 256) * (NFF / 256) % 256);
        ENSURE(conv_seg_start(l, f ? 7 : 2));
        GRID_BAR();
        {
            CArgs* ap = fresh_args(); unsigned char* ws = ap->ws;
            const bf16* Wo_ = (const bf16*)(ws + WS_W) + WO_FFNOUT + (size_t)hl * SZ_FFNOUT;
            { const pg8::Gemm g = pg8::plain_gemm((const bf16*)(ws + WS_ACT), Wo_, DFF, DFFP, DFFP); pg8::StaticOrder S; S.init(MP, D, G, bid);
              pg8::EpiBf16S E{(bf16*)(ws + WS_Y), D, nullptr, 0};
              pg8::gemm_phase<pg8::EpiBf16S, pg8::StaticOrder, true, true>(lds, g, S, E); }
            { const pg8::Gemm g{(const bf16*)(ws + WS_ACT) + (size_t)MP * DFFP, Wo_, 256, DFFP, DFFP, 512, 0, (size_t)256 * DFFP * 2, 512}; pg8::StaticOrder S; S.init(NSL_FFN * 256, D, G, bid);
              pg8::EpiF32 E{(float*)(ws + WS_YP), D};
              pg8::gemm_phase<pg8::EpiF32, pg8::StaticOrder, true, true>(lds, g, S, E); }
        }
        GRID_BAR();
        {
            CArgs* ap = fresh_args(); unsigned char* ws = ap->ws; const float* NG = ap->in[6];
            const float* ga = NG + (size_t)(l * 6 + (f ? 5 : 1)) * D;
            const float* gb = f == 0 ? NG + (size_t)(l * 6 + 2) * D : (l < 3 ? NG + (size_t)((l + 1) * 6) * D : nullptr);
            FRESH_TID();
            norm_phase<NSL_FFN>((const bf16*)(ws + WS_Y), (const float*)(ws + WS_YP), ap->out, (bf16*)(ws + WS_HB), 0.5f, ga, gb, gw_, NGW, lane_);
        }
        ENSURE(f == 0 ? conv_seg_start(l, 3) : (l < 3 ? conv_seg_start(l + 1, 1) : IT_TOTAL));
        GRID_BAR();
        if (f == 0) {
            {
                CArgs* ap = fresh_args(); unsigned char* ws = ap->ws;
                const int N = odd ? NQKV : NMIX; const bf16* W = (const bf16*)(ws + WS_W);
                const pg8::Gemm g = pg8::plain_gemm((const bf16*)(ws + WS_HB), odd ? W + WO_QKV + (size_t)j * SZ_QKV : W + WO_MIXIN + (size_t)j * SZ_MIXIN, D, D, D); pg8::StaticOrder S; S.init(M, N, G, bid);
                pg8::EpiBf16S E{(bf16*)(ws + WS_Z), N, nullptr, 0};
                pg8::gemm_phase<pg8::EpiBf16S, pg8::StaticOrder, true, true>(lds, g, S, E);
            }
            IDLE_CONV(odd ? (M / 256) * (NQKV / 256) % 256 : (M / 256) * (NMIX / 256) % 256);
            ENSURE(conv_seg_start(l, 5));
            GRID_BAR();
            if (odd) {
                FRESH_TID();
                attention_phase(fresh_args(), lds, j, bid, G, tid_, wave_, lane_);
                GRID_BAR();
            } else {
                { FRESH_TID();
                  convpool_phase(fresh_args(), j, bid, G, tid_); }
                GRID_BAR();
                {
                    CArgs* ap = fresh_args(); unsigned char* ws = ap->ws;
                    const pg8::Gemm g{(const bf16*)(ws + WS_DP), (const bf16*)(ws + WS_W) + WO_POOLW + (size_t)j * SZ_POOLW, 256, DCV, 256, (size_t)256 * DCV * 2, 512, (size_t)256 * 256 * 2, 0}; pg8::StaticOrder S; S.init(M, DCV, G, bid);
                    pg8::EpiBf16S E{(bf16*)(ws + WS_CAT), D, ap->in[12] + (size_t)j * DCV, DCV};
                    pg8::gemm_phase<pg8::EpiBf16S, pg8::StaticOrder, true, true>(lds, g, S, E);
                }
                GRID_BAR();
            }
            {
                CArgs* ap = fresh_args(); unsigned char* ws = ap->ws; const bf16* W = (const bf16*)(ws + WS_W);
                const bf16* Wm = odd ? W + WO_WO + (size_t)j * SZ_WO : W + WO_MIXOUT + (size_t)j * SZ_MIXOUT;
                { const pg8::Gemm g = pg8::plain_gemm((const bf16*)(ws + WS_CAT), Wm, D, D, D); pg8::StaticOrder S; S.init(MP, D, G, bid);
                  pg8::EpiBf16S E{(bf16*)(ws + WS_Y), D, nullptr, 0};
                  pg8::gemm_phase<pg8::EpiBf16S, pg8::StaticOrder, true, true>(lds, g, S, E); }
                { const pg8::Gemm g{(const bf16*)(ws + WS_CAT) + (size_t)MP * D, Wm, 256, D, D, 512, 0, (size_t)256 * D * 2, 512}; pg8::StaticOrder S; S.init(NSL_MIX * 256, D, G, bid);
                  pg8::EpiF32 E{(float*)(ws + WS_YP), D};
                  pg8::gemm_phase<pg8::EpiF32, pg8::StaticOrder, true, true>(lds, g, S, E); }
            }
            GRID_BAR();
            {   CArgs* ap = fresh_args(); unsigned char* ws = ap->ws; const float* NG = ap->in[6];
                FRESH_TID();
                norm_phase<NSL_MIX>((const bf16*)(ws + WS_Y), (const float*)(ws + WS_YP), ap->out, (bf16*)(ws + WS_HB), 1.0f, NG + (size_t)(l * 6 + 3) * D, NG + (size_t)(l * 6 + 4) * D, gw_, NGW, lane_); }
            ENSURE(conv_seg_start(l, 6));
            GRID_BAR();
        }
    }
}

extern "C" void kernel_launch(void* const* d_in, const int* in_sizes, int n_in, void* d_out, int out_size, void* d_ws, size_t ws_size, hipStream_t stream) {
    static int grid = 0;
    if (grid == 0) {
        if (n_in != 18 || out_size != (int)O_END || ws_size < WS_END) { fprintf(stderr, "kernel_launch: unexpected shapes (n_in %d, out %d, ws %zu; need ws >= %zu)\n", n_in, out_size, ws_size, (size_t)WS_END); grid = -1; return; }
        int dev = 0, cus = 0, per_cu = 0;
        if (hipGetDevice(&dev) != hipSuccess || hipDeviceGetAttribute(&cus, hipDeviceAttributeMultiprocessorCount, dev) != hipSuccess) { grid = -1; return; }
        if (hipFuncSetAttribute((const void*)mega_fwd, hipFuncAttributeMaxDynamicSharedMemorySize, LDS_BYTES) != hipSuccess) { fprintf(stderr, "kernel_launch: hipFuncSetAttribute failed\n"); grid = -1; return; }
        if (hipOccupancyMaxActiveBlocksPerMultiprocessor(&per_cu, (const void*)mega_fwd, NWAVES * 64, LDS_BYTES) != hipSuccess || per_cu < 1)
            fprintf(stderr, "kernel_launch: occupancy query reports %d\n", per_cu);
        (void)hipGetLastError();
        grid = cus;
    }
    if (grid < 0) return;
    if (hipMemsetAsync((char*)d_ws + WS_CTL, 0, CTL_ZERO_BYTES, stream) != hipSuccess) return;
    Args a{};
    for (int i = 0; i < 18; ++i) a.in[i] = (const float*)d_in[i];
    a.out = (float*)d_out; a.ws = (unsigned char*)d_ws;
    hipLaunchKernelGGL(mega_fwd, dim3(grid), dim3(NWAVES * 64), LDS_BYTES, stream, a);
}
```

```cpp
#include <hip/hip_runtime.h>
#include <cstdio>
#include <cstdint>

#define LAS __attribute__((address_space(3)))
#define GAS __attribute__((address_space(1)))

namespace pg8 {
typedef unsigned short bf16_t;
typedef short bf16x8 __attribute__((ext_vector_type(8)));
typedef float f32x4 __attribute__((ext_vector_type(4)));
typedef float f32x2 __attribute__((ext_vector_type(2)));
typedef unsigned u32x4 __attribute__((ext_vector_type(4)));
constexpr int BM = 256, BK = 64, HALF = 128, HTB = HALF * BK * 2, STAGE_BYTES = 8 * HTB, NXCD = 8, WGM = 8;

__host__ __device__ __forceinline__ int lds_byte(int r, int c) { const int st = (r >> 4) * 2 + (c >> 5), rr = r & 15, cc = c & 31, ob = rr * 64 + cc * 2; return st * 1024 + (ob ^ (((ob >> 9) & 1) << 5)); }
__host__ __device__ __forceinline__ void stage_rc(int b, int& R, int& C) { const int st = b / 1024, sb = b % 1024, swz = sb ^ (((sb >> 9) & 1) << 5); R = (st >> 1) * 16 + swz / 64; C = (st & 1) * 32 + (swz % 64) / 2; }
__host__ __device__ __forceinline__ int perm32(int rho) { const int n = rho >> 4, i = rho & 15; return 8 * (i >> 2) + 4 * n + (i & 3); }

struct Unit { int pm, pn; };
struct Gemm { const bf16_t* A; const bf16_t* Bt; int K, lda, ldb; size_t a_pm, a_pn, b_pn, b_pm; };
__device__ __forceinline__ Gemm plain_gemm(const bf16_t* A, const bf16_t* Bt, int K, int lda, int ldb) { return Gemm{A, Bt, K, lda, ldb, (size_t)BM * lda * 2, 0, (size_t)BM * ldb * 2, 0}; }

struct StaticOrder {
    int nM, nN, nwg, G, c;
    __host__ __device__ void init(int M, int N, int G_, int c_) { nM = M / BM; nN = N / BM; nwg = nM * nN; G = G_; c = c_; }
    __host__ __device__ bool next(int i, Unit& u) const {
        const long L = (long)i * G + c; if (L >= nwg) return false;
        int wgid = (int)L; { const int q = nwg / NXCD, r = nwg % NXCD, xcd = wgid % NXCD, off = wgid / NXCD; wgid = (xcd < r ? xcd * (q + 1) : r * (q + 1) + (xcd - r) * q) + off; }
        const int nig = WGM * nN, gid = wgid / nig, fm = gid * WGM, gsz = (nM - fm) < WGM ? (nM - fm) : WGM;
        u.pm = fm + ((wgid % nig) % gsz); u.pn = (wgid % nig) / gsz; return true;
    }
    __device__ __forceinline__ void a_ready(const Unit&) const {}
    __device__ __forceinline__ void done(const Unit&) const {}
};

__device__ __forceinline__ unsigned cvt_pk_bf16(float lo, float hi) { unsigned r; asm volatile("v_cvt_pk_bf16_f32 %0, %1, %2" : "=v"(r) : "v"(lo), "v"(hi)); return r; }

struct EpiF32 {
    static constexpr bool PERM = false, AFTER_DRAIN = false;
    float* C; int ldc;
    __device__ __forceinline__ void operator()(const f32x4 (&acc)[2][2][4][2], const Unit& u, int wr, int wc, int fr, int fq) const {
        const int row0 = u.pm * BM + wr * 64 + fr, col0 = u.pn * BM + wc * 32 + 4 * fq;
#pragma unroll
        for (int ai = 0; ai < 2; ++ai)
#pragma unroll
            for (int m = 0; m < 4; ++m) { float* rowp = C + (size_t)(row0 + ai * HALF + m * 16) * ldc + col0;
#pragma unroll
                for (int bj = 0; bj < 2; ++bj)
#pragma unroll
                    for (int n = 0; n < 2; ++n) *(f32x4*)(rowp + bj * HALF + n * 16) = acc[ai][bj][m][n]; }
    }
};
struct EpiBf16S {
    static constexpr bool PERM = true, AFTER_DRAIN = false;
    bf16_t* O; int ldc; const float* scale; int col_off;
    __device__ __forceinline__ void operator()(const f32x4 (&acc)[2][2][4][2], const Unit& u, int wr, int wc, int fr, int fq) const {
        const int row0 = u.pm * BM + wr * 64 + fr; const int col0 = u.pn * BM + wc * 32 + 8 * fq;
        f32x4 sv[2][2];
#pragma unroll
        for (int bj = 0; bj < 2; ++bj)
#pragma unroll
            for (int n = 0; n < 2; ++n) sv[bj][n] = scale ? *(const f32x4*)(scale + col0 + bj * HALF + 4 * n) : (f32x4){1.f, 1.f, 1.f, 1.f};
#pragma unroll
        for (int ai = 0; ai < 2; ++ai)
#pragma unroll
            for (int m = 0; m < 4; ++m) { bf16_t* rowp = O + (size_t)(row0 + ai * HALF + m * 16) * ldc + col_off + col0;
#pragma unroll
                for (int bj = 0; bj < 2; ++bj) { const f32x4 v0 = acc[ai][bj][m][0] * sv[bj][0], v1 = acc[ai][bj][m][1] * sv[bj][1];
                    u32x4 w; w.x = cvt_pk_bf16(v0[0], v0[1]); w.y = cvt_pk_bf16(v0[2], v0[3]); w.z = cvt_pk_bf16(v1[0], v1[1]); w.w = cvt_pk_bf16(v1[2], v1[3]);
                    *(u32x4*)(rowp + bj * HALF) = w; } }
    }
};
__device__ __forceinline__ float silu_mul(float g, float u) { const float e = __builtin_amdgcn_exp2f(g * -1.44269504089f); return g * __builtin_amdgcn_rcpf(1.0f + e) * u; }
struct EpiSwiGLU {
    static constexpr bool PERM = true, AFTER_DRAIN = false;
    bf16_t* O; int ldc;
    __device__ __forceinline__ void operator()(const f32x4 (&acc)[2][2][4][2], const Unit& u, int wr, int wc, int fr, int fq) const {
        const int row0 = u.pm * BM + wr * 64 + fr; const int col0 = u.pn * HALF + wc * 32 + 8 * fq;
#pragma unroll
        for (int ai = 0; ai < 2; ++ai)
#pragma unroll
            for (int m = 0; m < 4; ++m) { bf16_t* rowp = O + (size_t)(row0 + ai * HALF + m * 16) * ldc + col0;
                const f32x4 g0 = acc[ai][0][m][0], g1 = acc[ai][0][m][1], u0 = acc[ai][1][m][0], u1 = acc[ai][1][m][1];
                u32x4 w; w.x = cvt_pk_bf16(silu_mul(g0[0], u0[0]), silu_mul(g0[1], u0[1])); w.y = cvt_pk_bf16(silu_mul(g0[2], u0[2]), silu_mul(g0[3], u0[3]));
                w.z = cvt_pk_bf16(silu_mul(g1[0], u1[0]), silu_mul(g1[1], u1[1])); w.w = cvt_pk_bf16(silu_mul(g1[2], u1[2]), silu_mul(g1[3], u1[3]));
                *(u32x4*)rowp = w; }
    }
};

template <class Epi, class Sched, bool ALIGN_EPI = false, bool SP2 = false>
__device__ __forceinline__ void gemm_phase(LAS unsigned char* lds, const Gemm g, const Sched& S, const Epi& E) {
    int tid = threadIdx.x; asm volatile("" : "+v"(tid));
    const int wid = __builtin_amdgcn_readfirstlane(tid >> 6), lane = tid & 63, wr = wid >> 2, wc = wid & 3, fr = lane & 15, fq = lane >> 4;
    const int K = g.K, nt = K / BK;
    unsigned voffA[2], voffB[2];
#pragma unroll
    for (int i = 0; i < 2; ++i) { int R, C; stage_rc(tid * 16 + i * 8192, R, C); const int Rb = Epi::PERM ? ((R & ~31) + perm32(R & 31)) : R;
        voffA[i] = (unsigned)(R * g.lda + C) * 2u; voffB[i] = (unsigned)(Rb * g.ldb + C) * 2u; }
    const size_t kstep = (size_t)(BK * 2);
    const size_t hstepA = (size_t)HALF * g.lda * 2, hstepB = (size_t)HALF * g.ldb * 2;
    const unsigned ldsw = (unsigned)wid * 1024u;
    const int aoff = lds_byte(wr * 64 + fr, fq * 8), boff = lds_byte(wc * 32 + fr, fq * 8);
#define PG8_SA(b, h) (((b) * 2 + (h)) * HTB)
#define PG8_SB(b, h) ((4 + (b) * 2 + (h)) * HTB)
#define PG8_STAGE(bufoff, gbase, voff) do { _Pragma("unroll") for (int _i = 0; _i < 2; ++_i) \
        __builtin_amdgcn_global_load_lds((const unsigned*)((const char*)(gbase) + (voff)[_i]), (LAS unsigned*)(lds + (bufoff) + ldsw + _i * 8192), 16, 0, 0); } while (0)
#define PG8_LDA(dst, b, h) do { _Pragma("unroll") for (int m = 0; m < 4; ++m) _Pragma("unroll") for (int k = 0; k < 2; ++k) dst[m][k] = *(const LAS bf16x8*)(lds + PG8_SA(b, h) + aoff + m * 2048 + k * 1024); } while (0)
#define PG8_LDB(dst, b, h) do { _Pragma("unroll") for (int n = 0; n < 2; ++n) _Pragma("unroll") for (int k = 0; k < 2; ++k) dst[n][k] = *(const LAS bf16x8*)(lds + PG8_SB(b, h) + boff + n * 2048 + k * 1024); } while (0)
#define PG8_MMA(ai, bj, At, Bt) do { __builtin_amdgcn_s_setprio(1); _Pragma("unroll") for (int m = 0; m < 4; ++m) _Pragma("unroll") for (int n = 0; n < 2; ++n) _Pragma("unroll") for (int k = 0; k < 2; ++k) \
        acc[ai][bj][m][n] = __builtin_amdgcn_mfma_f32_16x16x32_bf16(Bt[n][k], At[m][k], acc[ai][bj][m][n], 0, 0, 0); __builtin_amdgcn_s_setprio(0); } while (0)
#define PG8_WAIT_V(n) asm volatile("s_waitcnt vmcnt(" #n ")" ::: "memory")
#define PG8_WAIT_L(n) asm volatile("s_waitcnt lgkmcnt(" #n ")" ::: "memory")
#define PG8_BAR __builtin_amdgcn_s_barrier()
#define PG8_SCHED __builtin_amdgcn_sched_barrier(0)
    Unit cur, nxt; int ui = 0;
    if (!S.next(0, cur)) return;
    f32x4 acc[2][2][4][2];
#pragma unroll
    for (int a = 0; a < 2; ++a)
#pragma unroll
        for (int b = 0; b < 2; ++b)
#pragma unroll
            for (int m = 0; m < 4; ++m)
#pragma unroll
                for (int n = 0; n < 2; ++n) acc[a][b][m][n] = (f32x4){0.f, 0.f, 0.f, 0.f};
    bf16x8 At[4][2], B0[2][2], B1[2][2];
    const char* cA = (const char*)g.A + (size_t)cur.pm * g.a_pm + (size_t)cur.pn * g.a_pn; const char* cB = (const char*)g.Bt + (size_t)cur.pn * g.b_pn + (size_t)cur.pm * g.b_pm;
    S.a_ready(cur);
    if constexpr (SP2) {
        PG8_STAGE(PG8_SB(0, 0), cB, voffB); PG8_STAGE(PG8_SB(0, 1), cB + hstepB, voffB); PG8_STAGE(PG8_SA(0, 0), cA, voffA); PG8_STAGE(PG8_SA(0, 1), cA + hstepA, voffA);
        if (wr == 1) PG8_BAR;
        PG8_WAIT_V(2); PG8_BAR;
        PG8_STAGE(PG8_SB(1, 0), cB + kstep, voffB); PG8_STAGE(PG8_SA(1, 0), cA + kstep, voffA); PG8_STAGE(PG8_SB(1, 1), cB + hstepB + kstep, voffB);
        PG8_WAIT_V(6); PG8_BAR;
    } else {
        PG8_STAGE(PG8_SB(0, 0), cB, voffB); PG8_STAGE(PG8_SA(0, 0), cA, voffA); PG8_STAGE(PG8_SB(0, 1), cB + hstepB, voffB); PG8_STAGE(PG8_SA(0, 1), cA + hstepA, voffA);
        if (wr == 1) PG8_BAR;
        PG8_WAIT_V(4); PG8_BAR;
        PG8_STAGE(PG8_SB(1, 0), cB + kstep, voffB); PG8_STAGE(PG8_SA(1, 0), cA + kstep, voffA); PG8_STAGE(PG8_SB(1, 1), cB + hstepB + kstep, voffB);
        PG8_WAIT_V(6); PG8_BAR;
    }
    for (;;) {
        const bool has_next = S.next(ui + 1, nxt);
        const char* nA = has_next ? (const char*)g.A + (size_t)nxt.pm * g.a_pm + (size_t)nxt.pn * g.a_pn : cA; const char* nB = has_next ? (const char*)g.Bt + (size_t)nxt.pn * g.b_pn + (size_t)nxt.pm * g.b_pm : cB;
        for (int t = 0; t < nt; t += 2) {
            const bool last = (t == nt - 2);
            const char* a1 = cA + (size_t)(t + 1) * kstep;
            const char* a2 = last ? nA : cA + (size_t)(t + 2) * kstep; const char* b2 = last ? nB : cB + (size_t)(t + 2) * kstep;
            const char* a3 = a2 + kstep; const char* b3 = b2 + kstep;
            if (last && has_next) S.a_ready(nxt);
            if constexpr (SP2) {
            PG8_LDB(B0, 0, 0); PG8_LDB(B1, 0, 1); PG8_SCHED; PG8_LDA(At, 0, 0); PG8_STAGE(PG8_SA(1, 1), a1 + hstepA, voffA);
            PG8_WAIT_V(8); PG8_WAIT_L(0); PG8_BAR; PG8_MMA(0, 0, At, B0); PG8_MMA(0, 1, At, B1); PG8_BAR; PG8_SCHED;
            PG8_LDA(At, 0, 1); PG8_STAGE(PG8_SB(0, 0), b2, voffB); PG8_STAGE(PG8_SB(0, 1), b2 + hstepB, voffB); PG8_STAGE(PG8_SA(0, 0), a2, voffA);
            PG8_WAIT_V(8); PG8_WAIT_L(0); PG8_BAR; PG8_MMA(1, 0, At, B0); PG8_MMA(1, 1, At, B1); PG8_BAR; PG8_SCHED;
            PG8_LDB(B0, 1, 0); PG8_LDB(B1, 1, 1); PG8_SCHED; PG8_LDA(At, 1, 0); PG8_STAGE(PG8_SA(0, 1), a2 + hstepA, voffA);
            PG8_WAIT_V(8); PG8_WAIT_L(0); PG8_BAR; PG8_MMA(0, 0, At, B0); PG8_MMA(0, 1, At, B1); PG8_BAR; PG8_SCHED;
            PG8_LDA(At, 1, 1); PG8_STAGE(PG8_SB(1, 0), b3, voffB); PG8_STAGE(PG8_SB(1, 1), b3 + hstepB, voffB); PG8_STAGE(PG8_SA(1, 0), a3, voffA);
            PG8_WAIT_V(8); PG8_WAIT_L(0); PG8_BAR; PG8_MMA(1, 0, At, B0); PG8_MMA(1, 1, At, B1); PG8_BAR; PG8_SCHED;
            } else {
            PG8_LDB(B0, 0, 0); PG8_SCHED; PG8_LDA(At, 0, 0); PG8_STAGE(PG8_SA(1, 1), a1 + hstepA, voffA);
            PG8_WAIT_L(8); PG8_BAR; PG8_WAIT_L(0); PG8_MMA(0, 0, At, B0); PG8_BAR; PG8_SCHED;
            PG8_LDB(B1, 0, 1); PG8_STAGE(PG8_SB(0, 0), b2, voffB);
            PG8_BAR; PG8_WAIT_L(0); PG8_MMA(0, 1, At, B1); PG8_BAR;
            PG8_LDA(At, 0, 1); PG8_STAGE(PG8_SA(0, 0), a2, voffA);
            PG8_BAR; PG8_WAIT_L(0); PG8_MMA(1, 0, At, B0); PG8_BAR; PG8_SCHED;
            PG8_STAGE(PG8_SB(0, 1), b2 + hstepB, voffB);
            PG8_WAIT_V(6); PG8_BAR; PG8_MMA(1, 1, At, B1); PG8_BAR;
            PG8_LDB(B0, 1, 0); PG8_SCHED; PG8_LDA(At, 1, 0); PG8_STAGE(PG8_SA(0, 1), a2 + hstepA, voffA);
            PG8_WAIT_L(8); PG8_BAR; PG8_WAIT_L(0); PG8_MMA(0, 0, At, B0); PG8_BAR; PG8_SCHED;
            PG8_LDB(B1, 1, 1); PG8_STAGE(PG8_SB(1, 0), b3, voffB);
            PG8_BAR; PG8_WAIT_L(0); PG8_MMA(0, 1, At, B1); PG8_BAR;
            PG8_LDA(At, 1, 1); PG8_STAGE(PG8_SA(1, 0), a3, voffA);
            PG8_BAR; PG8_WAIT_L(0); PG8_MMA(1, 0, At, B0); PG8_BAR; PG8_SCHED;
            PG8_STAGE(PG8_SB(1, 1), b3 + hstepB, voffB);
            PG8_WAIT_V(6); PG8_BAR; PG8_MMA(1, 1, At, B1); PG8_BAR;
            }
        }
        if constexpr (ALIGN_EPI) { if (wr == 0) PG8_BAR; }
        if constexpr (!Epi::AFTER_DRAIN) { E(acc, cur, wr, wc, fr, fq); S.done(cur); }
        if (!has_next) break;
#pragma unroll
        for (int a = 0; a < 2; ++a)
#pragma unroll
            for (int b = 0; b < 2; ++b)
#pragma unroll
                for (int m = 0; m < 4; ++m)
#pragma unroll
                    for (int n = 0; n < 2; ++n) acc[a][b][m][n] = (f32x4){0.f, 0.f, 0.f, 0.f};
        cur = nxt; cA = nA; cB = nB; ++ui;
        if constexpr (ALIGN_EPI) { if (wr == 1) PG8_BAR; }
    }
    PG8_WAIT_V(0);
    if constexpr (!ALIGN_EPI) { if (wr == 0) PG8_BAR; }
    PG8_BAR;
#undef PG8_SA
#undef PG8_SB
#undef PG8_STAGE
#undef PG8_LDA
#undef PG8_LDB
#undef PG8_MMA
#undef PG8_WAIT_V
#undef PG8_WAIT_L
#undef PG8_BAR
#undef PG8_SCHED
}
}

typedef unsigned short bf16;
typedef unsigned v4u __attribute__((ext_vector_type(4)));
typedef unsigned v2u __attribute__((ext_vector_type(2)));
typedef float f32x4 __attribute__((ext_vector_type(4)));
typedef float f32x2 __attribute__((ext_vector_type(2)));
typedef float f32x16 __attribute__((ext_vector_type(16)));
typedef short bf16x8 __attribute__((ext_vector_type(8)));
typedef short s16x4 __attribute__((ext_vector_type(4)));

constexpr int NWAVES = 8;
constexpr int CONV_PER_IDLE_WAVE = 6;
constexpr int D = 2048, MP = 8192, MS = 256, M = MP + MS, DFF = 5504, NFF = 2 * DFF, NMIX = 4096, NQKV = 2560, DCV = 1024;
constexpr int DFFP = 5632;
constexpr int KSL_FFN = 512, KSL_MIX = 256;
constexpr int NSL_FFN = DFFP / KSL_FFN, NSL_MIX = D / KSL_MIX;
constexpr int SEQ = 2048, NB = 4, DB = 32, DS = 8, NHEAD = 32, NKVH = 4, HD = 64, KVB = 128, PCTX = 15;
constexpr float EPS = 1e-6f;
constexpr float LOG2E = 1.4426950408889634f;

constexpr size_t O_Y = 0, O_CONVP = (size_t)M * D, O_POOLP = O_CONVP + 2 * NB * 2 * DCV, O_KP = O_POOLP + 2 * NB * PCTX * DCV, O_VP = O_KP + 2 * NB * KVB * 256,
                 O_CONVS = O_VP + 2 * NB * KVB * 256, O_POOLS = O_CONVS + 2 * DB * 2 * DCV, O_KS = O_POOLS + 2 * DB * PCTX * DCV, O_VS = O_KS + 2 * DB * KVB * 256, O_END = O_VS + 2 * DB * KVB * 256;
static_assert(O_END == 23273472, "output size");

constexpr size_t MiB = 1u << 20;
constexpr size_t WS_CTL = 0, CTL_ZERO_BYTES = 1 * MiB;
constexpr size_t WS_HB = 2 * MiB;
constexpr size_t WS_ACT = 36 * MiB;
constexpr size_t WS_Y = 128 * MiB;
constexpr size_t WS_Z = 194 * MiB;
constexpr size_t WS_CAT = 260 * MiB;
constexpr size_t WS_DP = 294 * MiB;
constexpr size_t WS_YP = 312 * MiB;
constexpr size_t WS_W = 360 * MiB;
constexpr size_t SZ_FFNIN = (size_t)NFF * D, SZ_FFNOUT = (size_t)D * DFFP, SZ_MIXIN = (size_t)NMIX * D, SZ_MIXOUT = (size_t)D * D, SZ_QKV = (size_t)NQKV * D, SZ_WO = (size_t)D * D, SZ_POOLW = 4 * 256 * 256;
constexpr size_t WO_FFNIN = 0, WO_FFNOUT = WO_FFNIN + 8 * SZ_FFNIN, WO_MIXIN = WO_FFNOUT + 8 * SZ_FFNOUT, WO_MIXOUT = WO_MIXIN + 2 * SZ_MIXIN, WO_QKV = WO_MIXOUT + 2 * SZ_MIXOUT,
                 WO_WO = WO_QKV + 2 * SZ_QKV, WO_POOLW = WO_WO + 2 * SZ_WO, WO_END = WO_POOLW + 2 * SZ_POOLW;
constexpr size_t WS_END = WS_W + WO_END * 2;
static_assert(WS_HB + (size_t)M * D * 2 <= WS_ACT && WS_ACT + (size_t)M * DFFP * 2 <= WS_Y && WS_Y + (size_t)M * D * 4 <= WS_Z && WS_Z + (size_t)M * NMIX * 2 <= WS_CAT && WS_CAT + (size_t)M * D * 2 <= WS_DP && WS_DP + (size_t)M * DCV * 2 <= WS_YP && WS_YP + (size_t)NSL_FFN * 256 * D * 4 <= WS_W, "ws map");
constexpr int CW_BAR = 4096;

constexpr int RING_BYTES = 135168;
constexpr int LDSCTL_OFF = RING_BYTES, MISC_OFF = LDSCTL_OFF + 320;
constexpr int LDS_BYTES = 147456;
static_assert(MISC_OFF + 128 <= LDS_BYTES, "LDS map");

#define LDS_WAIT() asm volatile("s_waitcnt lgkmcnt(0)" ::: "memory")
#define VM_WAIT() asm volatile("s_waitcnt vmcnt(0)" ::: "memory")
__device__ __forceinline__ unsigned f2bf(float f) { unsigned u = __builtin_bit_cast(unsigned, f); return (u + 0x7fffu + ((u >> 16) & 1u)) >> 16; }
__device__ __forceinline__ unsigned pk2(float lo, float hi) { return f2bf(lo) | (f2bf(hi) << 16); }
__device__ __forceinline__ float bf_lo(unsigned w) { return __builtin_bit_cast(float, w << 16); }
__device__ __forceinline__ float bf_hi(unsigned w) { return __builtin_bit_cast(float, w & 0xffff0000u); }

#define XB_TMO      128
#define XB_XCNT(j)  (256  + 64 * (j))
#define XB_XSUB(j)  (1280 + 64 * (j))
#define XB_XGEN(j)  (2304 + 64 * (j))
#define XB_TOP      3328
#define XB_TOPGEN   3392
#define XCD_BAR_WORDS 3456
#define XB_SPIN_CAP (1u << 18)
__device__ __forceinline__ unsigned xb_ld(unsigned* p)              { return __hip_atomic_load(p, __ATOMIC_RELAXED, __HIP_MEMORY_SCOPE_AGENT); }
__device__ __forceinline__ unsigned xb_add(unsigned* p, unsigned v) { return __hip_atomic_fetch_add(p, v, __ATOMIC_RELAXED, __HIP_MEMORY_SCOPE_AGENT); }
__device__ __forceinline__ unsigned xb_xcc_id() { return (unsigned)__builtin_amdgcn_s_getreg((3 << 11) | 20) & 0xFu; }
#define XB_SPIN(cond, bar) do { unsigned _sp = 0; while (cond) { __builtin_amdgcn_s_sleep(1); \
    if ((++_sp & 255u) == 0u) { if (xb_ld(&(bar)[XB_TMO])) break; if (_sp > XB_SPIN_CAP) { atomicAdd(&(bar)[XB_TMO], 1u); break; } } } } while (0)
struct XcdBarrier { unsigned* bar; unsigned x; volatile LAS unsigned* st; };
__device__ __forceinline__ XcdBarrier xcd_barrier_post(unsigned* bar, volatile LAS unsigned* st) {
    XcdBarrier b; b.bar = bar; b.x = xb_xcc_id(); b.st = st;
    if (threadIdx.x == 0) (void)xb_add(&bar[XB_XCNT(b.x)], 1u);
    return b;
}
__device__ __forceinline__ void xcd_barrier_complete(unsigned* bar, unsigned x, unsigned& nloc, unsigned& nx) {
    const unsigned G = gridDim.x * gridDim.y * gridDim.z;
    unsigned sum, cnt, mine, sp = 0u;
    for (;;) {
        sum = 0u; cnt = 0u; mine = 0u;
#pragma unroll
        for (unsigned j = 0; j < 16; ++j) { const unsigned c = xb_ld(&bar[XB_XCNT(j)]); sum += c; cnt += (c > 0u) ? 1u : 0u; mine = (j == x) ? c : mine; }
        if (sum == G) break;
        __builtin_amdgcn_s_sleep(1);
        if ((++sp & 255u) == 0u) { if (xb_ld(&bar[XB_TMO])) break; if (sp > XB_SPIN_CAP) { atomicAdd(&bar[XB_TMO], 1u); break; } }
    }
    nloc = mine > 0u ? mine : 1u; nx = cnt > 0u ? cnt : 1u;
}
__device__ __forceinline__ void xcd_barrier(const XcdBarrier& b) {
    asm volatile("s_waitcnt vmcnt(0)" ::: "memory");
    __syncthreads();
    if (threadIdx.x == 0) {
        unsigned* bar = b.bar; asm volatile("" : "+s"(bar));
        __builtin_amdgcn_s_waitcnt(0);
        unsigned nloc = b.st[0], nx = b.st[1];
        const unsigned bx = xb_xcc_id();
        if (nloc == 0u) { xcd_barrier_complete(bar, bx, nloc, nx); b.st[0] = nloc; b.st[1] = nx; }
        const unsigned old = xb_add(&bar[XB_XSUB(bx)], 1u);
        const unsigned gen = old / nloc;
        if (old + 1u == (gen + 1u) * nloc) {
            __builtin_amdgcn_fence(__ATOMIC_RELEASE, "agent");
            asm volatile("s_waitcnt vmcnt(0)" ::: "memory");
            const unsigned og = xb_add(&bar[XB_TOP], 1u);
            const unsigned tg = og / nx;
            if (og + 1u == (tg + 1u) * nx) xb_add(&bar[XB_TOPGEN], 1u);
            else XB_SPIN(xb_ld(&bar[XB_TOPGEN]) == tg, bar);
            __builtin_amdgcn_fence(__ATOMIC_ACQUIRE, "agent");
            xb_add(&bar[XB_XGEN(bx)], 1u);
            asm volatile("s_waitcnt vmcnt(0)" ::: "memory");
        } else {
            XB_SPIN(xb_ld(&bar[XB_XGEN(bx)]) == gen, bar);
            __builtin_amdgcn_fence(__ATOMIC_ACQUIRE, "agent");
            asm volatile("s_waitcnt vmcnt(0)" ::: "memory");
        }
    }
    __syncthreads();
}

__device__ __forceinline__ float wave_sum(float v) {
#pragma unroll
    for (int o = 1; o < 64; o <<= 1) v += __shfl_xor(v, o);
    return v;
}

__device__ __forceinline__ void tr_item(const float* __restrict__ src, int sld, bf16* __restrict__ dst, int K  , int k0, LAS float* scr, int lane) {
    const GAS float* s = (const GAS float*)src + (size_t)(k0 + (lane >> 4)) * sld + (lane & 15) * 4;
    f32x4 v[16];
#pragma unroll
    for (int it = 0; it < 16; ++it) v[it] = *(const GAS f32x4*)(s + (size_t)(4 * it) * sld);
#pragma unroll
    for (int it = 0; it < 16; ++it) { LAS float* w = scr + ((lane >> 4) + 4 * it) * 65 + (lane & 15) * 4; w[0] = v[it].x; w[1] = v[it].y; w[2] = v[it].z; w[3] = v[it].w; }
    LDS_WAIT(); asm volatile("" ::: "memory");
    const int c = lane >> 3, n1 = lane & 7;
#pragma unroll
    for (int jj = 0; jj < 8; ++jj) { const int n = n1 + 8 * jj; const LAS float* r = scr + (8 * c) * 65 + n;
        v4u o; o.x = pk2(r[0], r[65]); o.y = pk2(r[2 * 65], r[3 * 65]); o.z = pk2(r[4 * 65], r[5 * 65]); o.w = pk2(r[6 * 65], r[7 * 65]);
        *(GAS v4u*)(dst + (size_t)n * K + k0 + 8 * c) = o; }
    LDS_WAIT(); asm volatile("" ::: "memory");
}

struct Args { const float* in[18]; float* out; unsigned char* ws; };
typedef const __attribute__((address_space(4))) Args CArgs;
__device__ __forceinline__ CArgs* fresh_args() { CArgs* p = (CArgs*)__builtin_amdgcn_kernarg_segment_ptr(); asm volatile("" : "+s"(p)); return p; }

constexpr int CI_FFNIN = (D / 64) * (NFF / 64), CI_FFNOUT = (DFF / 64) * (D / 64), CI_MIXIN = (D / 64) * (NMIX / 64), CI_QKV = (D / 64) * (NQKV / 64), CI_SQ = (D / 64) * (D / 64), CI_POOLW = 4 * 16;
constexpr int CI_EVEN = 2 * (CI_FFNIN + CI_FFNOUT) + CI_MIXIN + CI_POOLW + CI_SQ, CI_ODD = 2 * (CI_FFNIN + CI_FFNOUT) + CI_QKV + CI_SQ, CI_PAIR = CI_EVEN + CI_ODD, IT_TOTAL = 2 * CI_PAIR;
__device__ __forceinline__ int conv_seg_start(int l, int seg) {
    const int odd = l & 1; int o = (l >> 1) * CI_PAIR + (odd ? CI_EVEN : 0);
    const int sz[7] = {CI_FFNIN, CI_FFNOUT, odd ? CI_QKV : CI_MIXIN, odd ? 0 : CI_POOLW, CI_SQ, CI_FFNIN, CI_FFNOUT};
#pragma unroll
    for (int i = 0; i < 7; ++i) o += (i < seg) ? sz[i] : 0;
    return o;
}
__device__ __forceinline__ void conv_item(CArgs* ap, int it, LAS float* scr, int lane) {
    bf16* W = (bf16*)(ap->ws + WS_W);
    int l = 2 * (it / CI_PAIR), r = it % CI_PAIR; if (r >= CI_EVEN) { r -= CI_EVEN; l += 1; }
    const int odd = l & 1, j = l >> 1;
    int hl = 2 * l, kind;
    if (r < CI_FFNIN) kind = 0;
    else if ((r -= CI_FFNIN) < CI_FFNOUT) kind = 1;
    else if ((r -= CI_FFNOUT) < (odd ? CI_QKV : CI_MIXIN)) kind = odd ? 3 : 2;
    else if ((r -= (odd ? CI_QKV : CI_MIXIN)) < (odd ? 0 : CI_POOLW)) kind = 4;
    else if ((r -= (odd ? 0 : CI_POOLW)) < CI_SQ) kind = odd ? 6 : 5;
    else if ((r -= CI_SQ) < CI_FFNIN) { kind = 0; hl += 1; }
    else { r -= CI_FFNIN; kind = 1; hl += 1; }
    if (kind == 0) { constexpr int nbn = NFF / 64; const int kb = r / nbn, nb = r % nbn;
        const int n0 = nb * 64, tile = n0 >> 8, w = n0 & 255, scol = (w < 128) ? tile * 128 + w : DFF + tile * 128 + (w - 128);
        tr_item(ap->in[7] + (size_t)hl * D * NFF + scol, NFF, W + WO_FFNIN + (size_t)hl * SZ_FFNIN + (size_t)n0 * D, D, kb * 64, scr, lane); }
    else if (kind == 1) { constexpr int nbn = D / 64; const int kb = r / nbn, nb = r % nbn;
        tr_item(ap->in[8] + (size_t)hl * DFF * D + nb * 64, D, W + WO_FFNOUT + (size_t)hl * SZ_FFNOUT + (size_t)(nb * 64) * DFFP, DFFP, kb * 64, scr, lane); }
    else if (kind == 2) { constexpr int nbn = NMIX / 64; const int kb = r / nbn, nb = r % nbn;
        tr_item(ap->in[9] + (size_t)j * D * NMIX + nb * 64, NMIX, W + WO_MIXIN + (size_t)j * SZ_MIXIN + (size_t)(nb * 64) * D, D, kb * 64, scr, lane); }
    else if (kind == 3) { constexpr int nbn = NQKV / 64; const int kb = r / nbn, nb = r % nbn;
        tr_item(ap->in[14] + (size_t)j * D * NQKV + nb * 64, NQKV, W + WO_QKV + (size_t)j * SZ_QKV + (size_t)(nb * 64) * D, D, kb * 64, scr, lane); }
    else if (kind == 4) { const int mat = j * 4 + (r >> 4), rr = r & 15, kb = rr >> 2, nb = rr & 3;
        tr_item(ap->in[11] + (size_t)mat * 65536 + nb * 64, 256, W + WO_POOLW + (size_t)mat * 65536 + (size_t)(nb * 64) * 256, 256, kb * 64, scr, lane); }
    else { constexpr int nbn = D / 64; const int kb = r / nbn, nb = r % nbn;
        if (kind == 5) tr_item(ap->in[13] + (size_t)j * D * D + nb * 64, D, W + WO_MIXOUT + (size_t)j * SZ_MIXOUT + (size_t)(nb * 64) * D, D, kb * 64, scr, lane);
        else tr_item(ap->in[15] + (size_t)j * D * D + nb * 64, D, W + WO_WO + (size_t)j * SZ_WO + (size_t)(nb * 64) * D, D, kb * 64, scr, lane); }
}
__device__ __forceinline__ void conv_range(CArgs* ap, LAS unsigned char* lds, int lo, int hi, int w, int nworkers, int wave, int lane) {
    LAS float* scr = (LAS float*)(lds + wave * 16640);
    for (int it = lo + w; it < hi; it += nworkers) conv_item(ap, it, scr, lane);
}

__device__ __forceinline__ void prologue(CArgs* ap, LAS unsigned char* lds, int gw, int NGW, int wave, int lane) {
    struct { const float* in[18]; float* out; unsigned char* ws; } a;
    a.in[0] = ap->in[0]; a.in[1] = ap->in[1]; a.in[6] = ap->in[6]; a.out = ap->out; a.ws = ap->ws;
    bf16* W = (bf16*)(a.ws + WS_W);
    for (int r = gw * 4 + (lane >> 4); r < 8 * D + M; r += NGW * 4) {
        bf16* p = r < 8 * D ? W + WO_FFNOUT + (size_t)r * DFFP + DFF : (bf16*)(a.ws + WS_ACT) + (size_t)(r - 8 * D) * DFFP + DFF;
        *(GAS v4u*)(p + (lane & 15) * 8) = (v4u){0u, 0u, 0u, 0u}; }
    const GAS f32x4* g4 = (const GAS f32x4*)a.in[6];
    for (int row = gw; row < M; row += NGW) {
        const float* xr = row < MP ? a.in[0] + (size_t)row * D : a.in[1] + (size_t)(row - MP) * D;
        const GAS f32x4* x4 = (const GAS f32x4*)xr + lane;
        f32x4 v[8]; float ss = 0.f;
#pragma unroll
        for (int j = 0; j < 8; ++j) { v[j] = x4[64 * j]; ss += (v[j].x * v[j].x + v[j].y * v[j].y) + (v[j].z * v[j].z + v[j].w * v[j].w); }
        const float rs = 1.0f / sqrtf(wave_sum(ss) * (1.f / D) + EPS);
        GAS f32x4* xo = (GAS f32x4*)(a.out + (size_t)row * D) + lane;
        GAS v2u* ho = (GAS v2u*)((bf16*)(a.ws + WS_HB) + (size_t)row * D) + lane;
#pragma unroll
        for (int j = 0; j < 8; ++j) { xo[64 * j] = v[j]; const f32x4 g = g4[lane + 64 * j];
            v2u o; o.x = pk2(v[j].x * rs * g.x, v[j].y * rs * g.y); o.y = pk2(v[j].z * rs * g.z, v[j].w * rs * g.w); ho[64 * j] = o; }
    }
}

__device__ __forceinline__ void norm_row(f32x4 (&y)[8], float* X, bf16* HB, float sc, const GAS f32x4* ga4, const GAS f32x4* gb4, int row, int lane) {
    GAS f32x4* x4 = (GAS f32x4*)(X + (size_t)row * D) + lane;
    f32x4 x[8]; float ss = 0.f;
#pragma unroll
    for (int j = 0; j < 8; ++j) x[j] = x4[64 * j];
#pragma unroll
    for (int j = 0; j < 8; ++j) ss += (y[j].x * y[j].x + y[j].y * y[j].y) + (y[j].z * y[j].z + y[j].w * y[j].w);
    const float r1 = sc / sqrtf(wave_sum(ss) * (1.f / D) + EPS);
    float s2 = 0.f;
#pragma unroll
    for (int j = 0; j < 8; ++j) { const f32x4 g = ga4[lane + 64 * j]; x[j] = x[j] + y[j] * g * r1; x4[64 * j] = x[j];
        s2 += (x[j].x * x[j].x + x[j].y * x[j].y) + (x[j].z * x[j].z + x[j].w * x[j].w); }
    if (gb4) {
        const float r2 = 1.0f / sqrtf(wave_sum(s2) * (1.f / D) + EPS);
        GAS v2u* ho = (GAS v2u*)(HB + (size_t)row * D) + lane;
#pragma unroll
        for (int j = 0; j < 8; ++j) { const f32x4 g = gb4[lane + 64 * j];
            v2u o; o.x = pk2(x[j].x * r2 * g.x, x[j].y * r2 * g.y); o.y = pk2(x[j].z * r2 * g.z, x[j].w * r2 * g.w); ho[64 * j] = o; }
    }
}
template <int NSL>
__device__ __forceinline__ void norm_phase(const bf16* Y, const float* YP, float* X, bf16* HB, float sc, const float* ga, const float* gb, int gw, int NGW, int lane) {
    const GAS f32x4* ga4 = (const GAS f32x4*)ga; const GAS f32x4* gb4 = (const GAS f32x4*)gb;
    if ((gw & 7) == 0) {
        for (int r = gw >> 3; r < MS; r += (NGW >> 3)) {
            const GAS f32x4* p4 = (const GAS f32x4*)(YP + (size_t)r * D) + lane;
            f32x4 y[8];
#pragma unroll
            for (int j = 0; j < 8; ++j) { f32x4 pv[NSL];
#pragma unroll
                for (int i = 0; i < NSL; ++i) pv[i] = p4[(size_t)i * (256 * D / 4) + 64 * j];
                f32x4 a = pv[0];
#pragma unroll
                for (int i = 1; i < NSL; ++i) a = a + pv[i];
                y[j] = a; }
            norm_row(y, X, HB, sc, ga4, gb4, MP + r, lane);
        }
    }
    for (int row = gw; row < MP; row += NGW) {
        const GAS v2u* y2 = (const GAS v2u*)(Y + (size_t)row * D) + lane;
        f32x4 y[8];
#pragma unroll
        for (int j = 0; j < 8; ++j) { const v2u w = y2[64 * j]; y[j] = (f32x4){bf_lo(w.x), bf_hi(w.x), bf_lo(w.y), bf_hi(w.y)}; }
        norm_row(y, X, HB, sc, ga4, gb4, row, lane);
    }
}

__device__ __forceinline__ unsigned ldz(const bf16* Zb, unsigned off) { return *(const GAS unsigned*)((const GAS char*)Zb + off); }
__device__ __forceinline__ void convpool_phase(CArgs* ap, int j, int bid, int G, int tid) {
    const bf16* Z = (const bf16*)(ap->ws + WS_Z); bf16* CAT = (bf16*)(ap->ws + WS_CAT); bf16* DP = (bf16*)(ap->ws + WS_DP);
    const int c = 2 * tid, gi = tid >> 7, w = 2 << gi;
    const float* cw = ap->in[10] + (size_t)j * 3 * DCV + c;
    const f32x2 w0 = *(const f32x2*)cw, w1 = *(const f32x2*)(cw + DCV), w2 = *(const f32x2*)(cw + 2 * DCV);
    float* out = ap->out;
    for (int u = bid; u < 256 + DB; u += G) {
        if (u < 256) {
            const int b = u >> 6, t0 = (u & 63) * 32; const int rb = b * SEQ;
            const bf16* Zb = Z + (size_t)rb * NMIX; bf16* Cb = CAT + (size_t)rb * D; bf16* Db = DP + (size_t)rb * DCV;
            f32x2 vm2 = {0.f, 0.f}, vm1 = {0.f, 0.f}, S = {0.f, 0.f};
            if (t0 > 0) {
                { const unsigned o = (unsigned)((t0 - 2) * NMIX + c) * 2u; const unsigned h = ldz(Zb, o), g = ldz(Zb, o + 2048u); vm2 = (f32x2){bf_lo(h) * bf_lo(g), bf_hi(h) * bf_hi(g)}; }
                { const unsigned o = (unsigned)((t0 - 1) * NMIX + c) * 2u; const unsigned h = ldz(Zb, o), g = ldz(Zb, o + 2048u); vm1 = (f32x2){bf_lo(h) * bf_lo(g), bf_hi(h) * bf_hi(g)}; }
                for (int i = 1; i <= w; ++i) { const unsigned uu = ldz(Zb, (unsigned)((t0 - i) * NMIX + 3072 + c) * 2u); S.x += bf_lo(uu); S.y += bf_hi(uu); }
            }
            const bool lastc = (t0 == SEQ - 32);
#pragma unroll 2
            for (int t = t0; t < t0 + 32; ++t) {
                const unsigned o = (unsigned)(t * NMIX + c) * 2u;
                const unsigned hh = ldz(Zb, o), gg = ldz(Zb, o + 2048u), bb = ldz(Zb, o + 4096u), uu = ldz(Zb, o + 6144u);
                unsigned uo = 0u; if (t >= w) uo = ldz(Zb, (unsigned)((t - w) * NMIX + 3072 + c) * 2u);
                const f32x2 v = {bf_lo(hh) * bf_lo(gg), bf_hi(hh) * bf_hi(gg)};
                const f32x2 yc = w0 * vm2 + w1 * vm1 + w2 * v; vm2 = vm1; vm1 = v;
                const f32x2 ut = {bf_lo(uu), bf_hi(uu)};
                S.x += ut.x - bf_lo(uo); S.y += ut.y - bf_hi(uo);
                const float cnt = (float)((t + 1 < w) ? (t + 1) : w);
                const f32x2 dd = S / cnt - ut;
                *(GAS unsigned*)((GAS char*)Cb + (unsigned)(t * D + c) * 2u) = pk2(bf_lo(bb) * yc.x, bf_hi(bb) * yc.y);
                *(GAS unsigned*)((GAS char*)Db + (unsigned)(t * DCV + c) * 2u) = pk2(dd.x, dd.y);
                if (lastc) {
                    if (t >= SEQ - 2) *(GAS f32x2*)((GAS char*)(out + O_CONVP + (size_t)(j * NB + b) * 2 * DCV) + (unsigned)((t - (SEQ - 2)) * DCV + c) * 4u) = v;
                    if (t >= SEQ - PCTX) *(GAS f32x2*)((GAS char*)(out + O_POOLP + (size_t)(j * NB + b) * PCTX * DCV) + (unsigned)((t - (SEQ - PCTX)) * DCV + c) * 4u) = ut;
                }
            }
        } else {
            const int b = u - 256; const int rb = MP + b * DS;
            const bf16* Zb = Z + (size_t)rb * NMIX; bf16* Cb = CAT + (size_t)rb * D; bf16* Db = DP + (size_t)rb * DCV;
            const GAS char* cc = (const GAS char*)(ap->in[2] + (size_t)(j * DB + b) * 2 * DCV);
            const GAS char* pc = (const GAS char*)(ap->in[3] + (size_t)(j * DB + b) * PCTX * DCV);
            GAS char* pso = (GAS char*)(out + O_POOLS + (size_t)(j * DB + b) * PCTX * DCV);
            GAS char* cso = (GAS char*)(out + O_CONVS + (size_t)(j * DB + b) * 2 * DCV);
            const unsigned c4 = (unsigned)c * 4u;
            f32x2 vm2 = *(const GAS f32x2*)(cc + c4), vm1 = *(const GAS f32x2*)(cc + c4 + DCV * 4u), S = {0.f, 0.f};
            for (int i = 1; i <= w && i <= PCTX; ++i) { const f32x2 p = *(const GAS f32x2*)(pc + c4 + (unsigned)(PCTX - i) * (DCV * 4u)); S += p; }
            for (int i = 0; i < PCTX - DS; ++i) *(GAS f32x2*)(pso + c4 + (unsigned)i * (DCV * 4u)) = *(const GAS f32x2*)(pc + c4 + (unsigned)(DS + i) * (DCV * 4u));
            for (int t = 0; t < DS; ++t) {
                const unsigned o = (unsigned)(t * NMIX + c) * 2u;
                const unsigned hh = ldz(Zb, o), gg = ldz(Zb, o + 2048u), bb = ldz(Zb, o + 4096u), uu = ldz(Zb, o + 6144u);
                f32x2 uo = {0.f, 0.f};
                if (t - w >= 0) { const unsigned uw = ldz(Zb, (unsigned)((t - w) * NMIX + 3072 + c) * 2u); uo = (f32x2){bf_lo(uw), bf_hi(uw)}; }
                else if (t - w >= -PCTX) uo = *(const GAS f32x2*)(pc + c4 + (unsigned)(PCTX + t - w) * (DCV * 4u));
                const f32x2 v = {bf_lo(hh) * bf_lo(gg), bf_hi(hh) * bf_hi(gg)};
                const f32x2 yc = w0 * vm2 + w1 * vm1 + w2 * v; vm2 = vm1; vm1 = v;
                const f32x2 ut = {bf_lo(uu), bf_hi(uu)};
                S += ut - uo;
                const f32x2 dd = S / (float)w - ut;
                *(GAS unsigned*)((GAS char*)Cb + (unsigned)(t * D + c) * 2u) = pk2(bf_lo(bb) * yc.x, bf_hi(bb) * yc.y);
                *(GAS unsigned*)((GAS char*)Db + (unsigned)(t * DCV + c) * 2u) = pk2(dd.x, dd.y);
                if (t >= DS - 2) *(GAS f32x2*)(cso + c4 + (unsigned)(t - (DS - 2)) * (DCV * 4u)) = v;
                *(GAS f32x2*)(pso + c4 + (unsigned)(PCTX - DS + t) * (DCV * 4u)) = ut;
            }
        }
    }
}

constexpr int AT_KP = 144, AT_VP = 520;
constexpr int AT_K = 0, AT_V = 256 * AT_KP, AT_B = AT_V + 64 * AT_VP, AT_END = AT_B + NHEAD * 192 * 4;
static_assert(AT_END <= RING_BYTES && (AT_V % 16) == 0 && (AT_B % 16) == 0, "attention LDS map");
__device__ __forceinline__ int crow(int r, int hi) { return (r & 3) + 8 * (r >> 2) + 4 * hi; }

__device__ __forceinline__ void attention_phase(CArgs* ap, LAS unsigned char* lds, int j, int bid, int G, int tid, int wave, int lane_in) {
    const bf16* QKV = (const bf16*)(ap->ws + WS_Z); bf16* ATT = (bf16*)(ap->ws + WS_CAT);
    float* out = ap->out; const float* relb = ap->in[17]; const float* ck = ap->in[4]; const float* cv = ap->in[5]; const float* sinks = ap->in[16];
    LAS float* biasL = (LAS float*)(lds + AT_B);
    for (int e = tid; e < NHEAD * 192; e += NWAVES * 64) {
        const int h = e / 192, dist = e % 192 - 32; float v = -1e30f;
        if (dist >= 0 && dist <= 128) { int bk = dist;
            if (dist >= 16) { const float ratio = logf((float)dist / 16.0f) / 2.0794415416798357f; bk = 16 + (int)(ratio * 16.0f); if (bk > 31) bk = 31; }
            v = relb[bk * NHEAD + h] * LOG2E; }
        biasL[e] = v;
    }
    const float CS = 0.125f * LOG2E;
    for (int u = bid; u < 256 + DB * NKVH; u += G) {
        __syncthreads();
        asm volatile("" : "+v"(tid));
        const bool prompt = u < 256;
        int b, kvh, row0; bool first = false, lastb = false;
        if (prompt) { b = u >> 6; kvh = (u >> 4) & 3; const int qb = u & 15; row0 = b * SEQ + qb * 128; first = (qb == 0); lastb = (qb == 15); }
        else { const int su = u - 256; b = su >> 2; kvh = su & 3; row0 = MP + b * DS; }
        if (prompt) {
#pragma unroll
            for (int it = 0; it < 4; ++it) { const int id = it * 512 + tid, row = id >> 3, ch = id & 7;
                v4u kv = {0u, 0u, 0u, 0u}, vv = {0u, 0u, 0u, 0u};
                if (!(first && row < 128)) { const bf16* src = QKV + (size_t)(row0 - 128 + row) * NQKV + 2048 + kvh * 64 + ch * 8; kv = *(const GAS v4u*)src; vv = *(const GAS v4u*)(src + 256); }
                *(LAS v4u*)(lds + AT_K + row * AT_KP + ch * 16) = kv;
                LAS bf16* vt = (LAS bf16*)(lds + AT_V + (ch * 8) * AT_VP) + row;
                vt[0] = (bf16)(vv.x & 0xffff); vt[AT_VP / 2] = (bf16)(vv.x >> 16); vt[2 * (AT_VP / 2)] = (bf16)(vv.y & 0xffff); vt[3 * (AT_VP / 2)] = (bf16)(vv.y >> 16);
                vt[4 * (AT_VP / 2)] = (bf16)(vv.z & 0xffff); vt[5 * (AT_VP / 2)] = (bf16)(vv.z >> 16); vt[6 * (AT_VP / 2)] = (bf16)(vv.w & 0xffff); vt[7 * (AT_VP / 2)] = (bf16)(vv.w >> 16);
                if (lastb && row >= 128) { const size_t o = ((size_t)(j * NB + b) * KVB + (row - 128)) * 256 + kvh * 64 + ch * 8;
                    *(f32x4*)(out + O_KP + o) = (f32x4){bf_lo(kv.x), bf_hi(kv.x), bf_lo(kv.y), bf_hi(kv.y)}; *(f32x4*)(out + O_KP + o + 4) = (f32x4){bf_lo(kv.z), bf_hi(kv.z), bf_lo(kv.w), bf_hi(kv.w)};
                    *(f32x4*)(out + O_VP + o) = (f32x4){bf_lo(vv.x), bf_hi(vv.x), bf_lo(vv.y), bf_hi(vv.y)}; *(f32x4*)(out + O_VP + o + 4) = (f32x4){bf_lo(vv.z), bf_hi(vv.z), bf_lo(vv.w), bf_hi(vv.w)}; }
            }
        } else {
#pragma unroll
            for (int it = 0; it < 3; ++it) { const int id = it * 512 + tid, row = id >> 3, ch = id & 7;
                if (row < 160) {
                    v4u kv = {0u, 0u, 0u, 0u}, vv = {0u, 0u, 0u, 0u};
                    f32x4 k0 = {0.f, 0.f, 0.f, 0.f}, k1 = k0, v0 = k0, v1 = k0;
                    if (row < 128) { const size_t so = ((size_t)(j * DB + b) * KVB + row) * 256 + kvh * 64 + ch * 8;
                        k0 = *(const f32x4*)(ck + so); k1 = *(const f32x4*)(ck + so + 4); v0 = *(const f32x4*)(cv + so); v1 = *(const f32x4*)(cv + so + 4);
                        kv = (v4u){pk2(k0.x, k0.y), pk2(k0.z, k0.w), pk2(k1.x, k1.y), pk2(k1.z, k1.w)}; vv = (v4u){pk2(v0.x, v0.y), pk2(v0.z, v0.w), pk2(v1.x, v1.y), pk2(v1.z, v1.w)}; }
                    else if (row < 128 + DS) { const bf16* src = QKV + (size_t)(row0 + row - 128) * NQKV + 2048 + kvh * 64 + ch * 8; kv = *(const GAS v4u*)src; vv = *(const GAS v4u*)(src + 256);
                        k0 = (f32x4){bf_lo(kv.x), bf_hi(kv.x), bf_lo(kv.y), bf_hi(kv.y)}; k1 = (f32x4){bf_lo(kv.z), bf_hi(kv.z), bf_lo(kv.w), bf_hi(kv.w)};
                        v0 = (f32x4){bf_lo(vv.x), bf_hi(vv.x), bf_lo(vv.y), bf_hi(vv.y)}; v1 = (f32x4){bf_lo(vv.z), bf_hi(vv.z), bf_lo(vv.w), bf_hi(vv.w)}; }
                    *(LAS v4u*)(lds + AT_K + row * AT_KP + ch * 16) = kv;
                    LAS bf16* vt = (LAS bf16*)(lds + AT_V + (ch * 8) * AT_VP) + row;
                    vt[0] = (bf16)(vv.x & 0xffff); vt[AT_VP / 2] = (bf16)(vv.x >> 16); vt[2 * (AT_VP / 2)] = (bf16)(vv.y & 0xffff); vt[3 * (AT_VP / 2)] = (bf16)(vv.y >> 16);
                    vt[4 * (AT_VP / 2)] = (bf16)(vv.z & 0xffff); vt[5 * (AT_VP / 2)] = (bf16)(vv.z >> 16); vt[6 * (AT_VP / 2)] = (bf16)(vv.w & 0xffff); vt[7 * (AT_VP / 2)] = (bf16)(vv.w >> 16);
                    if (row >= DS && row < 128 + DS) { const size_t o = ((size_t)(j * DB + b) * KVB + (row - DS)) * 256 + kvh * 64 + ch * 8;
                        *(f32x4*)(out + O_KS + o) = k0; *(f32x4*)(out + O_KS + o + 4) = k1; *(f32x4*)(out + O_VS + o) = v0; *(f32x4*)(out + O_VS + o + 4) = v1; }
                }
            }
        }
        LDS_WAIT();
        __syncthreads();
        const int lane = tid & 63, l31 = lane & 31, hi = lane >> 5;
        const int h = kvh * 8 + wave;
        const float sink2 = sinks[j * NHEAD + h] * LOG2E;
        const LAS float* bl = biasL + h * 192 + 160 + l31 - 4 * hi;
        const int nsub = prompt ? 4 : 1;
        bf16x8 qn[4];
        { const int qrow0 = prompt ? (row0 + l31) : (row0 + (l31 & 7));
#pragma unroll
          for (int k0 = 0; k0 < 4; ++k0) qn[k0] = *(const GAS bf16x8*)(QKV + (size_t)qrow0 * NQKV + h * 64 + 16 * k0 + 8 * hi); }
        for (int sub = 0; sub < nsub; ++sub) {
            const int qrow = prompt ? (row0 + 32 * sub + l31) : (row0 + (l31 & 7));
            bf16x8 qr[4];
#pragma unroll
            for (int k0 = 0; k0 < 4; ++k0) qr[k0] = qn[k0];
            if (sub + 1 < nsub) {
#pragma unroll
                for (int k0 = 0; k0 < 4; ++k0) qn[k0] = *(const GAS bf16x8*)(QKV + (size_t)(qrow + 32) * NQKV + h * 64 + 16 * k0 + 8 * hi); }
            f32x16 acc[5];
#pragma unroll
            for (int jt = 0; jt < 5; ++jt) {
                const int T = sub + jt;
                f32x16 c = {0.f, 0.f, 0.f, 0.f, 0.f, 0.f, 0.f, 0.f, 0.f, 0.f, 0.f, 0.f, 0.f, 0.f, 0.f, 0.f};
#pragma unroll
                for (int k0 = 0; k0 < 4; ++k0) { const bf16x8 kf = *(const LAS bf16x8*)(lds + AT_K + (32 * T + l31) * AT_KP + (16 * k0 + 8 * hi) * 2);
                    c = __builtin_amdgcn_mfma_f32_32x32x16_bf16(kf, qr[k0], c, 0, 0, 0); }
                acc[jt] = c;
            }
            float mx = -1e30f;
#pragma unroll
            for (int jt = 0; jt < 5; ++jt) {
                const float tm = (first && (sub + jt) < 4) ? -1e30f : 0.f;
#pragma unroll
                for (int r = 0; r < 16; ++r) { const float s = acc[jt][r] * CS + (bl[-32 * jt - ((r & 3) + 8 * (r >> 2))] + tm); acc[jt][r] = s; mx = fmaxf(mx, s); }
            }
            mx = fmaxf(mx, __shfl_xor(mx, 32));
            mx = fmaxf(mx, sink2);
            float ls = 0.f;
#pragma unroll
            for (int jt = 0; jt < 5; ++jt)
#pragma unroll
                for (int r = 0; r < 16; ++r) { const float p = __builtin_amdgcn_exp2f(acc[jt][r] - mx); acc[jt][r] = p; ls += p; }
            ls += __shfl_xor(ls, 32);
            ls += __builtin_amdgcn_exp2f(sink2 - mx);
            f32x16 o0 = {0.f, 0.f, 0.f, 0.f, 0.f, 0.f, 0.f, 0.f, 0.f, 0.f, 0.f, 0.f, 0.f, 0.f, 0.f, 0.f}, o1 = o0;
#pragma unroll
            for (int jt = 0; jt < 5; ++jt) {
                const int T = sub + jt;
#pragma unroll
                for (int c2 = 0; c2 < 2; ++c2) {
                    v4u pw; pw.x = pk2(acc[jt][8 * c2 + 0], acc[jt][8 * c2 + 1]); pw.y = pk2(acc[jt][8 * c2 + 2], acc[jt][8 * c2 + 3]); pw.z = pk2(acc[jt][8 * c2 + 4], acc[jt][8 * c2 + 5]); pw.w = pk2(acc[jt][8 * c2 + 6], acc[jt][8 * c2 + 7]);
                    const bf16x8 pf = __builtin_bit_cast(bf16x8, pw);
                    const LAS unsigned char* vb = lds + AT_V + l31 * AT_VP + (32 * T + 16 * c2 + 4 * hi) * 2;
                    { const s16x4 lo = *(const LAS s16x4*)vb, hh = *(const LAS s16x4*)(vb + 16); const bf16x8 vf = {lo[0], lo[1], lo[2], lo[3], hh[0], hh[1], hh[2], hh[3]};
                      o0 = __builtin_amdgcn_mfma_f32_32x32x16_bf16(vf, pf, o0, 0, 0, 0); }
                    { const s16x4 lo = *(const LAS s16x4*)(vb + 32 * AT_VP), hh = *(const LAS s16x4*)(vb + 32 * AT_VP + 16); const bf16x8 vf = {lo[0], lo[1], lo[2], lo[3], hh[0], hh[1], hh[2], hh[3]};
                      o1 = __builtin_amdgcn_mfma_f32_32x32x16_bf16(vf, pf, o1, 0, 0, 0); }
                }
            }
            const float inv = 1.0f / ls;
            if (prompt || l31 < DS) {
                bf16* orow = ATT + (size_t)(prompt ? qrow : (row0 + l31)) * D + h * 64 + 4 * hi;
#pragma unroll
                for (int rq = 0; rq < 4; ++rq) {
                    v2u w0; w0.x = pk2(o0[4 * rq] * inv, o0[4 * rq + 1] * inv); w0.y = pk2(o0[4 * rq + 2] * inv, o0[4 * rq + 3] * inv); *(GAS v2u*)(orow + 8 * rq) = w0;
                    v2u w1; w1.x = pk2(o1[4 * rq] * inv, o1[4 * rq + 1] * inv); w1.y = pk2(o1[4 * rq + 2] * inv, o1[4 * rq + 3] * inv); *(GAS v2u*)(orow + 32 + 8 * rq) = w1;
                }
            }
        }
    }
    __syncthreads();
}

__global__ void __launch_bounds__(NWAVES * 64, 2) mega_fwd(Args args) {
    extern __shared__ __attribute__((aligned(16))) unsigned char lds_raw[];
    LAS unsigned char* lds = (LAS unsigned char*)lds_raw;
    const int tid = threadIdx.x, lane = tid & 63, wave = __builtin_amdgcn_readfirstlane(tid >> 6);
    const int G = gridDim.x, bid = blockIdx.x;
    const int vcu = (G % 8 == 0) ? (bid % 8) * (G / 8) + bid / 8 : bid;
    const int gw = vcu * NWAVES + wave, NGW = G * NWAVES;
    CArgs* ap0 = fresh_args();
    for (int u = tid; u < (LDS_BYTES - LDSCTL_OFF) / 4; u += NWAVES * 64) ((LAS unsigned*)(lds + LDSCTL_OFF))[u] = 0u;
    __syncthreads();
    XcdBarrier bar = xcd_barrier_post((unsigned*)(ap0->ws + WS_CTL) + CW_BAR, (volatile LAS unsigned*)(lds + MISC_OFF) + 8);
#define GRID_BAR() xcd_barrier(bar)
#define FRESH_TID() int tid_ = threadIdx.x; asm volatile("" : "+v"(tid_)); const int lane_ = tid_ & 63, wave_ = __builtin_amdgcn_readfirstlane(tid_ >> 6), gw_ = vcu * NWAVES + wave_; (void)lane_; (void)gw_

    int cursor = 0;
#define ENSURE(need) do { const int need_ = (need); if (cursor < need_) { FRESH_TID(); conv_range(fresh_args(), lds, cursor, need_, gw_, NGW, wave_, lane_); cursor = need_; } } while (0)
#define IDLE_CONV(first_idle) do { if (cursor < IT_TOTAL) { const int nid_ = G - (first_idle); int hi_ = cursor + nid_ * NWAVES * CONV_PER_IDLE_WAVE; if (hi_ > IT_TOTAL) hi_ = IT_TOTAL; \
        if (bid >= (first_idle)) { FRESH_TID(); conv_range(fresh_args(), lds, cursor, hi_, (bid - (first_idle)) * NWAVES + wave_, nid_ * NWAVES, wave_, lane_); } cursor = hi_; } } while (0)
    prologue(ap0, lds, gw, NGW, wave, lane);
    ENSURE(conv_seg_start(0, 1));
    GRID_BAR();

    for (int hl = 0; hl < 8; ++hl) {
        const int l = hl >> 1, f = hl & 1, j = l >> 1;
        const bool odd = (l & 1) != 0;
        {
            CArgs* ap = fresh_args(); unsigned char* ws = ap->ws;
            const pg8::Gemm g = pg8::plain_gemm((const bf16*)(ws + WS_HB), (const bf16*)(ws + WS_W) + WO_FFNIN + (size_t)hl * SZ_FFNIN, D, D, D); pg8::StaticOrder S; S.init(M, NFF, G, bid);
            pg8::EpiSwiGLU E{(bf16*)(ws + WS_ACT), DFFP};
            pg8::gemm_phase<pg8::EpiSwiGLU, pg8::StaticOrder, true, true>(lds, g, S, E);
        }
        IDLE_CONV((M / 256) * (NFF / 256) % G == 0 ? G : (M / 256) * (NFF / 256) % G);
        ENSURE(conv_seg_start(l, f ? 7 : 2));
        GRID_BAR();
        {
            CArgs* ap = fresh_args(); unsigned char* ws = ap->ws;
            const bf16* Wo_ = (const bf16*)(ws + WS_W) + WO_FFNOUT + (size_t)hl * SZ_FFNOUT;
            { const pg8::Gemm g = pg8::plain_gemm((const bf16*)(ws + WS_ACT), Wo_, DFF, DFFP, DFFP); pg8::StaticOrder S; S.init(MP, D, G, bid);
              pg8::EpiBf16S E{(bf16*)(ws + WS_Y), D, nullptr, 0};
              pg8::gemm_phase<pg8::EpiBf16S, pg8::StaticOrder, true, true>(lds, g, S, E); }
            { const pg8::Gemm g{(const bf16*)(ws + WS_ACT) + (size_t)MP * DFFP, Wo_, KSL_FFN, DFFP, DFFP, KSL_FFN * 2, 0, (size_t)256 * DFFP * 2, KSL_FFN * 2}; pg8::StaticOrder S; S.init(NSL_FFN * 256, D, G, bid);
              pg8::EpiF32 E{(float*)(ws + WS_YP), D};
              pg8::gemm_phase<pg8::EpiF32, pg8::StaticOrder, true, true>(lds, g, S, E); }
        }
        GRID_BAR();
        {
            CArgs* ap = fresh_args(); unsigned char* ws = ap->ws; const float* NG = ap->in[6];
            const float* ga = NG + (size_t)(l * 6 + (f ? 5 : 1)) * D;
            const float* gb = f == 0 ? NG + (size_t)(l * 6 + 2) * D : (l < 3 ? NG + (size_t)((l + 1) * 6) * D : nullptr);
            FRESH_TID();
            norm_phase<NSL_FFN>((const bf16*)(ws + WS_Y), (const float*)(ws + WS_YP), ap->out, (bf16*)(ws + WS_HB), 0.5f, ga, gb, gw_, NGW, lane_);
        }
        ENSURE(f == 0 ? conv_seg_start(l, 3) : (l < 3 ? conv_seg_start(l + 1, 1) : IT_TOTAL));
        GRID_BAR();
        if (f == 0) {
            {
                CArgs* ap = fresh_args(); unsigned char* ws = ap->ws;
                const int N = odd ? NQKV : NMIX; const bf16* W = (const bf16*)(ws + WS_W);
                const pg8::Gemm g = pg8::plain_gemm((const bf16*)(ws + WS_HB), odd ? W + WO_QKV + (size_t)j * SZ_QKV : W + WO_MIXIN + (size_t)j * SZ_MIXIN, D, D, D); pg8::StaticOrder S; S.init(M, N, G, bid);
                pg8::EpiBf16S E{(bf16*)(ws + WS_Z), N, nullptr, 0};
                pg8::gemm_phase<pg8::EpiBf16S, pg8::StaticOrder, true, true>(lds, g, S, E);
            }
            { const int nu_ = (M / 256) * ((odd ? NQKV : NMIX) / 256); IDLE_CONV(nu_ % G == 0 ? G : nu_ % G); }
            ENSURE(conv_seg_start(l, 5));
            GRID_BAR();
            if (odd) {
                FRESH_TID();
                attention_phase(fresh_args(), lds, j, bid, G, tid_, wave_, lane_);
                GRID_BAR();
            } else {
                { FRESH_TID();
                  convpool_phase(fresh_args(), j, bid, G, tid_); }
                GRID_BAR();
                {
                    CArgs* ap = fresh_args(); unsigned char* ws = ap->ws;
                    const pg8::Gemm g{(const bf16*)(ws + WS_DP), (const bf16*)(ws + WS_W) + WO_POOLW + (size_t)j * SZ_POOLW, 256, DCV, 256, (size_t)256 * DCV * 2, 512, (size_t)256 * 256 * 2, 0}; pg8::StaticOrder S; S.init(M, DCV, G, bid);
                    pg8::EpiBf16S E{(bf16*)(ws + WS_CAT), D, ap->in[12] + (size_t)j * DCV, DCV};
                    pg8::gemm_phase<pg8::EpiBf16S, pg8::StaticOrder, true, true>(lds, g, S, E);
                }
                GRID_BAR();
            }
            {
                CArgs* ap = fresh_args(); unsigned char* ws = ap->ws; const bf16* W = (const bf16*)(ws + WS_W);
                const bf16* Wm = odd ? W + WO_WO + (size_t)j * SZ_WO : W + WO_MIXOUT + (size_t)j * SZ_MIXOUT;
                { const pg8::Gemm g = pg8::plain_gemm((const bf16*)(ws + WS_CAT), Wm, D, D, D); pg8::StaticOrder S; S.init(MP, D, G, bid);
                  pg8::EpiBf16S E{(bf16*)(ws + WS_Y), D, nullptr, 0};
                  pg8::gemm_phase<pg8::EpiBf16S, pg8::StaticOrder, true, true>(lds, g, S, E); }
                { const pg8::Gemm g{(const bf16*)(ws + WS_CAT) + (size_t)MP * D, Wm, KSL_MIX, D, D, KSL_MIX * 2, 0, (size_t)256 * D * 2, KSL_MIX * 2}; pg8::StaticOrder S; S.init(NSL_MIX * 256, D, G, bid);
                  pg8::EpiF32 E{(float*)(ws + WS_YP), D};
                  pg8::gemm_phase<pg8::EpiF32, pg8::StaticOrder, true, true>(lds, g, S, E); }
            }
            GRID_BAR();
            {   CArgs* ap = fresh_args(); unsigned char* ws = ap->ws; const float* NG = ap->in[6];
                FRESH_TID();
                norm_phase<NSL_MIX>((const bf16*)(ws + WS_Y), (const float*)(ws + WS_YP), ap->out, (bf16*)(ws + WS_HB), 1.0f, NG + (size_t)(l * 6 + 3) * D, NG + (size_t)(l * 6 + 4) * D, gw_, NGW, lane_); }
            ENSURE(conv_seg_start(l, 6));
            GRID_BAR();
        }
    }
}

extern "C" void kernel_launch(void* const* d_in, const int* in_sizes, int n_in, void* d_out, int out_size, void* d_ws, size_t ws_size, hipStream_t stream) {
    static int grid = 0;
    if (grid == 0) {
        if (n_in != 18 || out_size != (int)O_END || ws_size < WS_END) { fprintf(stderr, "kernel_launch: unexpected shapes (n_in %d, out %d, ws %zu; need ws >= %zu)\n", n_in, out_size, ws_size, (size_t)WS_END); grid = -1; return; }
        int dev = 0, cus = 0, per_cu = 0;
        if (hipGetDevice(&dev) != hipSuccess || hipDeviceGetAttribute(&cus, hipDeviceAttributeMultiprocessorCount, dev) != hipSuccess) { grid = -1; return; }
        if (hipFuncSetAttribute((const void*)mega_fwd, hipFuncAttributeMaxDynamicSharedMemorySize, LDS_BYTES) != hipSuccess) { fprintf(stderr, "kernel_launch: hipFuncSetAttribute failed\n"); grid = -1; return; }
        if (hipOccupancyMaxActiveBlocksPerMultiprocessor(&per_cu, (const void*)mega_fwd, NWAVES * 64, LDS_BYTES) != hipSuccess || per_cu < 1)
            fprintf(stderr, "kernel_launch: occupancy query reports %d\n", per_cu);
        (void)hipGetLastError();
        grid = cus;
    }
    if (grid < 0) return;
    if (hipMemsetAsync((char*)d_ws + WS_CTL, 0, CTL_ZERO_BYTES, stream) != hipSuccess) return;
    Args a{};
    for (int i = 0; i < 18; ++i) a.in[i] = (const float*)d_in[i];
    a.out = (float*)d_out; a.ws = (unsigned char*)d_ws;
    hipLaunchKernelGGL(mega_fwd, dim3(grid), dim3(NWAVES * 64), LDS_BYTES, stream, a);
}
```

```cpp
#include <hip/hip_runtime.h>
#include <cstdio>
#include <cstdint>

#define LAS __attribute__((address_space(3)))
#define GAS __attribute__((address_space(1)))

namespace pg8 {
typedef unsigned short bf16_t;
typedef short bf16x8 __attribute__((ext_vector_type(8)));
typedef float f32x4 __attribute__((ext_vector_type(4)));
typedef float f32x2 __attribute__((ext_vector_type(2)));
typedef unsigned u32x4 __attribute__((ext_vector_type(4)));
constexpr int BM = 256, BK = 64, HALF = 128, HTB = HALF * BK * 2, STAGE_BYTES = 8 * HTB, NXCD = 8, WGM = 8;

__host__ __device__ __forceinline__ int lds_byte(int r, int c) { const int st = (r >> 4) * 2 + (c >> 5), rr = r & 15, cc = c & 31, ob = rr * 64 + cc * 2; return st * 1024 + (ob ^ (((ob >> 9) & 1) << 5)); }
__host__ __device__ __forceinline__ void stage_rc(int b, int& R, int& C) { const int st = b / 1024, sb = b % 1024, swz = sb ^ (((sb >> 9) & 1) << 5); R = (st >> 1) * 16 + swz / 64; C = (st & 1) * 32 + (swz % 64) / 2; }
__host__ __device__ __forceinline__ int perm32(int rho) { const int n = rho >> 4, i = rho & 15; return 8 * (i >> 2) + 4 * n + (i & 3); }

struct Unit { int pm, pn; };
struct Gemm { const bf16_t* A; const bf16_t* Bt; int K, lda, ldb; size_t a_pm, a_pn, b_pn, b_pm; };
__device__ __forceinline__ Gemm plain_gemm(const bf16_t* A, const bf16_t* Bt, int K, int lda, int ldb) { return Gemm{A, Bt, K, lda, ldb, (size_t)BM * lda * 2, 0, (size_t)BM * ldb * 2, 0}; }

struct StaticOrder {
    int nM, nN, nwg, G, c;
    __host__ __device__ void init(int M, int N, int G_, int c_) { nM = M / BM; nN = N / BM; nwg = nM * nN; G = G_; c = c_; }
    __host__ __device__ bool next(int i, Unit& u) const {
        const long L = (long)i * G + c; if (L >= nwg) return false;
        int wgid = (int)L; { const int q = nwg / NXCD, r = nwg % NXCD, xcd = wgid % NXCD, off = wgid / NXCD; wgid = (xcd < r ? xcd * (q + 1) : r * (q + 1) + (xcd - r) * q) + off; }
        const int nig = WGM * nN, gid = wgid / nig, fm = gid * WGM, gsz = (nM - fm) < WGM ? (nM - fm) : WGM;
        u.pm = fm + ((wgid % nig) % gsz); u.pn = (wgid % nig) / gsz; return true;
    }
    __device__ __forceinline__ void a_ready(const Unit&) const {}
    __device__ __forceinline__ void done(const Unit&) const {}
};

__device__ __forceinline__ unsigned cvt_pk_bf16(float lo, float hi) { unsigned r; asm volatile("v_cvt_pk_bf16_f32 %0, %1, %2" : "=v"(r) : "v"(lo), "v"(hi)); return r; }

struct EpiF32 {
    static constexpr bool PERM = false, AFTER_DRAIN = false;
    float* C; int ldc;
    __device__ __forceinline__ void operator()(const f32x4 (&acc)[2][2][4][2], const Unit& u, int wr, int wc, int fr, int fq) const {
        const int row0 = u.pm * BM + wr * 64 + fr, col0 = u.pn * BM + wc * 32 + 4 * fq;
#pragma unroll
        for (int ai = 0; ai < 2; ++ai)
#pragma unroll
            for (int m = 0; m < 4; ++m) { float* rowp = C + (size_t)(row0 + ai * HALF + m * 16) * ldc + col0;
#pragma unroll
                for (int bj = 0; bj < 2; ++bj)
#pragma unroll
                    for (int n = 0; n < 2; ++n) *(f32x4*)(rowp + bj * HALF + n * 16) = acc[ai][bj][m][n]; }
    }
};
struct EpiBf16S {
    static constexpr bool PERM = true, AFTER_DRAIN = false;
    bf16_t* O; int ldc; const float* scale; int col_off;
    __device__ __forceinline__ void operator()(const f32x4 (&acc)[2][2][4][2], const Unit& u, int wr, int wc, int fr, int fq) const {
        const int row0 = u.pm * BM + wr * 64 + fr; const int col0 = u.pn * BM + wc * 32 + 8 * fq;
        f32x4 sv[2][2];
#pragma unroll
        for (int bj = 0; bj < 2; ++bj)
#pragma unroll
            for (int n = 0; n < 2; ++n) sv[bj][n] = scale ? *(const f32x4*)(scale + col0 + bj * HALF + 4 * n) : (f32x4){1.f, 1.f, 1.f, 1.f};
#pragma unroll
        for (int ai = 0; ai < 2; ++ai)
#pragma unroll
            for (int m = 0; m < 4; ++m) { bf16_t* rowp = O + (size_t)(row0 + ai * HALF + m * 16) * ldc + col_off + col0;
#pragma unroll
                for (int bj = 0; bj < 2; ++bj) { const f32x4 v0 = acc[ai][bj][m][0] * sv[bj][0], v1 = acc[ai][bj][m][1] * sv[bj][1];
                    u32x4 w; w.x = cvt_pk_bf16(v0[0], v0[1]); w.y = cvt_pk_bf16(v0[2], v0[3]); w.z = cvt_pk_bf16(v1[0], v1[1]); w.w = cvt_pk_bf16(v1[2], v1[3]);
                    *(u32x4*)(rowp + bj * HALF) = w; } }
    }
};
__device__ __forceinline__ f32x2 silu_mul2(f32x2 g, f32x2 u) {
    const f32x2 t = g * u, a = g * -1.44269504089f;
    f32x2 e; e.x = __builtin_amdgcn_exp2f(a.x); e.y = __builtin_amdgcn_exp2f(a.y);
    const f32x2 d = e + 1.0f;
    f32x2 r; r.x = __builtin_amdgcn_rcpf(d.x); r.y = __builtin_amdgcn_rcpf(d.y);
    return t * r;
}
struct EpiSwiGLU {
    static constexpr bool PERM = true, AFTER_DRAIN = false;
    bf16_t* O; int ldc;
    __device__ __forceinline__ void operator()(const f32x4 (&acc)[2][2][4][2], const Unit& u, int wr, int wc, int fr, int fq) const {
        const int row0 = u.pm * BM + wr * 64 + fr; const int col0 = u.pn * HALF + wc * 32 + 8 * fq;
#pragma unroll
        for (int ai = 0; ai < 2; ++ai)
#pragma unroll
            for (int m = 0; m < 4; ++m) { bf16_t* rowp = O + (size_t)(row0 + ai * HALF + m * 16) * ldc + col0;
                const f32x4 g0 = acc[ai][0][m][0], g1 = acc[ai][0][m][1], u0 = acc[ai][1][m][0], u1 = acc[ai][1][m][1];
                const f32x2 a = silu_mul2((f32x2){g0[0], g0[1]}, (f32x2){u0[0], u0[1]}), b = silu_mul2((f32x2){g0[2], g0[3]}, (f32x2){u0[2], u0[3]});
                const f32x2 c = silu_mul2((f32x2){g1[0], g1[1]}, (f32x2){u1[0], u1[1]}), d = silu_mul2((f32x2){g1[2], g1[3]}, (f32x2){u1[2], u1[3]});
                u32x4 w; w.x = cvt_pk_bf16(a.x, a.y); w.y = cvt_pk_bf16(b.x, b.y); w.z = cvt_pk_bf16(c.x, c.y); w.w = cvt_pk_bf16(d.x, d.y);
                *(u32x4*)rowp = w; }
    }
};

template <class Epi, class Sched, bool ALIGN_EPI = false, bool SP2 = false>
__device__ __forceinline__ void gemm_phase(LAS unsigned char* lds, const Gemm g, const Sched& S, const Epi& E) {
    int tid = threadIdx.x; asm volatile("" : "+v"(tid));
    const int wid = __builtin_amdgcn_readfirstlane(tid >> 6), lane = tid & 63, wr = wid >> 2, wc = wid & 3, fr = lane & 15, fq = lane >> 4;
    const int K = g.K, nt = K / BK;
    unsigned voffA[2], voffB[2];
#pragma unroll
    for (int i = 0; i < 2; ++i) { int R, C; stage_rc(tid * 16 + i * 8192, R, C); const int Rb = Epi::PERM ? ((R & ~31) + perm32(R & 31)) : R;
        voffA[i] = (unsigned)(R * g.lda + C) * 2u; voffB[i] = (unsigned)(Rb * g.ldb + C) * 2u; }
    const size_t kstep = (size_t)(BK * 2);
    const size_t hstepA = (size_t)HALF * g.lda * 2, hstepB = (size_t)HALF * g.ldb * 2;
    const unsigned ldsw = (unsigned)wid * 1024u;
    const int aoff = lds_byte(wr * 64 + fr, fq * 8), boff = lds_byte(wc * 32 + fr, fq * 8);
#define PG8_SA(b, h) (((b) * 2 + (h)) * HTB)
#define PG8_SB(b, h) ((4 + (b) * 2 + (h)) * HTB)
#define PG8_STAGE(bufoff, gbase, voff) do { _Pragma("unroll") for (int _i = 0; _i < 2; ++_i) \
        __builtin_amdgcn_global_load_lds((const unsigned*)((const char*)(gbase) + (voff)[_i]), (LAS unsigned*)(lds + (bufoff) + ldsw + _i * 8192), 16, 0, 0); } while (0)
#define PG8_LDA(dst, b, h) do { _Pragma("unroll") for (int m = 0; m < 4; ++m) _Pragma("unroll") for (int k = 0; k < 2; ++k) dst[m][k] = *(const LAS bf16x8*)(lds + PG8_SA(b, h) + aoff + m * 2048 + k * 1024); } while (0)
#define PG8_LDB(dst, b, h) do { _Pragma("unroll") for (int n = 0; n < 2; ++n) _Pragma("unroll") for (int k = 0; k < 2; ++k) dst[n][k] = *(const LAS bf16x8*)(lds + PG8_SB(b, h) + boff + n * 2048 + k * 1024); } while (0)
#define PG8_MMA(ai, bj, At, Bt) do { __builtin_amdgcn_s_setprio(1); _Pragma("unroll") for (int m = 0; m < 4; ++m) _Pragma("unroll") for (int n = 0; n < 2; ++n) _Pragma("unroll") for (int k = 0; k < 2; ++k) \
        acc[ai][bj][m][n] = __builtin_amdgcn_mfma_f32_16x16x32_bf16(Bt[n][k], At[m][k], acc[ai][bj][m][n], 0, 0, 0); __builtin_amdgcn_s_setprio(0); } while (0)
#define PG8_WAIT_V(n) asm volatile("s_waitcnt vmcnt(" #n ")" ::: "memory")
#define PG8_WAIT_L(n) asm volatile("s_waitcnt lgkmcnt(" #n ")" ::: "memory")
#define PG8_BAR __builtin_amdgcn_s_barrier()
#define PG8_SCHED __builtin_amdgcn_sched_barrier(0)
    Unit cur, nxt; int ui = 0;
    if (!S.next(0, cur)) return;
    f32x4 acc[2][2][4][2];
#pragma unroll
    for (int a = 0; a < 2; ++a)
#pragma unroll
        for (int b = 0; b < 2; ++b)
#pragma unroll
            for (int m = 0; m < 4; ++m)
#pragma unroll
                for (int n = 0; n < 2; ++n) acc[a][b][m][n] = (f32x4){0.f, 0.f, 0.f, 0.f};
    bf16x8 At[4][2], B0[2][2], B1[2][2];
    const char* cA = (const char*)g.A + (size_t)cur.pm * g.a_pm + (size_t)cur.pn * g.a_pn; const char* cB = (const char*)g.Bt + (size_t)cur.pn * g.b_pn + (size_t)cur.pm * g.b_pm;
    S.a_ready(cur);
    if constexpr (SP2) {
        PG8_STAGE(PG8_SB(0, 0), cB, voffB); PG8_STAGE(PG8_SB(0, 1), cB + hstepB, voffB); PG8_STAGE(PG8_SA(0, 0), cA, voffA); PG8_STAGE(PG8_SA(0, 1), cA + hstepA, voffA);
        if (wr == 1) PG8_BAR;
        PG8_WAIT_V(2); PG8_BAR;
        PG8_STAGE(PG8_SB(1, 0), cB + kstep, voffB); PG8_STAGE(PG8_SA(1, 0), cA + kstep, voffA); PG8_STAGE(PG8_SB(1, 1), cB + hstepB + kstep, voffB);
        PG8_WAIT_V(6); PG8_BAR;
    } else {
        PG8_STAGE(PG8_SB(0, 0), cB, voffB); PG8_STAGE(PG8_SA(0, 0), cA, voffA); PG8_STAGE(PG8_SB(0, 1), cB + hstepB, voffB); PG8_STAGE(PG8_SA(0, 1), cA + hstepA, voffA);
        if (wr == 1) PG8_BAR;
        PG8_WAIT_V(4); PG8_BAR;
        PG8_STAGE(PG8_SB(1, 0), cB + kstep, voffB); PG8_STAGE(PG8_SA(1, 0), cA + kstep, voffA); PG8_STAGE(PG8_SB(1, 1), cB + hstepB + kstep, voffB);
        PG8_WAIT_V(6); PG8_BAR;
    }
    for (;;) {
        const bool has_next = S.next(ui + 1, nxt);
        const char* nA = has_next ? (const char*)g.A + (size_t)nxt.pm * g.a_pm + (size_t)nxt.pn * g.a_pn : cA; const char* nB = has_next ? (const char*)g.Bt + (size_t)nxt.pn * g.b_pn + (size_t)nxt.pm * g.b_pm : cB;
        for (int t = 0; t < nt; t += 2) {
            const bool last = (t == nt - 2);
            const char* a1 = cA + (size_t)(t + 1) * kstep;
            const char* a2 = last ? nA : cA + (size_t)(t + 2) * kstep; const char* b2 = last ? nB : cB + (size_t)(t + 2) * kstep;
            const char* a3 = a2 + kstep; const char* b3 = b2 + kstep;
            if (last && has_next) S.a_ready(nxt);
            if constexpr (SP2) {
            PG8_LDB(B0, 0, 0); PG8_LDB(B1, 0, 1); PG8_SCHED; PG8_LDA(At, 0, 0); PG8_STAGE(PG8_SA(1, 1), a1 + hstepA, voffA);
            PG8_WAIT_V(8); PG8_WAIT_L(0); PG8_BAR; PG8_MMA(0, 0, At, B0); PG8_MMA(0, 1, At, B1); PG8_BAR; PG8_SCHED;
            PG8_LDA(At, 0, 1); PG8_STAGE(PG8_SB(0, 0), b2, voffB); PG8_STAGE(PG8_SB(0, 1), b2 + hstepB, voffB); PG8_STAGE(PG8_SA(0, 0), a2, voffA);
            PG8_WAIT_V(8); PG8_WAIT_L(0); PG8_BAR; PG8_MMA(1, 0, At, B0); PG8_MMA(1, 1, At, B1); PG8_BAR; PG8_SCHED;
            PG8_LDB(B0, 1, 0); PG8_LDB(B1, 1, 1); PG8_SCHED; PG8_LDA(At, 1, 0); PG8_STAGE(PG8_SA(0, 1), a2 + hstepA, voffA);
            PG8_WAIT_V(8); PG8_WAIT_L(0); PG8_BAR; PG8_MMA(0, 0, At, B0); PG8_MMA(0, 1, At, B1); PG8_BAR; PG8_SCHED;
            PG8_LDA(At, 1, 1); PG8_STAGE(PG8_SB(1, 0), b3, voffB); PG8_STAGE(PG8_SB(1, 1), b3 + hstepB, voffB); PG8_STAGE(PG8_SA(1, 0), a3, voffA);
            PG8_WAIT_V(8); PG8_WAIT_L(0); PG8_BAR; PG8_MMA(1, 0, At, B0); PG8_MMA(1, 1, At, B1); PG8_BAR; PG8_SCHED;
            } else {
            PG8_LDB(B0, 0, 0); PG8_SCHED; PG8_LDA(At, 0, 0); PG8_STAGE(PG8_SA(1, 1), a1 + hstepA, voffA);
            PG8_WAIT_L(8); PG8_BAR; PG8_WAIT_L(0); PG8_MMA(0, 0, At, B0); PG8_BAR; PG8_SCHED;
            PG8_LDB(B1, 0, 1); PG8_STAGE(PG8_SB(0, 0), b2, voffB);
            PG8_BAR; PG8_WAIT_L(0); PG8_MMA(0, 1, At, B1); PG8_BAR;
            PG8_LDA(At, 0, 1); PG8_STAGE(PG8_SA(0, 0), a2, voffA);
            PG8_BAR; PG8_WAIT_L(0); PG8_MMA(1, 0, At, B0); PG8_BAR; PG8_SCHED;
            PG8_STAGE(PG8_SB(0, 1), b2 + hstepB, voffB);
            PG8_WAIT_V(6); PG8_BAR; PG8_MMA(1, 1, At, B1); PG8_BAR;
            PG8_LDB(B0, 1, 0); PG8_SCHED; PG8_LDA(At, 1, 0); PG8_STAGE(PG8_SA(0, 1), a2 + hstepA, voffA);
            PG8_WAIT_L(8); PG8_BAR; PG8_WAIT_L(0); PG8_MMA(0, 0, At, B0); PG8_BAR; PG8_SCHED;
            PG8_LDB(B1, 1, 1); PG8_STAGE(PG8_SB(1, 0), b3, voffB);
            PG8_BAR; PG8_WAIT_L(0); PG8_MMA(0, 1, At, B1); PG8_BAR;
            PG8_LDA(At, 1, 1); PG8_STAGE(PG8_SA(1, 0), a3, voffA);
            PG8_BAR; PG8_WAIT_L(0); PG8_MMA(1, 0, At, B0); PG8_BAR; PG8_SCHED;
            PG8_STAGE(PG8_SB(1, 1), b3 + hstepB, voffB);
            PG8_WAIT_V(6); PG8_BAR; PG8_MMA(1, 1, At, B1); PG8_BAR;
            }
        }
        if constexpr (ALIGN_EPI) { if (wr == 0) PG8_BAR; }
        if constexpr (!Epi::AFTER_DRAIN) { E(acc, cur, wr, wc, fr, fq); S.done(cur); }
        if (!has_next) break;
#pragma unroll
        for (int a = 0; a < 2; ++a)
#pragma unroll
            for (int b = 0; b < 2; ++b)
#pragma unroll
                for (int m = 0; m < 4; ++m)
#pragma unroll
                    for (int n = 0; n < 2; ++n) acc[a][b][m][n] = (f32x4){0.f, 0.f, 0.f, 0.f};
        cur = nxt; cA = nA; cB = nB; ++ui;
        if constexpr (ALIGN_EPI) { if (wr == 1) PG8_BAR; }
    }
    PG8_WAIT_V(0);
    if constexpr (!ALIGN_EPI) { if (wr == 0) PG8_BAR; }
    PG8_BAR;
#undef PG8_SA
#undef PG8_SB
#undef PG8_STAGE
#undef PG8_LDA
#undef PG8_LDB
#undef PG8_MMA
#undef PG8_WAIT_V
#undef PG8_WAIT_L
#undef PG8_BAR
#undef PG8_SCHED
}
}

typedef unsigned short bf16;
typedef unsigned v4u __attribute__((ext_vector_type(4)));
typedef unsigned v2u __attribute__((ext_vector_type(2)));
typedef float f32x4 __attribute__((ext_vector_type(4)));
typedef float f32x2 __attribute__((ext_vector_type(2)));
typedef float f32x16 __attribute__((ext_vector_type(16)));
typedef short bf16x8 __attribute__((ext_vector_type(8)));
typedef short s16x4 __attribute__((ext_vector_type(4)));

constexpr int NWAVES = 8;
constexpr int CONV_PER_IDLE_WAVE = 6;
constexpr int D = 2048, MP = 8192, MS = 256, M = MP + MS, DFF = 5504, NFF = 2 * DFF, NMIX = 4096, NQKV = 2560, DCV = 1024;
constexpr int DFFP = 5632;
constexpr int KSL_FFN = 512, KSL_MIX = 256;
constexpr int NSL_FFN = DFFP / KSL_FFN, NSL_MIX = D / KSL_MIX;
constexpr int SEQ = 2048, NB = 4, DB = 32, DS = 8, NHEAD = 32, NKVH = 4, HD = 64, KVB = 128, PCTX = 15;
constexpr float EPS = 1e-6f;
constexpr float LOG2E = 1.4426950408889634f;

constexpr size_t O_Y = 0, O_CONVP = (size_t)M * D, O_POOLP = O_CONVP + 2 * NB * 2 * DCV, O_KP = O_POOLP + 2 * NB * PCTX * DCV, O_VP = O_KP + 2 * NB * KVB * 256,
                 O_CONVS = O_VP + 2 * NB * KVB * 256, O_POOLS = O_CONVS + 2 * DB * 2 * DCV, O_KS = O_POOLS + 2 * DB * PCTX * DCV, O_VS = O_KS + 2 * DB * KVB * 256, O_END = O_VS + 2 * DB * KVB * 256;
static_assert(O_END == 23273472, "output size");

constexpr size_t MiB = 1u << 20;
constexpr size_t WS_CTL = 0, CTL_ZERO_BYTES = 1 * MiB;
constexpr size_t WS_HB = 2 * MiB;
constexpr size_t WS_ACT = 36 * MiB;
constexpr size_t WS_Y = 128 * MiB;
constexpr size_t WS_Z = 194 * MiB;
constexpr size_t WS_CAT = 260 * MiB;
constexpr size_t WS_DP = 294 * MiB;
constexpr size_t WS_YP = 312 * MiB;
constexpr size_t WS_W = 360 * MiB;
constexpr size_t SZ_FFNIN = (size_t)NFF * D, SZ_FFNOUT = (size_t)D * DFFP, SZ_MIXIN = (size_t)NMIX * D, SZ_MIXOUT = (size_t)D * D, SZ_QKV = (size_t)NQKV * D, SZ_WO = (size_t)D * D, SZ_POOLW = 4 * 256 * 256;
constexpr size_t WO_FFNIN = 0, WO_FFNOUT = WO_FFNIN + 8 * SZ_FFNIN, WO_MIXIN = WO_FFNOUT + 8 * SZ_FFNOUT, WO_MIXOUT = WO_MIXIN + 2 * SZ_MIXIN, WO_QKV = WO_MIXOUT + 2 * SZ_MIXOUT,
                 WO_WO = WO_QKV + 2 * SZ_QKV, WO_POOLW = WO_WO + 2 * SZ_WO, WO_END = WO_POOLW + 2 * SZ_POOLW;
constexpr size_t WS_END = WS_W + WO_END * 2;
static_assert(WS_HB + (size_t)M * D * 2 <= WS_ACT && WS_ACT + (size_t)M * DFFP * 2 <= WS_Y && WS_Y + (size_t)M * D * 4 <= WS_Z && WS_Z + (size_t)M * NMIX * 2 <= WS_CAT && WS_CAT + (size_t)M * D * 2 <= WS_DP && WS_DP + (size_t)M * DCV * 2 <= WS_YP && WS_YP + (size_t)NSL_FFN * 256 * D * 4 <= WS_W, "ws map");
constexpr int CW_BAR = 4096;

constexpr int RING_BYTES = 135168;
constexpr int LDSCTL_OFF = RING_BYTES, MISC_OFF = LDSCTL_OFF + 320;
constexpr int LDS_BYTES = 147456;
static_assert(MISC_OFF + 128 <= LDS_BYTES, "LDS map");

#define LDS_WAIT() asm volatile("s_waitcnt lgkmcnt(0)" ::: "memory")
#define VM_WAIT() asm volatile("s_waitcnt vmcnt(0)" ::: "memory")
__device__ __forceinline__ unsigned f2bf(float f) { unsigned u = __builtin_bit_cast(unsigned, f); return (u + 0x7fffu + ((u >> 16) & 1u)) >> 16; }
__device__ __forceinline__ unsigned pk2(float lo, float hi) { return f2bf(lo) | (f2bf(hi) << 16); }
__device__ __forceinline__ float bf_lo(unsigned w) { return __builtin_bit_cast(float, w << 16); }
__device__ __forceinline__ float bf_hi(unsigned w) { return __builtin_bit_cast(float, w & 0xffff0000u); }

#define XB_TMO      128
#define XB_XCNT(j)  (256  + 64 * (j))
#define XB_XSUB(j)  (1280 + 64 * (j))
#define XB_XGEN(j)  (2304 + 64 * (j))
#define XB_TOP      3328
#define XB_TOPGEN   3392
#define XCD_BAR_WORDS 3456
#define XB_SPIN_CAP (1u << 18)
__device__ __forceinline__ unsigned xb_ld(unsigned* p)              { return __hip_atomic_load(p, __ATOMIC_RELAXED, __HIP_MEMORY_SCOPE_AGENT); }
__device__ __forceinline__ unsigned xb_add(unsigned* p, unsigned v) { return __hip_atomic_fetch_add(p, v, __ATOMIC_RELAXED, __HIP_MEMORY_SCOPE_AGENT); }
__device__ __forceinline__ unsigned xb_xcc_id() { return (unsigned)__builtin_amdgcn_s_getreg((3 << 11) | 20) & 0xFu; }
#define XB_SPIN(cond, bar) do { unsigned _sp = 0; while (cond) { __builtin_amdgcn_s_sleep(1); \
    if ((++_sp & 255u) == 0u) { if (xb_ld(&(bar)[XB_TMO])) break; if (_sp > XB_SPIN_CAP) { atomicAdd(&(bar)[XB_TMO], 1u); break; } } } } while (0)
struct XcdBarrier { unsigned* bar; unsigned x; volatile LAS unsigned* st; };
__device__ __forceinline__ XcdBarrier xcd_barrier_post(unsigned* bar, volatile LAS unsigned* st) {
    XcdBarrier b; b.bar = bar; b.x = xb_xcc_id(); b.st = st;
    if (threadIdx.x == 0) (void)xb_add(&bar[XB_XCNT(b.x)], 1u);
    return b;
}
__device__ __forceinline__ void xcd_barrier_complete(unsigned* bar, unsigned x, unsigned& nloc, unsigned& nx) {
    const unsigned G = gridDim.x * gridDim.y * gridDim.z;
    unsigned sum, cnt, mine, sp = 0u;
    for (;;) {
        sum = 0u; cnt = 0u; mine = 0u;
#pragma unroll
        for (unsigned j = 0; j < 16; ++j) { const unsigned c = xb_ld(&bar[XB_XCNT(j)]); sum += c; cnt += (c > 0u) ? 1u : 0u; mine = (j == x) ? c : mine; }
        if (sum == G) break;
        __builtin_amdgcn_s_sleep(1);
        if ((++sp & 255u) == 0u) { if (xb_ld(&bar[XB_TMO])) break; if (sp > XB_SPIN_CAP) { atomicAdd(&bar[XB_TMO], 1u); break; } }
    }
    nloc = mine > 0u ? mine : 1u; nx = cnt > 0u ? cnt : 1u;
}
__device__ __forceinline__ void xcd_barrier(const XcdBarrier& b) {
    asm volatile("s_waitcnt vmcnt(0)" ::: "memory");
    __syncthreads();
    if (threadIdx.x == 0) {
        unsigned* bar = b.bar; asm volatile("" : "+s"(bar));
        __builtin_amdgcn_s_waitcnt(0);
        unsigned nloc = b.st[0], nx = b.st[1];
        const unsigned bx = xb_xcc_id();
        if (nloc == 0u) { xcd_barrier_complete(bar, bx, nloc, nx); b.st[0] = nloc; b.st[1] = nx; }
        const unsigned old = xb_add(&bar[XB_XSUB(bx)], 1u);
        const unsigned gen = old / nloc;
        if (old + 1u == (gen + 1u) * nloc) {
            __builtin_amdgcn_fence(__ATOMIC_RELEASE, "agent");
            asm volatile("s_waitcnt vmcnt(0)" ::: "memory");
            const unsigned og = xb_add(&bar[XB_TOP], 1u);
            const unsigned tg = og / nx;
            if (og + 1u == (tg + 1u) * nx) xb_add(&bar[XB_TOPGEN], 1u);
            else XB_SPIN(xb_ld(&bar[XB_TOPGEN]) == tg, bar);
            __builtin_amdgcn_fence(__ATOMIC_ACQUIRE, "agent");
            xb_add(&bar[XB_XGEN(bx)], 1u);
            asm volatile("s_waitcnt vmcnt(0)" ::: "memory");
        } else {
            XB_SPIN(xb_ld(&bar[XB_XGEN(bx)]) == gen, bar);
            __builtin_amdgcn_fence(__ATOMIC_ACQUIRE, "agent");
            asm volatile("s_waitcnt vmcnt(0)" ::: "memory");
        }
    }
    __syncthreads();
}

__device__ __forceinline__ float wave_sum(float v) {
#pragma unroll
    for (int o = 1; o < 64; o <<= 1) v += __shfl_xor(v, o);
    return v;
}

__device__ __forceinline__ void tr_item(const float* __restrict__ src, int sld, bf16* __restrict__ dst, int K  , int k0, LAS float* scr, int lane) {
    const GAS float* s = (const GAS float*)src + (size_t)(k0 + (lane >> 4)) * sld + (lane & 15) * 4;
    f32x4 v[16];
#pragma unroll
    for (int it = 0; it < 16; ++it) v[it] = *(const GAS f32x4*)(s + (size_t)(4 * it) * sld);
#pragma unroll
    for (int it = 0; it < 16; ++it) { LAS float* w = scr + ((lane >> 4) + 4 * it) * 65 + (lane & 15) * 4; w[0] = v[it].x; w[1] = v[it].y; w[2] = v[it].z; w[3] = v[it].w; }
    LDS_WAIT(); asm volatile("" ::: "memory");
    const int c = lane >> 3, n1 = lane & 7;
#pragma unroll
    for (int jj = 0; jj < 8; ++jj) { const int n = n1 + 8 * jj; const LAS float* r = scr + (8 * c) * 65 + n;
        v4u o; o.x = pk2(r[0], r[65]); o.y = pk2(r[2 * 65], r[3 * 65]); o.z = pk2(r[4 * 65], r[5 * 65]); o.w = pk2(r[6 * 65], r[7 * 65]);
        *(GAS v4u*)(dst + (size_t)n * K + k0 + 8 * c) = o; }
    LDS_WAIT(); asm volatile("" ::: "memory");
}

struct Args { const float* in[18]; float* out; unsigned char* ws; };
typedef const __attribute__((address_space(4))) Args CArgs;
__device__ __forceinline__ CArgs* fresh_args() { CArgs* p = (CArgs*)__builtin_amdgcn_kernarg_segment_ptr(); asm volatile("" : "+s"(p)); return p; }

constexpr int CI_FFNIN = (D / 64) * (NFF / 64), CI_FFNOUT = (DFF / 64) * (D / 64), CI_MIXIN = (D / 64) * (NMIX / 64), CI_QKV = (D / 64) * (NQKV / 64), CI_SQ = (D / 64) * (D / 64), CI_POOLW = 4 * 16;
constexpr int CI_EVEN = 2 * (CI_FFNIN + CI_FFNOUT) + CI_MIXIN + CI_POOLW + CI_SQ, CI_ODD = 2 * (CI_FFNIN + CI_FFNOUT) + CI_QKV + CI_SQ, CI_PAIR = CI_EVEN + CI_ODD, IT_TOTAL = 2 * CI_PAIR;
__device__ __forceinline__ int conv_seg_start(int l, int seg) {
    const int odd = l & 1; int o = (l >> 1) * CI_PAIR + (odd ? CI_EVEN : 0);
    const int sz[7] = {CI_FFNIN, CI_FFNOUT, odd ? CI_QKV : CI_MIXIN, odd ? 0 : CI_POOLW, CI_SQ, CI_FFNIN, CI_FFNOUT};
#pragma unroll
    for (int i = 0; i < 7; ++i) o += (i < seg) ? sz[i] : 0;
    return o;
}
__device__ __forceinline__ void conv_item(CArgs* ap, int it, LAS float* scr, int lane) {
    bf16* W = (bf16*)(ap->ws + WS_W);
    int l = 2 * (it / CI_PAIR), r = it % CI_PAIR; if (r >= CI_EVEN) { r -= CI_EVEN; l += 1; }
    const int odd = l & 1, j = l >> 1;
    int hl = 2 * l, kind;
    if (r < CI_FFNIN) kind = 0;
    else if ((r -= CI_FFNIN) < CI_FFNOUT) kind = 1;
    else if ((r -= CI_FFNOUT) < (odd ? CI_QKV : CI_MIXIN)) kind = odd ? 3 : 2;
    else if ((r -= (odd ? CI_QKV : CI_MIXIN)) < (odd ? 0 : CI_POOLW)) kind = 4;
    else if ((r -= (odd ? 0 : CI_POOLW)) < CI_SQ) kind = odd ? 6 : 5;
    else if ((r -= CI_SQ) < CI_FFNIN) { kind = 0; hl += 1; }
    else { r -= CI_FFNIN; kind = 1; hl += 1; }
    if (kind == 0) { constexpr int nbn = NFF / 64; const int kb = r / nbn, nb = r % nbn;
        const int n0 = nb * 64, tile = n0 >> 8, w = n0 & 255, scol = (w < 128) ? tile * 128 + w : DFF + tile * 128 + (w - 128);
        tr_item(ap->in[7] + (size_t)hl * D * NFF + scol, NFF, W + WO_FFNIN + (size_t)hl * SZ_FFNIN + (size_t)n0 * D, D, kb * 64, scr, lane); }
    else if (kind == 1) { constexpr int nbn = D / 64; const int kb = r / nbn, nb = r % nbn;
        tr_item(ap->in[8] + (size_t)hl * DFF * D + nb * 64, D, W + WO_FFNOUT + (size_t)hl * SZ_FFNOUT + (size_t)(nb * 64) * DFFP, DFFP, kb * 64, scr, lane); }
    else if (kind == 2) { constexpr int nbn = NMIX / 64; const int kb = r / nbn, nb = r % nbn;
        tr_item(ap->in[9] + (size_t)j * D * NMIX + nb * 64, NMIX, W + WO_MIXIN + (size_t)j * SZ_MIXIN + (size_t)(nb * 64) * D, D, kb * 64, scr, lane); }
    else if (kind == 3) { constexpr int nbn = NQKV / 64; const int kb = r / nbn, nb = r % nbn;
        tr_item(ap->in[14] + (size_t)j * D * NQKV + nb * 64, NQKV, W + WO_QKV + (size_t)j * SZ_QKV + (size_t)(nb * 64) * D, D, kb * 64, scr, lane); }
    else if (kind == 4) { const int mat = j * 4 + (r >> 4), rr = r & 15, kb = rr >> 2, nb = rr & 3;
        tr_item(ap->in[11] + (size_t)mat * 65536 + nb * 64, 256, W + WO_POOLW + (size_t)mat * 65536 + (size_t)(nb * 64) * 256, 256, kb * 64, scr, lane); }
    else { constexpr int nbn = D / 64; const int kb = r / nbn, nb = r % nbn;
        if (kind == 5) tr_item(ap->in[13] + (size_t)j * D * D + nb * 64, D, W + WO_MIXOUT + (size_t)j * SZ_MIXOUT + (size_t)(nb * 64) * D, D, kb * 64, scr, lane);
        else tr_item(ap->in[15] + (size_t)j * D * D + nb * 64, D, W + WO_WO + (size_t)j * SZ_WO + (size_t)(nb * 64) * D, D, kb * 64, scr, lane); }
}
__device__ __forceinline__ void conv_range(CArgs* ap, LAS unsigned char* lds, int lo, int hi, int w, int nworkers, int wave, int lane) {
    LAS float* scr = (LAS float*)(lds + wave * 16640);
    for (int it = lo + w; it < hi; it += nworkers) conv_item(ap, it, scr, lane);
}

__device__ __forceinline__ void prologue(CArgs* ap, LAS unsigned char* lds, int gw, int NGW, int wave, int lane) {
    struct { const float* in[18]; float* out; unsigned char* ws; } a;
    a.in[0] = ap->in[0]; a.in[1] = ap->in[1]; a.in[6] = ap->in[6]; a.out = ap->out; a.ws = ap->ws;
    bf16* W = (bf16*)(a.ws + WS_W);
    for (int r = gw * 4 + (lane >> 4); r < 8 * D + M; r += NGW * 4) {
        bf16* p = r < 8 * D ? W + WO_FFNOUT + (size_t)r * DFFP + DFF : (bf16*)(a.ws + WS_ACT) + (size_t)(r - 8 * D) * DFFP + DFF;
        *(GAS v4u*)(p + (lane & 15) * 8) = (v4u){0u, 0u, 0u, 0u}; }
    const GAS f32x4* g4 = (const GAS f32x4*)a.in[6];
    for (int row = gw; row < M; row += NGW) {
        const float* xr = row < MP ? a.in[0] + (size_t)row * D : a.in[1] + (size_t)(row - MP) * D;
        const GAS f32x4* x4 = (const GAS f32x4*)xr + lane;
        f32x4 v[8]; float ss = 0.f;
#pragma unroll
        for (int j = 0; j < 8; ++j) { v[j] = x4[64 * j]; ss += (v[j].x * v[j].x + v[j].y * v[j].y) + (v[j].z * v[j].z + v[j].w * v[j].w); }
        const float rs = 1.0f / sqrtf(wave_sum(ss) * (1.f / D) + EPS);
        GAS f32x4* xo = (GAS f32x4*)(a.out + (size_t)row * D) + lane;
        GAS v2u* ho = (GAS v2u*)((bf16*)(a.ws + WS_HB) + (size_t)row * D) + lane;
#pragma unroll
        for (int j = 0; j < 8; ++j) { xo[64 * j] = v[j]; const f32x4 g = g4[lane + 64 * j];
            v2u o; o.x = pk2(v[j].x * rs * g.x, v[j].y * rs * g.y); o.y = pk2(v[j].z * rs * g.z, v[j].w * rs * g.w); ho[64 * j] = o; }
    }
}

__device__ __forceinline__ void norm_row(f32x4 (&y)[8], float* X, bf16* HB, float sc, const GAS f32x4* ga4, const GAS f32x4* gb4, int row, int lane) {
    GAS f32x4* x4 = (GAS f32x4*)(X + (size_t)row * D) + lane;
    f32x4 x[8]; float ss = 0.f;
#pragma unroll
    for (int j = 0; j < 8; ++j) x[j] = x4[64 * j];
#pragma unroll
    for (int j = 0; j < 8; ++j) ss += (y[j].x * y[j].x + y[j].y * y[j].y) + (y[j].z * y[j].z + y[j].w * y[j].w);
    const float r1 = sc / sqrtf(wave_sum(ss) * (1.f / D) + EPS);
    float s2 = 0.f;
#pragma unroll
    for (int j = 0; j < 8; ++j) { const f32x4 g = ga4[lane + 64 * j]; x[j] = x[j] + y[j] * g * r1; x4[64 * j] = x[j];
        s2 += (x[j].x * x[j].x + x[j].y * x[j].y) + (x[j].z * x[j].z + x[j].w * x[j].w); }
    if (gb4) {
        const float r2 = 1.0f / sqrtf(wave_sum(s2) * (1.f / D) + EPS);
        GAS v2u* ho = (GAS v2u*)(HB + (size_t)row * D) + lane;
#pragma unroll
        for (int j = 0; j < 8; ++j) { const f32x4 g = gb4[lane + 64 * j];
            v2u o; o.x = pk2(x[j].x * r2 * g.x, x[j].y * r2 * g.y); o.y = pk2(x[j].z * r2 * g.z, x[j].w * r2 * g.w); ho[64 * j] = o; }
    }
}
template <int NSL>
__device__ __forceinline__ void norm_phase(const bf16* Y, const float* YP, float* X, bf16* HB, float sc, const float* ga, const float* gb, int gw, int NGW, int lane) {
    const GAS f32x4* ga4 = (const GAS f32x4*)ga; const GAS f32x4* gb4 = (const GAS f32x4*)gb;
    if ((gw & 7) == 0) {
        for (int r = gw >> 3; r < MS; r += (NGW >> 3)) {
            const GAS f32x4* p4 = (const GAS f32x4*)(YP + (size_t)r * D) + lane;
            f32x4 y[8];
#pragma unroll
            for (int j = 0; j < 8; ++j) { f32x4 pv[NSL];
#pragma unroll
                for (int i = 0; i < NSL; ++i) pv[i] = p4[(size_t)i * (256 * D / 4) + 64 * j];
                f32x4 a = pv[0];
#pragma unroll
                for (int i = 1; i < NSL; ++i) a = a + pv[i];
                y[j] = a; }
            norm_row(y, X, HB, sc, ga4, gb4, MP + r, lane);
        }
    }
    for (int row = gw; row < MP; row += NGW) {
        const GAS v2u* y2 = (const GAS v2u*)(Y + (size_t)row * D) + lane;
        f32x4 y[8];
#pragma unroll
        for (int j = 0; j < 8; ++j) { const v2u w = y2[64 * j]; y[j] = (f32x4){bf_lo(w.x), bf_hi(w.x), bf_lo(w.y), bf_hi(w.y)}; }
        norm_row(y, X, HB, sc, ga4, gb4, row, lane);
    }
}

__device__ __forceinline__ unsigned ldz(const bf16* Zb, unsigned off) { return *(const GAS unsigned*)((const GAS char*)Zb + off); }
__device__ __forceinline__ void convpool_phase(CArgs* ap, int j, int bid, int G, int tid) {
    const bf16* Z = (const bf16*)(ap->ws + WS_Z); bf16* CAT = (bf16*)(ap->ws + WS_CAT); bf16* DP = (bf16*)(ap->ws + WS_DP);
    const int c = 2 * tid, gi = tid >> 7, w = 2 << gi;
    const float* cw = ap->in[10] + (size_t)j * 3 * DCV + c;
    const f32x2 w0 = *(const f32x2*)cw, w1 = *(const f32x2*)(cw + DCV), w2 = *(const f32x2*)(cw + 2 * DCV);
    float* out = ap->out;
    for (int u = bid; u < 256 + DB; u += G) {
        if (u < 256) {
            const int b = u >> 6, t0 = (u & 63) * 32; const int rb = b * SEQ;
            const bf16* Zb = Z + (size_t)rb * NMIX; bf16* Cb = CAT + (size_t)rb * D; bf16* Db = DP + (size_t)rb * DCV;
            f32x2 vm2 = {0.f, 0.f}, vm1 = {0.f, 0.f}, S = {0.f, 0.f};
            if (t0 > 0) {
                { const unsigned o = (unsigned)((t0 - 2) * NMIX + c) * 2u; const unsigned h = ldz(Zb, o), g = ldz(Zb, o + 2048u); vm2 = (f32x2){bf_lo(h) * bf_lo(g), bf_hi(h) * bf_hi(g)}; }
                { const unsigned o = (unsigned)((t0 - 1) * NMIX + c) * 2u; const unsigned h = ldz(Zb, o), g = ldz(Zb, o + 2048u); vm1 = (f32x2){bf_lo(h) * bf_lo(g), bf_hi(h) * bf_hi(g)}; }
                for (int i = 1; i <= w; ++i) { const unsigned uu = ldz(Zb, (unsigned)((t0 - i) * NMIX + 3072 + c) * 2u); S.x += bf_lo(uu); S.y += bf_hi(uu); }
            }
            const bool lastc = (t0 == SEQ - 32);
#pragma unroll 2
            for (int t = t0; t < t0 + 32; ++t) {
                const unsigned o = (unsigned)(t * NMIX + c) * 2u;
                const unsigned hh = ldz(Zb, o), gg = ldz(Zb, o + 2048u), bb = ldz(Zb, o + 4096u), uu = ldz(Zb, o + 6144u);
                unsigned uo = 0u; if (t >= w) uo = ldz(Zb, (unsigned)((t - w) * NMIX + 3072 + c) * 2u);
                const f32x2 v = {bf_lo(hh) * bf_lo(gg), bf_hi(hh) * bf_hi(gg)};
                const f32x2 yc = w0 * vm2 + w1 * vm1 + w2 * v; vm2 = vm1; vm1 = v;
                const f32x2 ut = {bf_lo(uu), bf_hi(uu)};
                S.x += ut.x - bf_lo(uo); S.y += ut.y - bf_hi(uo);
                const float cnt = (float)((t + 1 < w) ? (t + 1) : w);
                const f32x2 dd = S / cnt - ut;
                *(GAS unsigned*)((GAS char*)Cb + (unsigned)(t * D + c) * 2u) = pk2(bf_lo(bb) * yc.x, bf_hi(bb) * yc.y);
                *(GAS unsigned*)((GAS char*)Db + (unsigned)(t * DCV + c) * 2u) = pk2(dd.x, dd.y);
                if (lastc) {
                    if (t >= SEQ - 2) *(GAS f32x2*)((GAS char*)(out + O_CONVP + (size_t)(j * NB + b) * 2 * DCV) + (unsigned)((t - (SEQ - 2)) * DCV + c) * 4u) = v;
                    if (t >= SEQ - PCTX) *(GAS f32x2*)((GAS char*)(out + O_POOLP + (size_t)(j * NB + b) * PCTX * DCV) + (unsigned)((t - (SEQ - PCTX)) * DCV + c) * 4u) = ut;
                }
            }
        } else {
            const int b = u - 256; const int rb = MP + b * DS;
            const bf16* Zb = Z + (size_t)rb * NMIX; bf16* Cb = CAT + (size_t)rb * D; bf16* Db = DP + (size_t)rb * DCV;
            const GAS char* cc = (const GAS char*)(ap->in[2] + (size_t)(j * DB + b) * 2 * DCV);
            const GAS char* pc = (const GAS char*)(ap->in[3] + (size_t)(j * DB + b) * PCTX * DCV);
            GAS char* pso = (GAS char*)(out + O_POOLS + (size_t)(j * DB + b) * PCTX * DCV);
            GAS char* cso = (GAS char*)(out + O_CONVS + (size_t)(j * DB + b) * 2 * DCV);
            const unsigned c4 = (unsigned)c * 4u;
            f32x2 vm2 = *(const GAS f32x2*)(cc + c4), vm1 = *(const GAS f32x2*)(cc + c4 + DCV * 4u), S = {0.f, 0.f};
            for (int i = 1; i <= w && i <= PCTX; ++i) { const f32x2 p = *(const GAS f32x2*)(pc + c4 + (unsigned)(PCTX - i) * (DCV * 4u)); S += p; }
            for (int i = 0; i < PCTX - DS; ++i) *(GAS f32x2*)(pso + c4 + (unsigned)i * (DCV * 4u)) = *(const GAS f32x2*)(pc + c4 + (unsigned)(DS + i) * (DCV * 4u));
            for (int t = 0; t < DS; ++t) {
                const unsigned o = (unsigned)(t * NMIX + c) * 2u;
                const unsigned hh = ldz(Zb, o), gg = ldz(Zb, o + 2048u), bb = ldz(Zb, o + 4096u), uu = ldz(Zb, o + 6144u);
                f32x2 uo = {0.f, 0.f};
                if (t - w >= 0) { const unsigned uw = ldz(Zb, (unsigned)((t - w) * NMIX + 3072 + c) * 2u); uo = (f32x2){bf_lo(uw), bf_hi(uw)}; }
                else if (t - w >= -PCTX) uo = *(const GAS f32x2*)(pc + c4 + (unsigned)(PCTX + t - w) * (DCV * 4u));
                const f32x2 v = {bf_lo(hh) * bf_lo(gg), bf_hi(hh) * bf_hi(gg)};
                const f32x2 yc = w0 * vm2 + w1 * vm1 + w2 * v; vm2 = vm1; vm1 = v;
                const f32x2 ut = {bf_lo(uu), bf_hi(uu)};
                S += ut - uo;
                const f32x2 dd = S / (float)w - ut;
                *(GAS unsigned*)((GAS char*)Cb + (unsigned)(t * D + c) * 2u) = pk2(bf_lo(bb) * yc.x, bf_hi(bb) * yc.y);
                *(GAS unsigned*)((GAS char*)Db + (unsigned)(t * DCV + c) * 2u) = pk2(dd.x, dd.y);
                if (t >= DS - 2) *(GAS f32x2*)(cso + c4 + (unsigned)(t - (DS - 2)) * (DCV * 4u)) = v;
                *(GAS f32x2*)(pso + c4 + (unsigned)(PCTX - DS + t) * (DCV * 4u)) = ut;
            }
        }
    }
}

constexpr int AT_KP = 144, AT_VP = 520;
constexpr int AT_K = 0, AT_V = 256 * AT_KP, AT_B = AT_V + 64 * AT_VP, AT_END = AT_B + NHEAD * 192 * 4;
static_assert(AT_END <= RING_BYTES && (AT_V % 16) == 0 && (AT_B % 16) == 0, "attention LDS map");
__device__ __forceinline__ int crow(int r, int hi) { return (r & 3) + 8 * (r >> 2) + 4 * hi; }

__device__ __forceinline__ void attention_phase(CArgs* ap, LAS unsigned char* lds, int j, int bid, int G, int tid, int wave, int lane_in) {
    const bf16* QKV = (const bf16*)(ap->ws + WS_Z); bf16* ATT = (bf16*)(ap->ws + WS_CAT);
    float* out = ap->out; const float* relb = ap->in[17]; const float* ck = ap->in[4]; const float* cv = ap->in[5]; const float* sinks = ap->in[16];
    LAS float* biasL = (LAS float*)(lds + AT_B);
    for (int e = tid; e < NHEAD * 192; e += NWAVES * 64) {
        const int h = e / 192, dist = e % 192 - 32; float v = -1e30f;
        if (dist >= 0 && dist <= 128) { int bk = dist;
            if (dist >= 16) { const float ratio = logf((float)dist / 16.0f) / 2.0794415416798357f; bk = 16 + (int)(ratio * 16.0f); if (bk > 31) bk = 31; }
            v = relb[bk * NHEAD + h] * LOG2E; }
        biasL[e] = v;
    }
    const float CS = 0.125f * LOG2E;
    for (int u = bid; u < 256 + DB * NKVH; u += G) {
        __syncthreads();
        asm volatile("" : "+v"(tid));
        const bool prompt = u < 256;
        int b, kvh, row0; bool first = false, lastb = false;
        if (prompt) { b = u >> 6; kvh = (u >> 4) & 3; const int qb = u & 15; row0 = b * SEQ + qb * 128; first = (qb == 0); lastb = (qb == 15); }
        else { const int su = u - 256; b = su >> 2; kvh = su & 3; row0 = MP + b * DS; }
        if (prompt) {
#pragma unroll
            for (int it = 0; it < 4; ++it) { const int id = it * 512 + tid, row = id >> 3, ch = id & 7;
                v4u kv = {0u, 0u, 0u, 0u}, vv = {0u, 0u, 0u, 0u};
                if (!(first && row < 128)) { const bf16* src = QKV + (size_t)(row0 - 128 + row) * NQKV + 2048 + kvh * 64 + ch * 8; kv = *(const GAS v4u*)src; vv = *(const GAS v4u*)(src + 256); }
                *(LAS v4u*)(lds + AT_K + row * AT_KP + ch * 16) = kv;
                LAS bf16* vt = (LAS bf16*)(lds + AT_V + (ch * 8) * AT_VP) + row;
                vt[0] = (bf16)(vv.x & 0xffff); vt[AT_VP / 2] = (bf16)(vv.x >> 16); vt[2 * (AT_VP / 2)] = (bf16)(vv.y & 0xffff); vt[3 * (AT_VP / 2)] = (bf16)(vv.y >> 16);
                vt[4 * (AT_VP / 2)] = (bf16)(vv.z & 0xffff); vt[5 * (AT_VP / 2)] = (bf16)(vv.z >> 16); vt[6 * (AT_VP / 2)] = (bf16)(vv.w & 0xffff); vt[7 * (AT_VP / 2)] = (bf16)(vv.w >> 16);
                if (lastb && row >= 128) { const size_t o = ((size_t)(j * NB + b) * KVB + (row - 128)) * 256 + kvh * 64 + ch * 8;
                    *(f32x4*)(out + O_KP + o) = (f32x4){bf_lo(kv.x), bf_hi(kv.x), bf_lo(kv.y), bf_hi(kv.y)}; *(f32x4*)(out + O_KP + o + 4) = (f32x4){bf_lo(kv.z), bf_hi(kv.z), bf_lo(kv.w), bf_hi(kv.w)};
                    *(f32x4*)(out + O_VP + o) = (f32x4){bf_lo(vv.x), bf_hi(vv.x), bf_lo(vv.y), bf_hi(vv.y)}; *(f32x4*)(out + O_VP + o + 4) = (f32x4){bf_lo(vv.z), bf_hi(vv.z), bf_lo(vv.w), bf_hi(vv.w)}; }
            }
        } else {
#pragma unroll
            for (int it = 0; it < 3; ++it) { const int id = it * 512 + tid, row = id >> 3, ch = id & 7;
                if (row < 160) {
                    v4u kv = {0u, 0u, 0u, 0u}, vv = {0u, 0u, 0u, 0u};
                    f32x4 k0 = {0.f, 0.f, 0.f, 0.f}, k1 = k0, v0 = k0, v1 = k0;
                    if (row < 128) { const size_t so = ((size_t)(j * DB + b) * KVB + row) * 256 + kvh * 64 + ch * 8;
                        k0 = *(const f32x4*)(ck + so); k1 = *(const f32x4*)(ck + so + 4); v0 = *(const f32x4*)(cv + so); v1 = *(const f32x4*)(cv + so + 4);
                        kv = (v4u){pk2(k0.x, k0.y), pk2(k0.z, k0.w), pk2(k1.x, k1.y), pk2(k1.z, k1.w)}; vv = (v4u){pk2(v0.x, v0.y), pk2(v0.z, v0.w), pk2(v1.x, v1.y), pk2(v1.z, v1.w)}; }
                    else if (row < 128 + DS) { const bf16* src = QKV + (size_t)(row0 + row - 128) * NQKV + 2048 + kvh * 64 + ch * 8; kv = *(const GAS v4u*)src; vv = *(const GAS v4u*)(src + 256);
                        k0 = (f32x4){bf_lo(kv.x), bf_hi(kv.x), bf_lo(kv.y), bf_hi(kv.y)}; k1 = (f32x4){bf_lo(kv.z), bf_hi(kv.z), bf_lo(kv.w), bf_hi(kv.w)};
                        v0 = (f32x4){bf_lo(vv.x), bf_hi(vv.x), bf_lo(vv.y), bf_hi(vv.y)}; v1 = (f32x4){bf_lo(vv.z), bf_hi(vv.z), bf_lo(vv.w), bf_hi(vv.w)}; }
                    *(LAS v4u*)(lds + AT_K + row * AT_KP + ch * 16) = kv;
                    LAS bf16* vt = (LAS bf16*)(lds + AT_V + (ch * 8) * AT_VP) + row;
                    vt[0] = (bf16)(vv.x & 0xffff); vt[AT_VP / 2] = (bf16)(vv.x >> 16); vt[2 * (AT_VP / 2)] = (bf16)(vv.y & 0xffff); vt[3 * (AT_VP / 2)] = (bf16)(vv.y >> 16);
                    vt[4 * (AT_VP / 2)] = (bf16)(vv.z & 0xffff); vt[5 * (AT_VP / 2)] = (bf16)(vv.z >> 16); vt[6 * (AT_VP / 2)] = (bf16)(vv.w & 0xffff); vt[7 * (AT_VP / 2)] = (bf16)(vv.w >> 16);
                    if (row >= DS && row < 128 + DS) { const size_t o = ((size_t)(j * DB + b) * KVB + (row - DS)) * 256 + kvh * 64 + ch * 8;
                        *(f32x4*)(out + O_KS + o) = k0; *(f32x4*)(out + O_KS + o + 4) = k1; *(f32x4*)(out + O_VS + o) = v0; *(f32x4*)(out + O_VS + o + 4) = v1; }
                }
            }
        }
        LDS_WAIT();
        __syncthreads();
        const int lane = tid & 63, l31 = lane & 31, hi = lane >> 5;
        const int h = kvh * 8 + wave;
        const float sink2 = sinks[j * NHEAD + h] * LOG2E;
        const LAS float* bl = biasL + h * 192 + 160 + l31 - 4 * hi;
        const int nsub = prompt ? 4 : 1;
        bf16x8 qn[4];
        { const int qrow0 = prompt ? (row0 + l31) : (row0 + (l31 & 7));
#pragma unroll
          for (int k0 = 0; k0 < 4; ++k0) qn[k0] = *(const GAS bf16x8*)(QKV + (size_t)qrow0 * NQKV + h * 64 + 16 * k0 + 8 * hi); }
        for (int sub = 0; sub < nsub; ++sub) {
            const int qrow = prompt ? (row0 + 32 * sub + l31) : (row0 + (l31 & 7));
            bf16x8 qr[4];
#pragma unroll
            for (int k0 = 0; k0 < 4; ++k0) qr[k0] = qn[k0];
            if (sub + 1 < nsub) {
#pragma unroll
                for (int k0 = 0; k0 < 4; ++k0) qn[k0] = *(const GAS bf16x8*)(QKV + (size_t)(qrow + 32) * NQKV + h * 64 + 16 * k0 + 8 * hi); }
            f32x16 acc[5];
#pragma unroll
            for (int jt = 0; jt < 5; ++jt) {
                const int T = sub + jt;
                f32x16 c = {0.f, 0.f, 0.f, 0.f, 0.f, 0.f, 0.f, 0.f, 0.f, 0.f, 0.f, 0.f, 0.f, 0.f, 0.f, 0.f};
#pragma unroll
                for (int k0 = 0; k0 < 4; ++k0) { const bf16x8 kf = *(const LAS bf16x8*)(lds + AT_K + (32 * T + l31) * AT_KP + (16 * k0 + 8 * hi) * 2);
                    c = __builtin_amdgcn_mfma_f32_32x32x16_bf16(kf, qr[k0], c, 0, 0, 0); }
                acc[jt] = c;
            }
            float mx = -1e30f;
#pragma unroll
            for (int jt = 0; jt < 5; ++jt) {
                const float tm = (first && (sub + jt) < 4) ? -1e30f : 0.f;
#pragma unroll
                for (int r = 0; r < 16; ++r) { const float s = acc[jt][r] * CS + (bl[-32 * jt - ((r & 3) + 8 * (r >> 2))] + tm); acc[jt][r] = s; mx = fmaxf(mx, s); }
            }
            mx = fmaxf(mx, __shfl_xor(mx, 32));
            mx = fmaxf(mx, sink2);
            float ls = 0.f;
#pragma unroll
            for (int jt = 0; jt < 5; ++jt)
#pragma unroll
                for (int r = 0; r < 16; ++r) { const float p = __builtin_amdgcn_exp2f(acc[jt][r] - mx); acc[jt][r] = p; ls += p; }
            ls += __shfl_xor(ls, 32);
            ls += __builtin_amdgcn_exp2f(sink2 - mx);
            f32x16 o0 = {0.f, 0.f, 0.f, 0.f, 0.f, 0.f, 0.f, 0.f, 0.f, 0.f, 0.f, 0.f, 0.f, 0.f, 0.f, 0.f}, o1 = o0;
#pragma unroll
            for (int jt = 0; jt < 5; ++jt) {
                const int T = sub + jt;
#pragma unroll
                for (int c2 = 0; c2 < 2; ++c2) {
                    v4u pw; pw.x = pk2(acc[jt][8 * c2 + 0], acc[jt][8 * c2 + 1]); pw.y = pk2(acc[jt][8 * c2 + 2], acc[jt][8 * c2 + 3]); pw.z = pk2(acc[jt][8 * c2 + 4], acc[jt][8 * c2 + 5]); pw.w = pk2(acc[jt][8 * c2 + 6], acc[jt][8 * c2 + 7]);
                    const bf16x8 pf = __builtin_bit_cast(bf16x8, pw);
                    const LAS unsigned char* vb = lds + AT_V + l31 * AT_VP + (32 * T + 16 * c2 + 4 * hi) * 2;
                    { const s16x4 lo = *(const LAS s16x4*)vb, hh = *(const LAS s16x4*)(vb + 16); const bf16x8 vf = {lo[0], lo[1], lo[2], lo[3], hh[0], hh[1], hh[2], hh[3]};
                      o0 = __builtin_amdgcn_mfma_f32_32x32x16_bf16(vf, pf, o0, 0, 0, 0); }
                    { const s16x4 lo = *(const LAS s16x4*)(vb + 32 * AT_VP), hh = *(const LAS s16x4*)(vb + 32 * AT_VP + 16); const bf16x8 vf = {lo[0], lo[1], lo[2], lo[3], hh[0], hh[1], hh[2], hh[3]};
                      o1 = __builtin_amdgcn_mfma_f32_32x32x16_bf16(vf, pf, o1, 0, 0, 0); }
                }
            }
            const float inv = 1.0f / ls;
            if (prompt || l31 < DS) {
                bf16* orow = ATT + (size_t)(prompt ? qrow : (row0 + l31)) * D + h * 64 + 4 * hi;
#pragma unroll
                for (int rq = 0; rq < 4; ++rq) {
                    v2u w0; w0.x = pk2(o0[4 * rq] * inv, o0[4 * rq + 1] * inv); w0.y = pk2(o0[4 * rq + 2] * inv, o0[4 * rq + 3] * inv); *(GAS v2u*)(orow + 8 * rq) = w0;
                    v2u w1; w1.x = pk2(o1[4 * rq] * inv, o1[4 * rq + 1] * inv); w1.y = pk2(o1[4 * rq + 2] * inv, o1[4 * rq + 3] * inv); *(GAS v2u*)(orow + 32 + 8 * rq) = w1;
                }
            }
        }
    }
    __syncthreads();
}

__global__ void __launch_bounds__(NWAVES * 64, 2) mega_fwd(Args args) {
    extern __shared__ __attribute__((aligned(16))) unsigned char lds_raw[];
    LAS unsigned char* lds = (LAS unsigned char*)lds_raw;
    const int tid = threadIdx.x, lane = tid & 63, wave = __builtin_amdgcn_readfirstlane(tid >> 6);
    const int G = gridDim.x, bid = blockIdx.x;
    const int vcu = (G % 8 == 0) ? (bid % 8) * (G / 8) + bid / 8 : bid;
    const int gw = vcu * NWAVES + wave, NGW = G * NWAVES;
    CArgs* ap0 = fresh_args();
    for (int u = tid; u < (LDS_BYTES - LDSCTL_OFF) / 4; u += NWAVES * 64) ((LAS unsigned*)(lds + LDSCTL_OFF))[u] = 0u;
    __syncthreads();
    XcdBarrier bar = xcd_barrier_post((unsigned*)(ap0->ws + WS_CTL) + CW_BAR, (volatile LAS unsigned*)(lds + MISC_OFF) + 8);
#define GRID_BAR() xcd_barrier(bar)
#define FRESH_TID() int tid_ = threadIdx.x; asm volatile("" : "+v"(tid_)); const int lane_ = tid_ & 63, wave_ = __builtin_amdgcn_readfirstlane(tid_ >> 6), gw_ = vcu * NWAVES + wave_; (void)lane_; (void)gw_

    int cursor = 0;
#define ENSURE(need) do { const int need_ = (need); if (cursor < need_) { FRESH_TID(); conv_range(fresh_args(), lds, cursor, need_, gw_, NGW, wave_, lane_); cursor = need_; } } while (0)
#define IDLE_CONV(first_idle, per_wave) do { if (cursor < IT_TOTAL) { const int nid_ = G - (first_idle); int hi_ = cursor + nid_ * NWAVES * (per_wave); if (hi_ > IT_TOTAL) hi_ = IT_TOTAL; \
        if (bid >= (first_idle)) { FRESH_TID(); conv_range(fresh_args(), lds, cursor, hi_, (bid - (first_idle)) * NWAVES + wave_, nid_ * NWAVES, wave_, lane_); } cursor = hi_; } } while (0)
    prologue(ap0, lds, gw, NGW, wave, lane);
    ENSURE(conv_seg_start(0, 1));
    GRID_BAR();

    for (int hl = 0; hl < 8; ++hl) {
        const int l = hl >> 1, f = hl & 1, j = l >> 1;
        const bool odd = (l & 1) != 0;
        {
            CArgs* ap = fresh_args(); unsigned char* ws = ap->ws;
            const pg8::Gemm g = pg8::plain_gemm((const bf16*)(ws + WS_HB), (const bf16*)(ws + WS_W) + WO_FFNIN + (size_t)hl * SZ_FFNIN, D, D, D); pg8::StaticOrder S; S.init(M, NFF, G, bid);
            pg8::EpiSwiGLU E{(bf16*)(ws + WS_ACT), DFFP};
            pg8::gemm_phase<pg8::EpiSwiGLU, pg8::StaticOrder, true, true>(lds, g, S, E);
        }
        IDLE_CONV((M / 256) * (NFF / 256) % G == 0 ? G : (M / 256) * (NFF / 256) % G, 7);
        ENSURE(conv_seg_start(l, f ? 7 : 2));
        GRID_BAR();
        {
            CArgs* ap = fresh_args(); unsigned char* ws = ap->ws;
            const bf16* Wo_ = (const bf16*)(ws + WS_W) + WO_FFNOUT + (size_t)hl * SZ_FFNOUT;
            { const pg8::Gemm g = pg8::plain_gemm((const bf16*)(ws + WS_ACT), Wo_, DFF, DFFP, DFFP); pg8::StaticOrder S; S.init(MP, D, G, bid);
              pg8::EpiBf16S E{(bf16*)(ws + WS_Y), D, nullptr, 0};
              pg8::gemm_phase<pg8::EpiBf16S, pg8::StaticOrder, true, true>(lds, g, S, E); }
            { const pg8::Gemm g{(const bf16*)(ws + WS_ACT) + (size_t)MP * DFFP, Wo_, KSL_FFN, DFFP, DFFP, KSL_FFN * 2, 0, (size_t)256 * DFFP * 2, KSL_FFN * 2}; pg8::StaticOrder S; S.init(NSL_FFN * 256, D, G, bid);
              pg8::EpiF32 E{(float*)(ws + WS_YP), D};
              pg8::gemm_phase<pg8::EpiF32, pg8::StaticOrder, true, true>(lds, g, S, E); }
        }
        GRID_BAR();
        {
            CArgs* ap = fresh_args(); unsigned char* ws = ap->ws; const float* NG = ap->in[6];
            const float* ga = NG + (size_t)(l * 6 + (f ? 5 : 1)) * D;
            const float* gb = f == 0 ? NG + (size_t)(l * 6 + 2) * D : (l < 3 ? NG + (size_t)((l + 1) * 6) * D : nullptr);
            FRESH_TID();
            norm_phase<NSL_FFN>((const bf16*)(ws + WS_Y), (const float*)(ws + WS_YP), ap->out, (bf16*)(ws + WS_HB), 0.5f, ga, gb, gw_, NGW, lane_);
        }
        ENSURE(f == 0 ? conv_seg_start(l, 3) : (l < 3 ? conv_seg_start(l + 1, 1) : IT_TOTAL));
        GRID_BAR();
        if (f == 0) {
            {
                CArgs* ap = fresh_args(); unsigned char* ws = ap->ws;
                const int N = odd ? NQKV : NMIX; const bf16* W = (const bf16*)(ws + WS_W);
                const pg8::Gemm g = pg8::plain_gemm((const bf16*)(ws + WS_HB), odd ? W + WO_QKV + (size_t)j * SZ_QKV : W + WO_MIXIN + (size_t)j * SZ_MIXIN, D, D, D); pg8::StaticOrder S; S.init(M, N, G, bid);
                pg8::EpiBf16S E{(bf16*)(ws + WS_Z), N, nullptr, 0};
                pg8::gemm_phase<pg8::EpiBf16S, pg8::StaticOrder, true, true>(lds, g, S, E);
            }
            { const int nu_ = (M / 256) * ((odd ? NQKV : NMIX) / 256); IDLE_CONV(nu_ % G == 0 ? G : nu_ % G, odd ? 5 : 4); }
            ENSURE(conv_seg_start(l, 5));
            GRID_BAR();
            if (odd) {
                FRESH_TID();
                attention_phase(fresh_args(), lds, j, bid, G, tid_, wave_, lane_);
                GRID_BAR();
            } else {
                { FRESH_TID();
                  convpool_phase(fresh_args(), j, bid, G, tid_); }
                GRID_BAR();
                {
                    CArgs* ap = fresh_args(); unsigned char* ws = ap->ws;
                    const pg8::Gemm g{(const bf16*)(ws + WS_DP), (const bf16*)(ws + WS_W) + WO_POOLW + (size_t)j * SZ_POOLW, 256, DCV, 256, (size_t)256 * DCV * 2, 512, (size_t)256 * 256 * 2, 0}; pg8::StaticOrder S; S.init(M, DCV, G, bid);
                    pg8::EpiBf16S E{(bf16*)(ws + WS_CAT), D, ap->in[12] + (size_t)j * DCV, DCV};
                    pg8::gemm_phase<pg8::EpiBf16S, pg8::StaticOrder, true, true>(lds, g, S, E);
                }
                GRID_BAR();
            }
            {
                CArgs* ap = fresh_args(); unsigned char* ws = ap->ws; const bf16* W = (const bf16*)(ws + WS_W);
                const bf16* Wm = odd ? W + WO_WO + (size_t)j * SZ_WO : W + WO_MIXOUT + (size_t)j * SZ_MIXOUT;
                { const pg8::Gemm g = pg8::plain_gemm((const bf16*)(ws + WS_CAT), Wm, D, D, D); pg8::StaticOrder S; S.init(MP, D, G, bid);
                  pg8::EpiBf16S E{(bf16*)(ws + WS_Y), D, nullptr, 0};
                  pg8::gemm_phase<pg8::EpiBf16S, pg8::StaticOrder, true, true>(lds, g, S, E); }
                { const pg8::Gemm g{(const bf16*)(ws + WS_CAT) + (size_t)MP * D, Wm, KSL_MIX, D, D, KSL_MIX * 2, 0, (size_t)256 * D * 2, KSL_MIX * 2}; pg8::StaticOrder S; S.init(NSL_MIX * 256, D, G, bid);
                  pg8::EpiF32 E{(float*)(ws + WS_YP), D};
                  pg8::gemm_phase<pg8::EpiF32, pg8::StaticOrder, true, true>(lds, g, S, E); }
            }
            GRID_BAR();
            {   CArgs* ap = fresh_args(); unsigned char* ws = ap->ws; const float* NG = ap->in[6];
                FRESH_TID();
                norm_phase<NSL_MIX>((const bf16*)(ws + WS_Y), (const float*)(ws + WS_YP), ap->out, (bf16*)(ws + WS_HB), 1.0f, NG + (size_t)(l * 6 + 3) * D, NG + (size_t)(l * 6 + 4) * D, gw_, NGW, lane_); }
            ENSURE(conv_seg_start(l, 6));
            GRID_BAR();
        }
    }
}

extern "C" void kernel_launch(void* const* d_in, const int* in_sizes, int n_in, void* d_out, int out_size, void* d_ws, size_t ws_size, hipStream_t stream) {
    static int grid = 0;
    if (grid == 0) {
        if (n_in != 18 || out_size != (int)O_END || ws_size < WS_END) { fprintf(stderr, "kernel_launch: unexpected shapes (n_in %d, out %d, ws %zu; need ws >= %zu)\n", n_in, out_size, ws_size, (size_t)WS_END); grid = -1; return; }
        int dev = 0, cus = 0, per_cu = 0;
        if (hipGetDevice(&dev) != hipSuccess || hipDeviceGetAttribute(&cus, hipDeviceAttributeMultiprocessorCount, dev) != hipSuccess) { grid = -1; return; }
        if (hipFuncSetAttribute((const void*)mega_fwd, hipFuncAttributeMaxDynamicSharedMemorySize, LDS_BYTES) != hipSuccess) { fprintf(stderr, "kernel_launch: hipFuncSetAttribute failed\n"); grid = -1; return; }
        if (hipOccupancyMaxActiveBlocksPerMultiprocessor(&per_cu, (const void*)mega_fwd, NWAVES * 64, LDS_BYTES) != hipSuccess || per_cu < 1)
            fprintf(stderr, "kernel_launch: occupancy query reports %d\n", per_cu);
        (void)hipGetLastError();
        grid = cus;
    }
    if (grid < 0) return;
    if (hipMemsetAsync((char*)d_ws + WS_CTL, 0, CTL_ZERO_BYTES, stream) != hipSuccess) return;
    Args a{};
    for (int i = 0; i < 18; ++i) a.in[i] = (const float*)d_in[i];
    a.out = (float*)d_out; a.ws = (unsigned char*)d_ws;
    hipLaunchKernelGGL(mega_fwd, dim3(grid), dim3(NWAVES * 64), LDS_BYTES, stream, a);
}
```

```cpp
#include <hip/hip_runtime.h>
#include <cstdio>
#include <cstdint>

#define LAS __attribute__((address_space(3)))
#define GAS __attribute__((address_space(1)))

namespace pg8 {
typedef unsigned short bf16_t;
typedef short bf16x8 __attribute__((ext_vector_type(8)));
typedef float f32x4 __attribute__((ext_vector_type(4)));
typedef float f32x2 __attribute__((ext_vector_type(2)));
typedef unsigned u32x4 __attribute__((ext_vector_type(4)));
constexpr int BM = 256, BK = 64, HALF = 128, HTB = HALF * BK * 2, STAGE_BYTES = 8 * HTB, NXCD = 8, WGM = 8;

__host__ __device__ __forceinline__ int lds_byte(int r, int c) { const int st = (r >> 4) * 2 + (c >> 5), rr = r & 15, cc = c & 31, ob = rr * 64 + cc * 2; return st * 1024 + (ob ^ (((ob >> 9) & 1) << 5)); }
__host__ __device__ __forceinline__ void stage_rc(int b, int& R, int& C) { const int st = b / 1024, sb = b % 1024, swz = sb ^ (((sb >> 9) & 1) << 5); R = (st >> 1) * 16 + swz / 64; C = (st & 1) * 32 + (swz % 64) / 2; }
__host__ __device__ __forceinline__ int perm32(int rho) { const int n = rho >> 4, i = rho & 15; return 8 * (i >> 2) + 4 * n + (i & 3); }

struct Unit { int pm, pn; };
struct Gemm { const bf16_t* A; const bf16_t* Bt; int K, lda, ldb; size_t a_pm, a_pn, b_pn, b_pm; };
__device__ __forceinline__ Gemm plain_gemm(const bf16_t* A, const bf16_t* Bt, int K, int lda, int ldb) { return Gemm{A, Bt, K, lda, ldb, (size_t)BM * lda * 2, 0, (size_t)BM * ldb * 2, 0}; }

struct StaticOrder {
    int nM, nN, nwg, G, c;
    __host__ __device__ void init(int M, int N, int G_, int c_) { nM = M / BM; nN = N / BM; nwg = nM * nN; G = G_; c = c_; }
    __host__ __device__ bool next(int i, Unit& u) const {
        const long L = (long)i * G + c; if (L >= nwg) return false;
        int wgid = (int)L; { const int q = nwg / NXCD, r = nwg % NXCD, xcd = wgid % NXCD, off = wgid / NXCD; wgid = (xcd < r ? xcd * (q + 1) : r * (q + 1) + (xcd - r) * q) + off; }
        const int nig = WGM * nN, gid = wgid / nig, fm = gid * WGM, gsz = (nM - fm) < WGM ? (nM - fm) : WGM;
        u.pm = fm + ((wgid % nig) % gsz); u.pn = (wgid % nig) / gsz; return true;
    }
    __device__ __forceinline__ void a_ready(const Unit&) const {}
    __device__ __forceinline__ void done(const Unit&) const {}
};

__device__ __forceinline__ unsigned cvt_pk_bf16(float lo, float hi) { unsigned r; asm volatile("v_cvt_pk_bf16_f32 %0, %1, %2" : "=v"(r) : "v"(lo), "v"(hi)); return r; }

struct EpiF32 {
    static constexpr bool PERM = false, AFTER_DRAIN = false;
    float* C; int ldc;
    __device__ __forceinline__ void operator()(const f32x4 (&acc)[2][2][4][2], const Unit& u, int wr, int wc, int fr, int fq) const {
        const int row0 = u.pm * BM + wr * 64 + fr, col0 = u.pn * BM + wc * 32 + 4 * fq;
#pragma unroll
        for (int ai = 0; ai < 2; ++ai)
#pragma unroll
            for (int m = 0; m < 4; ++m) { float* rowp = C + (size_t)(row0 + ai * HALF + m * 16) * ldc + col0;
#pragma unroll
                for (int bj = 0; bj < 2; ++bj)
#pragma unroll
                    for (int n = 0; n < 2; ++n) *(f32x4*)(rowp + bj * HALF + n * 16) = acc[ai][bj][m][n]; }
    }
};
struct EpiBf16S {
    static constexpr bool PERM = true, AFTER_DRAIN = false;
    bf16_t* O; int ldc; const float* scale; int col_off; const float* rs;
    __device__ __forceinline__ void operator()(const f32x4 (&acc)[2][2][4][2], const Unit& u, int wr, int wc, int fr, int fq) const {
        float rsv[8];
        { const GAS float* p = (const GAS float*)rs + (u.pm * BM + wr * 64 + fr);
#pragma unroll
          for (int i = 0; i < 8; ++i) rsv[i] = rs ? p[(i >> 2) * HALF + (i & 3) * 16] : 1.0f; }
        const int row0 = u.pm * BM + wr * 64 + fr; const int col0 = u.pn * BM + wc * 32 + 8 * fq;
        f32x4 sv[2][2];
#pragma unroll
        for (int bj = 0; bj < 2; ++bj)
#pragma unroll
            for (int n = 0; n < 2; ++n) sv[bj][n] = scale ? *(const f32x4*)(scale + col0 + bj * HALF + 4 * n) : (f32x4){1.f, 1.f, 1.f, 1.f};
#pragma unroll
        for (int ai = 0; ai < 2; ++ai)
#pragma unroll
            for (int m = 0; m < 4; ++m) { bf16_t* rowp = O + (size_t)(row0 + ai * HALF + m * 16) * ldc + col_off + col0; const float r = rsv[ai * 4 + m];
#pragma unroll
                for (int bj = 0; bj < 2; ++bj) { const f32x4 v0 = acc[ai][bj][m][0] * sv[bj][0] * r, v1 = acc[ai][bj][m][1] * sv[bj][1] * r;
                    u32x4 w; w.x = cvt_pk_bf16(v0[0], v0[1]); w.y = cvt_pk_bf16(v0[2], v0[3]); w.z = cvt_pk_bf16(v1[0], v1[1]); w.w = cvt_pk_bf16(v1[2], v1[3]);
                    *(u32x4*)(rowp + bj * HALF) = w; } }
    }
};
__device__ __forceinline__ f32x2 silu_mul2(f32x2 g, f32x2 u) {
    const f32x2 t = g * u, a = g * -1.44269504089f;
    f32x2 e; e.x = __builtin_amdgcn_exp2f(a.x); e.y = __builtin_amdgcn_exp2f(a.y);
    const f32x2 d = e + 1.0f;
    f32x2 r; r.x = __builtin_amdgcn_rcpf(d.x); r.y = __builtin_amdgcn_rcpf(d.y);
    return t * r;
}
struct EpiSwiGLU {
    static constexpr bool PERM = true, AFTER_DRAIN = false;
    bf16_t* O; int ldc; const float* rs;
    __device__ __forceinline__ void operator()(const f32x4 (&acc)[2][2][4][2], const Unit& u, int wr, int wc, int fr, int fq) const {
        float rsv[8];
        { const GAS float* p = (const GAS float*)rs + (u.pm * BM + wr * 64 + fr);
#pragma unroll
          for (int i = 0; i < 8; ++i) rsv[i] = p[(i >> 2) * HALF + (i & 3) * 16]; }
        const int row0 = u.pm * BM + wr * 64 + fr; const int col0 = u.pn * HALF + wc * 32 + 8 * fq;
#pragma unroll
        for (int ai = 0; ai < 2; ++ai)
#pragma unroll
            for (int m = 0; m < 4; ++m) { bf16_t* rowp = O + (size_t)(row0 + ai * HALF + m * 16) * ldc + col0;
                const float r = rsv[ai * 4 + m];
                const f32x4 g0 = acc[ai][0][m][0] * r, g1 = acc[ai][0][m][1] * r, u0 = acc[ai][1][m][0] * r, u1 = acc[ai][1][m][1] * r;
                const f32x2 a = silu_mul2((f32x2){g0[0], g0[1]}, (f32x2){u0[0], u0[1]}), b = silu_mul2((f32x2){g0[2], g0[3]}, (f32x2){u0[2], u0[3]});
                const f32x2 c = silu_mul2((f32x2){g1[0], g1[1]}, (f32x2){u1[0], u1[1]}), d = silu_mul2((f32x2){g1[2], g1[3]}, (f32x2){u1[2], u1[3]});
                u32x4 w; w.x = cvt_pk_bf16(a.x, a.y); w.y = cvt_pk_bf16(b.x, b.y); w.z = cvt_pk_bf16(c.x, c.y); w.w = cvt_pk_bf16(d.x, d.y);
                *(u32x4*)rowp = w; }
    }
};

template <class Epi, class Sched, bool ALIGN_EPI = false, bool SP2 = false>
__device__ __forceinline__ void gemm_phase(LAS unsigned char* lds, const Gemm g, const Sched& S, const Epi& E) {
    int tid = threadIdx.x; asm volatile("" : "+v"(tid));
    const int wid = __builtin_amdgcn_readfirstlane(tid >> 6), lane = tid & 63, wr = wid >> 2, wc = wid & 3, fr = lane & 15, fq = lane >> 4;
    const int K = g.K, nt = K / BK;
    unsigned voffA[2], voffB[2];
#pragma unroll
    for (int i = 0; i < 2; ++i) { int R, C; stage_rc(tid * 16 + i * 8192, R, C); const int Rb = Epi::PERM ? ((R & ~31) + perm32(R & 31)) : R;
        voffA[i] = (unsigned)(R * g.lda + C) * 2u; voffB[i] = (unsigned)(Rb * g.ldb + C) * 2u; }
    const size_t kstep = (size_t)(BK * 2);
    const size_t hstepA = (size_t)HALF * g.lda * 2, hstepB = (size_t)HALF * g.ldb * 2;
    const unsigned ldsw = (unsigned)wid * 1024u;
    const int aoff = lds_byte(wr * 64 + fr, fq * 8), boff = lds_byte(wc * 32 + fr, fq * 8);
#define PG8_SA(b, h) (((b) * 2 + (h)) * HTB)
#define PG8_SB(b, h) ((4 + (b) * 2 + (h)) * HTB)
#define PG8_STAGE(bufoff, gbase, voff) do { _Pragma("unroll") for (int _i = 0; _i < 2; ++_i) \
        __builtin_amdgcn_global_load_lds((const unsigned*)((const char*)(gbase) + (voff)[_i]), (LAS unsigned*)(lds + (bufoff) + ldsw + _i * 8192), 16, 0, 0); } while (0)
#define PG8_LDA(dst, b, h) do { _Pragma("unroll") for (int m = 0; m < 4; ++m) _Pragma("unroll") for (int k = 0; k < 2; ++k) dst[m][k] = *(const LAS bf16x8*)(lds + PG8_SA(b, h) + aoff + m * 2048 + k * 1024); } while (0)
#define PG8_LDB(dst, b, h) do { _Pragma("unroll") for (int n = 0; n < 2; ++n) _Pragma("unroll") for (int k = 0; k < 2; ++k) dst[n][k] = *(const LAS bf16x8*)(lds + PG8_SB(b, h) + boff + n * 2048 + k * 1024); } while (0)
#define PG8_MMA(ai, bj, At, Bt) do { __builtin_amdgcn_s_setprio(1); _Pragma("unroll") for (int m = 0; m < 4; ++m) _Pragma("unroll") for (int n = 0; n < 2; ++n) _Pragma("unroll") for (int k = 0; k < 2; ++k) \
        acc[ai][bj][m][n] = __builtin_amdgcn_mfma_f32_16x16x32_bf16(Bt[n][k], At[m][k], acc[ai][bj][m][n], 0, 0, 0); __builtin_amdgcn_s_setprio(0); } while (0)
#define PG8_WAIT_V(n) asm volatile("s_waitcnt vmcnt(" #n ")" ::: "memory")
#define PG8_WAIT_L(n) asm volatile("s_waitcnt lgkmcnt(" #n ")" ::: "memory")
#define PG8_BAR __builtin_amdgcn_s_barrier()
#define PG8_SCHED __builtin_amdgcn_sched_barrier(0)
    Unit cur, nxt; int ui = 0;
    if (!S.next(0, cur)) return;
    f32x4 acc[2][2][4][2];
#pragma unroll
    for (int a = 0; a < 2; ++a)
#pragma unroll
        for (int b = 0; b < 2; ++b)
#pragma unroll
            for (int m = 0; m < 4; ++m)
#pragma unroll
                for (int n = 0; n < 2; ++n) acc[a][b][m][n] = (f32x4){0.f, 0.f, 0.f, 0.f};
    bf16x8 At[4][2], B0[2][2], B1[2][2];
    const char* cA = (const char*)g.A + (size_t)cur.pm * g.a_pm + (size_t)cur.pn * g.a_pn; const char* cB = (const char*)g.Bt + (size_t)cur.pn * g.b_pn + (size_t)cur.pm * g.b_pm;
    S.a_ready(cur);
    if constexpr (SP2) {
        PG8_STAGE(PG8_SB(0, 0), cB, voffB); PG8_STAGE(PG8_SB(0, 1), cB + hstepB, voffB); PG8_STAGE(PG8_SA(0, 0), cA, voffA); PG8_STAGE(PG8_SA(0, 1), cA + hstepA, voffA);
        if (wr == 1) PG8_BAR;
        PG8_WAIT_V(2); PG8_BAR;
        PG8_STAGE(PG8_SB(1, 0), cB + kstep, voffB); PG8_STAGE(PG8_SA(1, 0), cA + kstep, voffA); PG8_STAGE(PG8_SB(1, 1), cB + hstepB + kstep, voffB);
        PG8_WAIT_V(6); PG8_BAR;
    } else {
        PG8_STAGE(PG8_SB(0, 0), cB, voffB); PG8_STAGE(PG8_SA(0, 0), cA, voffA); PG8_STAGE(PG8_SB(0, 1), cB + hstepB, voffB); PG8_STAGE(PG8_SA(0, 1), cA + hstepA, voffA);
        if (wr == 1) PG8_BAR;
        PG8_WAIT_V(4); PG8_BAR;
        PG8_STAGE(PG8_SB(1, 0), cB + kstep, voffB); PG8_STAGE(PG8_SA(1, 0), cA + kstep, voffA); PG8_STAGE(PG8_SB(1, 1), cB + hstepB + kstep, voffB);
        PG8_WAIT_V(6); PG8_BAR;
    }
    for (;;) {
        const bool has_next = S.next(ui + 1, nxt);
        const char* nA = has_next ? (const char*)g.A + (size_t)nxt.pm * g.a_pm + (size_t)nxt.pn * g.a_pn : cA; const char* nB = has_next ? (const char*)g.Bt + (size_t)nxt.pn * g.b_pn + (size_t)nxt.pm * g.b_pm : cB;
        for (int t = 0; t < nt; t += 2) {
            const bool last = (t == nt - 2);
            const char* a1 = cA + (size_t)(t + 1) * kstep;
            const char* a2 = last ? nA : cA + (size_t)(t + 2) * kstep; const char* b2 = last ? nB : cB + (size_t)(t + 2) * kstep;
            const char* a3 = a2 + kstep; const char* b3 = b2 + kstep;
            if (last && has_next) S.a_ready(nxt);
            if constexpr (SP2) {
            PG8_LDB(B0, 0, 0); PG8_LDB(B1, 0, 1); PG8_SCHED; PG8_LDA(At, 0, 0); PG8_STAGE(PG8_SA(1, 1), a1 + hstepA, voffA);
            PG8_WAIT_V(8); PG8_WAIT_L(0); PG8_BAR; PG8_MMA(0, 0, At, B0); PG8_MMA(0, 1, At, B1); PG8_BAR; PG8_SCHED;
            PG8_LDA(At, 0, 1); PG8_STAGE(PG8_SB(0, 0), b2, voffB); PG8_STAGE(PG8_SB(0, 1), b2 + hstepB, voffB); PG8_STAGE(PG8_SA(0, 0), a2, voffA);
            PG8_WAIT_V(8); PG8_WAIT_L(0); PG8_BAR; PG8_MMA(1, 0, At, B0); PG8_MMA(1, 1, At, B1); PG8_BAR; PG8_SCHED;
            PG8_LDB(B0, 1, 0); PG8_LDB(B1, 1, 1); PG8_SCHED; PG8_LDA(At, 1, 0); PG8_STAGE(PG8_SA(0, 1), a2 + hstepA, voffA);
            PG8_WAIT_V(8); PG8_WAIT_L(0); PG8_BAR; PG8_MMA(0, 0, At, B0); PG8_MMA(0, 1, At, B1); PG8_BAR; PG8_SCHED;
            PG8_LDA(At, 1, 1); PG8_STAGE(PG8_SB(1, 0), b3, voffB); PG8_STAGE(PG8_SB(1, 1), b3 + hstepB, voffB); PG8_STAGE(PG8_SA(1, 0), a3, voffA);
            PG8_WAIT_V(8); PG8_WAIT_L(0); PG8_BAR; PG8_MMA(1, 0, At, B0); PG8_MMA(1, 1, At, B1); PG8_BAR; PG8_SCHED;
            } else {
            PG8_LDB(B0, 0, 0); PG8_SCHED; PG8_LDA(At, 0, 0); PG8_STAGE(PG8_SA(1, 1), a1 + hstepA, voffA);
            PG8_WAIT_L(8); PG8_BAR; PG8_WAIT_L(0); PG8_MMA(0, 0, At, B0); PG8_BAR; PG8_SCHED;
            PG8_LDB(B1, 0, 1); PG8_STAGE(PG8_SB(0, 0), b2, voffB);
            PG8_BAR; PG8_WAIT_L(0); PG8_MMA(0, 1, At, B1); PG8_BAR;
            PG8_LDA(At, 0, 1); PG8_STAGE(PG8_SA(0, 0), a2, voffA);
            PG8_BAR; PG8_WAIT_L(0); PG8_MMA(1, 0, At, B0); PG8_BAR; PG8_SCHED;
            PG8_STAGE(PG8_SB(0, 1), b2 + hstepB, voffB);
            PG8_WAIT_V(6); PG8_BAR; PG8_MMA(1, 1, At, B1); PG8_BAR;
            PG8_LDB(B0, 1, 0); PG8_SCHED; PG8_LDA(At, 1, 0); PG8_STAGE(PG8_SA(0, 1), a2 + hstepA, voffA);
            PG8_WAIT_L(8); PG8_BAR; PG8_WAIT_L(0); PG8_MMA(0, 0, At, B0); PG8_BAR; PG8_SCHED;
            PG8_LDB(B1, 1, 1); PG8_STAGE(PG8_SB(1, 0), b3, voffB);
            PG8_BAR; PG8_WAIT_L(0); PG8_MMA(0, 1, At, B1); PG8_BAR;
            PG8_LDA(At, 1, 1); PG8_STAGE(PG8_SA(1, 0), a3, voffA);
            PG8_BAR; PG8_WAIT_L(0); PG8_MMA(1, 0, At, B0); PG8_BAR; PG8_SCHED;
            PG8_STAGE(PG8_SB(1, 1), b3 + hstepB, voffB);
            PG8_WAIT_V(6); PG8_BAR; PG8_MMA(1, 1, At, B1); PG8_BAR;
            }
        }
        if constexpr (ALIGN_EPI) { if (wr == 0) PG8_BAR; }
        if constexpr (!Epi::AFTER_DRAIN) { E(acc, cur, wr, wc, fr, fq); S.done(cur); }
        if (!has_next) break;
#pragma unroll
        for (int a = 0; a < 2; ++a)
#pragma unroll
            for (int b = 0; b < 2; ++b)
#pragma unroll
                for (int m = 0; m < 4; ++m)
#pragma unroll
                    for (int n = 0; n < 2; ++n) acc[a][b][m][n] = (f32x4){0.f, 0.f, 0.f, 0.f};
        cur = nxt; cA = nA; cB = nB; ++ui;
        if constexpr (ALIGN_EPI) { if (wr == 1) PG8_BAR; }
    }
    PG8_WAIT_V(0);
    if constexpr (!ALIGN_EPI) { if (wr == 0) PG8_BAR; }
    PG8_BAR;
#undef PG8_SA
#undef PG8_SB
#undef PG8_STAGE
#undef PG8_LDA
#undef PG8_LDB
#undef PG8_MMA
#undef PG8_WAIT_V
#undef PG8_WAIT_L
#undef PG8_BAR
#undef PG8_SCHED
}
}

typedef unsigned short bf16;
typedef unsigned v4u __attribute__((ext_vector_type(4)));
typedef unsigned v2u __attribute__((ext_vector_type(2)));
typedef float f32x4 __attribute__((ext_vector_type(4)));
typedef float f32x2 __attribute__((ext_vector_type(2)));
typedef float f32x16 __attribute__((ext_vector_type(16)));
typedef short bf16x8 __attribute__((ext_vector_type(8)));
typedef short s16x4 __attribute__((ext_vector_type(4)));

constexpr int NWAVES = 8;
constexpr int CONV_PER_IDLE_WAVE = 6;
constexpr int D = 2048, MP = 8192, MS = 256, M = MP + MS, DFF = 5504, NFF = 2 * DFF, NMIX = 4096, NQKV = 2560, DCV = 1024;
constexpr int DFFP = 5632;
constexpr int KSL_FFN = 512, KSL_MIX = 256;
constexpr int NSL_FFN = DFFP / KSL_FFN, NSL_MIX = D / KSL_MIX;
constexpr int SEQ = 2048, NB = 4, DB = 32, DS = 8, NHEAD = 32, NKVH = 4, HD = 64, KVB = 128, PCTX = 15;
constexpr float EPS = 1e-6f;
constexpr float LOG2E = 1.4426950408889634f;

constexpr size_t O_Y = 0, O_CONVP = (size_t)M * D, O_POOLP = O_CONVP + 2 * NB * 2 * DCV, O_KP = O_POOLP + 2 * NB * PCTX * DCV, O_VP = O_KP + 2 * NB * KVB * 256,
                 O_CONVS = O_VP + 2 * NB * KVB * 256, O_POOLS = O_CONVS + 2 * DB * 2 * DCV, O_KS = O_POOLS + 2 * DB * PCTX * DCV, O_VS = O_KS + 2 * DB * KVB * 256, O_END = O_VS + 2 * DB * KVB * 256;
static_assert(O_END == 23273472, "output size");

constexpr size_t MiB = 1u << 20;
constexpr size_t WS_CTL = 0, CTL_ZERO_BYTES = 1 * MiB;
constexpr size_t WS_RS = 1 * MiB;
constexpr size_t WS_HB = 2 * MiB;
constexpr size_t WS_ACT = 36 * MiB;
constexpr size_t WS_Y = 128 * MiB;
constexpr size_t WS_Z = 194 * MiB;
constexpr size_t WS_CAT = 260 * MiB;
constexpr size_t WS_DP = 294 * MiB;
constexpr size_t WS_YP = 312 * MiB;
constexpr size_t WS_W = 360 * MiB;
constexpr size_t SZ_FFNIN = (size_t)NFF * D, SZ_FFNOUT = (size_t)D * DFFP, SZ_MIXIN = (size_t)NMIX * D, SZ_MIXOUT = (size_t)D * D, SZ_QKV = (size_t)NQKV * D, SZ_WO = (size_t)D * D, SZ_POOLW = 4 * 256 * 256;
constexpr size_t WO_FFNIN = 0, WO_FFNOUT = WO_FFNIN + 8 * SZ_FFNIN, WO_MIXIN = WO_FFNOUT + 8 * SZ_FFNOUT, WO_MIXOUT = WO_MIXIN + 2 * SZ_MIXIN, WO_QKV = WO_MIXOUT + 2 * SZ_MIXOUT,
                 WO_WO = WO_QKV + 2 * SZ_QKV, WO_POOLW = WO_WO + 2 * SZ_WO, WO_END = WO_POOLW + 2 * SZ_POOLW;
constexpr size_t WS_END = WS_W + WO_END * 2;
static_assert(WS_HB + (size_t)M * D * 2 <= WS_ACT && WS_ACT + (size_t)M * DFFP * 2 <= WS_Y && WS_Y + (size_t)M * D * 4 <= WS_Z && WS_Z + (size_t)M * NMIX * 2 <= WS_CAT && WS_CAT + (size_t)M * D * 2 <= WS_DP && WS_DP + (size_t)M * DCV * 2 <= WS_YP && WS_YP + (size_t)NSL_FFN * 256 * D * 4 <= WS_W, "ws map");
constexpr int CW_BAR = 4096;

constexpr int RING_BYTES = 135168;
constexpr int LDSCTL_OFF = RING_BYTES, MISC_OFF = LDSCTL_OFF + 320;
constexpr int LDS_BYTES = 147456;
static_assert(MISC_OFF + 128 <= LDS_BYTES, "LDS map");

#define LDS_WAIT() asm volatile("s_waitcnt lgkmcnt(0)" ::: "memory")
#define VM_WAIT() asm volatile("s_waitcnt vmcnt(0)" ::: "memory")
__device__ __forceinline__ unsigned f2bf(float f) { unsigned u = __builtin_bit_cast(unsigned, f); return (u + 0x7fffu + ((u >> 16) & 1u)) >> 16; }
__device__ __forceinline__ unsigned pk2(float lo, float hi) { return f2bf(lo) | (f2bf(hi) << 16); }
__device__ __forceinline__ float bf_lo(unsigned w) { return __builtin_bit_cast(float, w << 16); }
__device__ __forceinline__ float bf_hi(unsigned w) { return __builtin_bit_cast(float, w & 0xffff0000u); }

#define XB_TMO      128
#define XB_XCNT(j)  (256  + 64 * (j))
#define XB_XSUB(j)  (1280 + 64 * (j))
#define XB_XGEN(j)  (2304 + 64 * (j))
#define XB_TOP      3328
#define XB_TOPGEN   3392
#define XCD_BAR_WORDS 3456
#define XB_SPIN_CAP (1u << 18)
__device__ __forceinline__ unsigned xb_ld(unsigned* p)              { return __hip_atomic_load(p, __ATOMIC_RELAXED, __HIP_MEMORY_SCOPE_AGENT); }
__device__ __forceinline__ unsigned xb_add(unsigned* p, unsigned v) { return __hip_atomic_fetch_add(p, v, __ATOMIC_RELAXED, __HIP_MEMORY_SCOPE_AGENT); }
__device__ __forceinline__ unsigned xb_xcc_id() { return (unsigned)__builtin_amdgcn_s_getreg((3 << 11) | 20) & 0xFu; }
#define XB_SPIN(cond, bar) do { unsigned _sp = 0; while (cond) { __builtin_amdgcn_s_sleep(1); \
    if ((++_sp & 255u) == 0u) { if (xb_ld(&(bar)[XB_TMO])) break; if (_sp > XB_SPIN_CAP) { atomicAdd(&(bar)[XB_TMO], 1u); break; } } } } while (0)
struct XcdBarrier { unsigned* bar; unsigned x; volatile LAS unsigned* st; };
__device__ __forceinline__ XcdBarrier xcd_barrier_post(unsigned* bar, volatile LAS unsigned* st) {
    XcdBarrier b; b.bar = bar; b.x = xb_xcc_id(); b.st = st;
    if (threadIdx.x == 0) (void)xb_add(&bar[XB_XCNT(b.x)], 1u);
    return b;
}
__device__ __forceinline__ void xcd_barrier_complete(unsigned* bar, unsigned x, unsigned& nloc, unsigned& nx) {
    const unsigned G = gridDim.x * gridDim.y * gridDim.z;
    unsigned sum, cnt, mine, sp = 0u;
    for (;;) {
        sum = 0u; cnt = 0u; mine = 0u;
#pragma unroll
        for (unsigned j = 0; j < 16; ++j) { const unsigned c = xb_ld(&bar[XB_XCNT(j)]); sum += c; cnt += (c > 0u) ? 1u : 0u; mine = (j == x) ? c : mine; }
        if (sum == G) break;
        __builtin_amdgcn_s_sleep(1);
        if ((++sp & 255u) == 0u) { if (xb_ld(&bar[XB_TMO])) break; if (sp > XB_SPIN_CAP) { atomicAdd(&bar[XB_TMO], 1u); break; } }
    }
    nloc = mine > 0u ? mine : 1u; nx = cnt > 0u ? cnt : 1u;
}
__device__ __forceinline__ void xcd_barrier(const XcdBarrier& b) {
    asm volatile("s_waitcnt vmcnt(0)" ::: "memory");
    __syncthreads();
    if (threadIdx.x == 0) {
        unsigned* bar = b.bar; asm volatile("" : "+s"(bar));
        __builtin_amdgcn_s_waitcnt(0);
        unsigned nloc = b.st[0], nx = b.st[1];
        const unsigned bx = xb_xcc_id();
        if (nloc == 0u) { xcd_barrier_complete(bar, bx, nloc, nx); b.st[0] = nloc; b.st[1] = nx; }
        const unsigned old = xb_add(&bar[XB_XSUB(bx)], 1u);
        const unsigned gen = old / nloc;
        if (old + 1u == (gen + 1u) * nloc) {
            __builtin_amdgcn_fence(__ATOMIC_RELEASE, "agent");
            asm volatile("s_waitcnt vmcnt(0)" ::: "memory");
            const unsigned og = xb_add(&bar[XB_TOP], 1u);
            const unsigned tg = og / nx;
            if (og + 1u == (tg + 1u) * nx) xb_add(&bar[XB_TOPGEN], 1u);
            else XB_SPIN(xb_ld(&bar[XB_TOPGEN]) == tg, bar);
            __builtin_amdgcn_fence(__ATOMIC_ACQUIRE, "agent");
            xb_add(&bar[XB_XGEN(bx)], 1u);
            asm volatile("s_waitcnt vmcnt(0)" ::: "memory");
        } else {
            XB_SPIN(xb_ld(&bar[XB_XGEN(bx)]) == gen, bar);
            __builtin_amdgcn_fence(__ATOMIC_ACQUIRE, "agent");
            asm volatile("s_waitcnt vmcnt(0)" ::: "memory");
        }
    }
    __syncthreads();
}

__device__ __forceinline__ float wave_sum(float v) {
#pragma unroll
    for (int o = 1; o < 64; o <<= 1) v += __shfl_xor(v, o);
    return v;
}

__device__ __forceinline__ void tr_item(const float* __restrict__ src, int sld, bf16* __restrict__ dst, int K  , int k0, LAS float* scr, int lane, const float* gain = nullptr  ) {
    const GAS float* s = (const GAS float*)src + (size_t)(k0 + (lane >> 4)) * sld + (lane & 15) * 4;
    f32x4 v[16];
#pragma unroll
    for (int it = 0; it < 16; ++it) v[it] = *(const GAS f32x4*)(s + (size_t)(4 * it) * sld);
    if (gain) {
#pragma unroll
        for (int it = 0; it < 16; ++it) v[it] = v[it] * gain[k0 + (lane >> 4) + 4 * it]; }
#pragma unroll
    for (int it = 0; it < 16; ++it) { LAS float* w = scr + ((lane >> 4) + 4 * it) * 65 + (lane & 15) * 4; w[0] = v[it].x; w[1] = v[it].y; w[2] = v[it].z; w[3] = v[it].w; }
    LDS_WAIT(); asm volatile("" ::: "memory");
    const int c = lane >> 3, n1 = lane & 7;
#pragma unroll
    for (int jj = 0; jj < 8; ++jj) { const int n = n1 + 8 * jj; const LAS float* r = scr + (8 * c) * 65 + n;
        v4u o; o.x = pk2(r[0], r[65]); o.y = pk2(r[2 * 65], r[3 * 65]); o.z = pk2(r[4 * 65], r[5 * 65]); o.w = pk2(r[6 * 65], r[7 * 65]);
        *(GAS v4u*)(dst + (size_t)n * K + k0 + 8 * c) = o; }
    LDS_WAIT(); asm volatile("" ::: "memory");
}

struct Args { const float* in[18]; float* out; unsigned char* ws; };
typedef const __attribute__((address_space(4))) Args CArgs;
__device__ __forceinline__ CArgs* fresh_args() { CArgs* p = (CArgs*)__builtin_amdgcn_kernarg_segment_ptr(); asm volatile("" : "+s"(p)); return p; }

constexpr int CI_FFNIN = (D / 64) * (NFF / 64), CI_FFNOUT = (DFF / 64) * (D / 64), CI_MIXIN = (D / 64) * (NMIX / 64), CI_QKV = (D / 64) * (NQKV / 64), CI_SQ = (D / 64) * (D / 64), CI_POOLW = 4 * 16;
constexpr int CI_EVEN = 2 * (CI_FFNIN + CI_FFNOUT) + CI_MIXIN + CI_POOLW + CI_SQ, CI_ODD = 2 * (CI_FFNIN + CI_FFNOUT) + CI_QKV + CI_SQ, CI_PAIR = CI_EVEN + CI_ODD, IT_TOTAL = 2 * CI_PAIR;
__device__ __forceinline__ int conv_seg_start(int l, int seg) {
    const int odd = l & 1; int o = (l >> 1) * CI_PAIR + (odd ? CI_EVEN : 0);
    const int sz[7] = {CI_FFNIN, CI_FFNOUT, odd ? CI_QKV : CI_MIXIN, odd ? 0 : CI_POOLW, CI_SQ, CI_FFNIN, CI_FFNOUT};
#pragma unroll
    for (int i = 0; i < 7; ++i) o += (i < seg) ? sz[i] : 0;
    return o;
}
__device__ __forceinline__ void conv_item(CArgs* ap, int it, LAS float* scr, int lane) {
    bf16* W = (bf16*)(ap->ws + WS_W);
    int l = 2 * (it / CI_PAIR), r = it % CI_PAIR; if (r >= CI_EVEN) { r -= CI_EVEN; l += 1; }
    const int odd = l & 1, j = l >> 1;
    int hl = 2 * l, kind;
    if (r < CI_FFNIN) kind = 0;
    else if ((r -= CI_FFNIN) < CI_FFNOUT) kind = 1;
    else if ((r -= CI_FFNOUT) < (odd ? CI_QKV : CI_MIXIN)) kind = odd ? 3 : 2;
    else if ((r -= (odd ? CI_QKV : CI_MIXIN)) < (odd ? 0 : CI_POOLW)) kind = 4;
    else if ((r -= (odd ? 0 : CI_POOLW)) < CI_SQ) kind = odd ? 6 : 5;
    else if ((r -= CI_SQ) < CI_FFNIN) { kind = 0; hl += 1; }
    else { r -= CI_FFNIN; kind = 1; hl += 1; }
    if (kind == 0) { constexpr int nbn = NFF / 64; const int kb = r / nbn, nb = r % nbn;
        const int n0 = nb * 64, tile = n0 >> 8, w = n0 & 255, scol = (w < 128) ? tile * 128 + w : DFF + tile * 128 + (w - 128);
        tr_item(ap->in[7] + (size_t)hl * D * NFF + scol, NFF, W + WO_FFNIN + (size_t)hl * SZ_FFNIN + (size_t)n0 * D, D, kb * 64, scr, lane, ap->in[6] + (size_t)((hl >> 1) * 6 + ((hl & 1) ? 4 : 0)) * D); }
    else if (kind == 1) { constexpr int nbn = D / 64; const int kb = r / nbn, nb = r % nbn;
        tr_item(ap->in[8] + (size_t)hl * DFF * D + nb * 64, D, W + WO_FFNOUT + (size_t)hl * SZ_FFNOUT + (size_t)(nb * 64) * DFFP, DFFP, kb * 64, scr, lane); }
    else if (kind == 2) { constexpr int nbn = NMIX / 64; const int kb = r / nbn, nb = r % nbn;
        tr_item(ap->in[9] + (size_t)j * D * NMIX + nb * 64, NMIX, W + WO_MIXIN + (size_t)j * SZ_MIXIN + (size_t)(nb * 64) * D, D, kb * 64, scr, lane, ap->in[6] + (size_t)(l * 6 + 2) * D); }
    else if (kind == 3) { constexpr int nbn = NQKV / 64; const int kb = r / nbn, nb = r % nbn;
        tr_item(ap->in[14] + (size_t)j * D * NQKV + nb * 64, NQKV, W + WO_QKV + (size_t)j * SZ_QKV + (size_t)(nb * 64) * D, D, kb * 64, scr, lane, ap->in[6] + (size_t)(l * 6 + 2) * D); }
    else if (kind == 4) { const int mat = j * 4 + (r >> 4), rr = r & 15, kb = rr >> 2, nb = rr & 3;
        tr_item(ap->in[11] + (size_t)mat * 65536 + nb * 64, 256, W + WO_POOLW + (size_t)mat * 65536 + (size_t)(nb * 64) * 256, 256, kb * 64, scr, lane); }
    else { constexpr int nbn = D / 64; const int kb = r / nbn, nb = r % nbn;
        if (kind == 5) tr_item(ap->in[13] + (size_t)j * D * D + nb * 64, D, W + WO_MIXOUT + (size_t)j * SZ_MIXOUT + (size_t)(nb * 64) * D, D, kb * 64, scr, lane);
        else tr_item(ap->in[15] + (size_t)j * D * D + nb * 64, D, W + WO_WO + (size_t)j * SZ_WO + (size_t)(nb * 64) * D, D, kb * 64, scr, lane); }
}
__device__ __forceinline__ void conv_range(CArgs* ap, LAS unsigned char* lds, int lo, int hi, int w, int nworkers, int wave, int lane) {
    LAS float* scr = (LAS float*)(lds + wave * 16640);
    for (int it = lo + w; it < hi; it += nworkers) conv_item(ap, it, scr, lane);
}

__device__ __forceinline__ void prologue(CArgs* ap, LAS unsigned char* lds, int gw, int NGW, int wave, int lane) {
    struct { const float* in[18]; float* out; unsigned char* ws; } a;
    a.in[0] = ap->in[0]; a.in[1] = ap->in[1]; a.in[6] = ap->in[6]; a.out = ap->out; a.ws = ap->ws;
    bf16* W = (bf16*)(a.ws + WS_W);
    for (int r = gw * 4 + (lane >> 4); r < 8 * D + M; r += NGW * 4) {
        bf16* p = r < 8 * D ? W + WO_FFNOUT + (size_t)r * DFFP + DFF : (bf16*)(a.ws + WS_ACT) + (size_t)(r - 8 * D) * DFFP + DFF;
        *(GAS v4u*)(p + (lane & 15) * 8) = (v4u){0u, 0u, 0u, 0u}; }
    for (int row = gw; row < M; row += NGW) {
        const float* xr = row < MP ? a.in[0] + (size_t)row * D : a.in[1] + (size_t)(row - MP) * D;
        const GAS f32x4* x4 = (const GAS f32x4*)xr + lane;
        f32x4 v[8]; float ss = 0.f;
#pragma unroll
        for (int j = 0; j < 8; ++j) { v[j] = x4[64 * j]; ss += (v[j].x * v[j].x + v[j].y * v[j].y) + (v[j].z * v[j].z + v[j].w * v[j].w); }
        const float rs = 1.0f / sqrtf(wave_sum(ss) * (1.f / D) + EPS);
        if (lane == 0) ((float*)(a.ws + WS_RS))[row] = rs;
        GAS v2u* ho = (GAS v2u*)((bf16*)(a.ws + WS_HB) + (size_t)row * D) + lane;
#pragma unroll
        for (int j = 0; j < 8; ++j) { v2u o; o.x = pk2(v[j].x, v[j].y); o.y = pk2(v[j].z, v[j].w); ho[64 * j] = o; }
    }
}

__device__ __forceinline__ void norm_row(f32x4 (&y)[8], bf16* XB, float* RS, float* yout, float sc, const GAS f32x4* ga4, int row, int lane) {
    GAS v2u* x2 = (GAS v2u*)(XB + (size_t)row * D) + lane;
    f32x4 x[8]; float ss = 0.f;
#pragma unroll
    for (int j = 0; j < 8; ++j) { const v2u w = x2[64 * j]; x[j] = (f32x4){bf_lo(w.x), bf_hi(w.x), bf_lo(w.y), bf_hi(w.y)}; }
#pragma unroll
    for (int j = 0; j < 8; ++j) ss += (y[j].x * y[j].x + y[j].y * y[j].y) + (y[j].z * y[j].z + y[j].w * y[j].w);
    const float r1 = sc / sqrtf(wave_sum(ss) * (1.f / D) + EPS);
    float s2 = 0.f;
#pragma unroll
    for (int j = 0; j < 8; ++j) { const f32x4 g = ga4[lane + 64 * j]; x[j] = x[j] + y[j] * g * r1;
        s2 += (x[j].x * x[j].x + x[j].y * x[j].y) + (x[j].z * x[j].z + x[j].w * x[j].w); }
    if (yout) {
        GAS f32x4* o4 = (GAS f32x4*)(yout + (size_t)row * D) + lane;
#pragma unroll
        for (int j = 0; j < 8; ++j) o4[64 * j] = x[j];
    } else {
#pragma unroll
        for (int j = 0; j < 8; ++j) { v2u o; o.x = pk2(x[j].x, x[j].y); o.y = pk2(x[j].z, x[j].w); x2[64 * j] = o; }
        const float r2 = 1.0f / sqrtf(wave_sum(s2) * (1.f / D) + EPS);
        if (lane == 0) RS[row] = r2;
    }
}
template <int NSL>
__device__ __forceinline__ void norm_phase(const bf16* Y, const float* YP, bf16* XB, float* RS, float* yout, float sc, const float* ga, int gw, int NGW, int lane) {
    const GAS f32x4* ga4 = (const GAS f32x4*)ga;
    if ((gw & 7) == 0) {
        for (int r = gw >> 3; r < MS; r += (NGW >> 3)) {
            const GAS f32x4* p4 = (const GAS f32x4*)(YP + (size_t)r * D) + lane;
            f32x4 y[8];
#pragma unroll
            for (int j = 0; j < 8; ++j) { f32x4 pv[NSL];
#pragma unroll
                for (int i = 0; i < NSL; ++i) pv[i] = p4[(size_t)i * (256 * D / 4) + 64 * j];
                f32x4 a = pv[0];
#pragma unroll
                for (int i = 1; i < NSL; ++i) a = a + pv[i];
                y[j] = a; }
            norm_row(y, XB, RS, yout, sc, ga4, MP + r, lane);
        }
    }
    for (int row = gw; row < MP; row += NGW) {
        const GAS v2u* y2 = (const GAS v2u*)(Y + (size_t)row * D) + lane;
        f32x4 y[8];
#pragma unroll
        for (int j = 0; j < 8; ++j) { const v2u w = y2[64 * j]; y[j] = (f32x4){bf_lo(w.x), bf_hi(w.x), bf_lo(w.y), bf_hi(w.y)}; }
        norm_row(y, XB, RS, yout, sc, ga4, row, lane);
    }
}

__device__ __forceinline__ unsigned ldz(const bf16* Zb, unsigned off) { return *(const GAS unsigned*)((const GAS char*)Zb + off); }
__device__ __forceinline__ void convpool_phase(CArgs* ap, int j, int bid, int G, int tid) {
    const bf16* Z = (const bf16*)(ap->ws + WS_Z); bf16* CAT = (bf16*)(ap->ws + WS_CAT); bf16* DP = (bf16*)(ap->ws + WS_DP);
    const int c = 2 * tid, gi = tid >> 7, w = 2 << gi;
    const float* cw = ap->in[10] + (size_t)j * 3 * DCV + c;
    const f32x2 w0 = *(const f32x2*)cw, w1 = *(const f32x2*)(cw + DCV), w2 = *(const f32x2*)(cw + 2 * DCV);
    float* out = ap->out;
    for (int u = bid; u < 256 + DB; u += G) {
        if (u < 256) {
            const int b = u >> 6, t0 = (u & 63) * 32; const int rb = b * SEQ;
            const bf16* Zb = Z + (size_t)rb * NMIX; bf16* Cb = CAT + (size_t)rb * D; bf16* Db = DP + (size_t)rb * DCV;
            f32x2 vm2 = {0.f, 0.f}, vm1 = {0.f, 0.f}, S = {0.f, 0.f};
            if (t0 > 0) {
                { const unsigned o = (unsigned)((t0 - 2) * NMIX + c) * 2u; const unsigned h = ldz(Zb, o), g = ldz(Zb, o + 2048u); vm2 = (f32x2){bf_lo(h) * bf_lo(g), bf_hi(h) * bf_hi(g)}; }
                { const unsigned o = (unsigned)((t0 - 1) * NMIX + c) * 2u; const unsigned h = ldz(Zb, o), g = ldz(Zb, o + 2048u); vm1 = (f32x2){bf_lo(h) * bf_lo(g), bf_hi(h) * bf_hi(g)}; }
                for (int i = 1; i <= w; ++i) { const unsigned uu = ldz(Zb, (unsigned)((t0 - i) * NMIX + 3072 + c) * 2u); S.x += bf_lo(uu); S.y += bf_hi(uu); }
            }
            const bool lastc = (t0 == SEQ - 32);
#pragma unroll 2
            for (int t = t0; t < t0 + 32; ++t) {
                const unsigned o = (unsigned)(t * NMIX + c) * 2u;
                const unsigned hh = ldz(Zb, o), gg = ldz(Zb, o + 2048u), bb = ldz(Zb, o + 4096u), uu = ldz(Zb, o + 6144u);
                unsigned uo = 0u; if (t >= w) uo = ldz(Zb, (unsigned)((t - w) * NMIX + 3072 + c) * 2u);
                const f32x2 v = {bf_lo(hh) * bf_lo(gg), bf_hi(hh) * bf_hi(gg)};
                const f32x2 yc = w0 * vm2 + w1 * vm1 + w2 * v; vm2 = vm1; vm1 = v;
                const f32x2 ut = {bf_lo(uu), bf_hi(uu)};
                S.x += ut.x - bf_lo(uo); S.y += ut.y - bf_hi(uo);
                const float cnt = (float)((t + 1 < w) ? (t + 1) : w);
                const f32x2 dd = S / cnt - ut;
                *(GAS unsigned*)((GAS char*)Cb + (unsigned)(t * D + c) * 2u) = pk2(bf_lo(bb) * yc.x, bf_hi(bb) * yc.y);
                *(GAS unsigned*)((GAS char*)Db + (unsigned)(t * DCV + c) * 2u) = pk2(dd.x, dd.y);
                if (lastc) {
                    if (t >= SEQ - 2) *(GAS f32x2*)((GAS char*)(out + O_CONVP + (size_t)(j * NB + b) * 2 * DCV) + (unsigned)((t - (SEQ - 2)) * DCV + c) * 4u) = v;
                    if (t >= SEQ - PCTX) *(GAS f32x2*)((GAS char*)(out + O_POOLP + (size_t)(j * NB + b) * PCTX * DCV) + (unsigned)((t - (SEQ - PCTX)) * DCV + c) * 4u) = ut;
                }
            }
        } else {
            const int b = u - 256; const int rb = MP + b * DS;
            const bf16* Zb = Z + (size_t)rb * NMIX; bf16* Cb = CAT + (size_t)rb * D; bf16* Db = DP + (size_t)rb * DCV;
            const GAS char* cc = (const GAS char*)(ap->in[2] + (size_t)(j * DB + b) * 2 * DCV);
            const GAS char* pc = (const GAS char*)(ap->in[3] + (size_t)(j * DB + b) * PCTX * DCV);
            GAS char* pso = (GAS char*)(out + O_POOLS + (size_t)(j * DB + b) * PCTX * DCV);
            GAS char* cso = (GAS char*)(out + O_CONVS + (size_t)(j * DB + b) * 2 * DCV);
            const unsigned c4 = (unsigned)c * 4u;
            f32x2 vm2 = *(const GAS f32x2*)(cc + c4), vm1 = *(const GAS f32x2*)(cc + c4 + DCV * 4u), S = {0.f, 0.f};
            for (int i = 1; i <= w && i <= PCTX; ++i) { const f32x2 p = *(const GAS f32x2*)(pc + c4 + (unsigned)(PCTX - i) * (DCV * 4u)); S += p; }
            for (int i = 0; i < PCTX - DS; ++i) *(GAS f32x2*)(pso + c4 + (unsigned)i * (DCV * 4u)) = *(const GAS f32x2*)(pc + c4 + (unsigned)(DS + i) * (DCV * 4u));
            for (int t = 0; t < DS; ++t) {
                const unsigned o = (unsigned)(t * NMIX + c) * 2u;
                const unsigned hh = ldz(Zb, o), gg = ldz(Zb, o + 2048u), bb = ldz(Zb, o + 4096u), uu = ldz(Zb, o + 6144u);
                f32x2 uo = {0.f, 0.f};
                if (t - w >= 0) { const unsigned uw = ldz(Zb, (unsigned)((t - w) * NMIX + 3072 + c) * 2u); uo = (f32x2){bf_lo(uw), bf_hi(uw)}; }
                else if (t - w >= -PCTX) uo = *(const GAS f32x2*)(pc + c4 + (unsigned)(PCTX + t - w) * (DCV * 4u));
                const f32x2 v = {bf_lo(hh) * bf_lo(gg), bf_hi(hh) * bf_hi(gg)};
                const f32x2 yc = w0 * vm2 + w1 * vm1 + w2 * v; vm2 = vm1; vm1 = v;
                const f32x2 ut = {bf_lo(uu), bf_hi(uu)};
                S += ut - uo;
                const f32x2 dd = S / (float)w - ut;
                *(GAS unsigned*)((GAS char*)Cb + (unsigned)(t * D + c) * 2u) = pk2(bf_lo(bb) * yc.x, bf_hi(bb) * yc.y);
                *(GAS unsigned*)((GAS char*)Db + (unsigned)(t * DCV + c) * 2u) = pk2(dd.x, dd.y);
                if (t >= DS - 2) *(GAS f32x2*)(cso + c4 + (unsigned)(t - (DS - 2)) * (DCV * 4u)) = v;
                *(GAS f32x2*)(pso + c4 + (unsigned)(PCTX - DS + t) * (DCV * 4u)) = ut;
            }
        }
    }
}

constexpr int AT_KP = 144, AT_VP = 520;
constexpr int AT_K = 0, AT_V = 256 * AT_KP, AT_B = AT_V + 64 * AT_VP, AT_END = AT_B + NHEAD * 192 * 4;
static_assert(AT_END <= RING_BYTES && (AT_V % 16) == 0 && (AT_B % 16) == 0, "attention LDS map");
__device__ __forceinline__ int crow(int r, int hi) { return (r & 3) + 8 * (r >> 2) + 4 * hi; }

__device__ __forceinline__ void attention_phase(CArgs* ap, LAS unsigned char* lds, int j, int bid, int G, int tid, int wave, int lane_in) {
    const bf16* QKV = (const bf16*)(ap->ws + WS_Z); bf16* ATT = (bf16*)(ap->ws + WS_CAT);
    float* out = ap->out; const float* relb = ap->in[17]; const float* ck = ap->in[4]; const float* cv = ap->in[5]; const float* sinks = ap->in[16];
    LAS float* biasL = (LAS float*)(lds + AT_B);
    for (int e = tid; e < NHEAD * 192; e += NWAVES * 64) {
        const int h = e / 192, dist = e % 192 - 32; float v = -1e30f;
        if (dist >= 0 && dist <= 128) { int bk = dist;
            if (dist >= 16) { const float ratio = logf((float)dist / 16.0f) / 2.0794415416798357f; bk = 16 + (int)(ratio * 16.0f); if (bk > 31) bk = 31; }
            v = relb[bk * NHEAD + h] * LOG2E; }
        biasL[e] = v;
    }
    const float CS = 0.125f * LOG2E;
    for (int u = bid; u < 256 + DB * NKVH; u += G) {
        __syncthreads();
        asm volatile("" : "+v"(tid));
        const bool prompt = u < 256;
        int b, kvh, row0; bool first = false, lastb = false;
        if (prompt) { b = u >> 6; kvh = (u >> 4) & 3; const int qb = u & 15; row0 = b * SEQ + qb * 128; first = (qb == 0); lastb = (qb == 15); }
        else { const int su = u - 256; b = su >> 2; kvh = su & 3; row0 = MP + b * DS; }
        if (prompt) {
#pragma unroll
            for (int it = 0; it < 4; ++it) { const int id = it * 512 + tid, row = id >> 3, ch = id & 7;
                v4u kv = {0u, 0u, 0u, 0u}, vv = {0u, 0u, 0u, 0u};
                if (!(first && row < 128)) { const bf16* src = QKV + (size_t)(row0 - 128 + row) * NQKV + 2048 + kvh * 64 + ch * 8; kv = *(const GAS v4u*)src; vv = *(const GAS v4u*)(src + 256); }
                *(LAS v4u*)(lds + AT_K + row * AT_KP + ch * 16) = kv;
                LAS bf16* vt = (LAS bf16*)(lds + AT_V + (ch * 8) * AT_VP) + row;
                vt[0] = (bf16)(vv.x & 0xffff); vt[AT_VP / 2] = (bf16)(vv.x >> 16); vt[2 * (AT_VP / 2)] = (bf16)(vv.y & 0xffff); vt[3 * (AT_VP / 2)] = (bf16)(vv.y >> 16);
                vt[4 * (AT_VP / 2)] = (bf16)(vv.z & 0xffff); vt[5 * (AT_VP / 2)] = (bf16)(vv.z >> 16); vt[6 * (AT_VP / 2)] = (bf16)(vv.w & 0xffff); vt[7 * (AT_VP / 2)] = (bf16)(vv.w >> 16);
                if (lastb && row >= 128) { const size_t o = ((size_t)(j * NB + b) * KVB + (row - 128)) * 256 + kvh * 64 + ch * 8;
                    *(f32x4*)(out + O_KP + o) = (f32x4){bf_lo(kv.x), bf_hi(kv.x), bf_lo(kv.y), bf_hi(kv.y)}; *(f32x4*)(out + O_KP + o + 4) = (f32x4){bf_lo(kv.z), bf_hi(kv.z), bf_lo(kv.w), bf_hi(kv.w)};
                    *(f32x4*)(out + O_VP + o) = (f32x4){bf_lo(vv.x), bf_hi(vv.x), bf_lo(vv.y), bf_hi(vv.y)}; *(f32x4*)(out + O_VP + o + 4) = (f32x4){bf_lo(vv.z), bf_hi(vv.z), bf_lo(vv.w), bf_hi(vv.w)}; }
            }
        } else {
#pragma unroll
            for (int it = 0; it < 3; ++it) { const int id = it * 512 + tid, row = id >> 3, ch = id & 7;
                if (row < 160) {
                    v4u kv = {0u, 0u, 0u, 0u}, vv = {0u, 0u, 0u, 0u};
                    f32x4 k0 = {0.f, 0.f, 0.f, 0.f}, k1 = k0, v0 = k0, v1 = k0;
                    if (row < 128) { const size_t so = ((size_t)(j * DB + b) * KVB + row) * 256 + kvh * 64 + ch * 8;
                        k0 = *(const f32x4*)(ck + so); k1 = *(const f32x4*)(ck + so + 4); v0 = *(const f32x4*)(cv + so); v1 = *(const f32x4*)(cv + so + 4);
                        kv = (v4u){pk2(k0.x, k0.y), pk2(k0.z, k0.w), pk2(k1.x, k1.y), pk2(k1.z, k1.w)}; vv = (v4u){pk2(v0.x, v0.y), pk2(v0.z, v0.w), pk2(v1.x, v1.y), pk2(v1.z, v1.w)}; }
                    else if (row < 128 + DS) { const bf16* src = QKV + (size_t)(row0 + row - 128) * NQKV + 2048 + kvh * 64 + ch * 8; kv = *(const GAS v4u*)src; vv = *(const GAS v4u*)(src + 256);
                        k0 = (f32x4){bf_lo(kv.x), bf_hi(kv.x), bf_lo(kv.y), bf_hi(kv.y)}; k1 = (f32x4){bf_lo(kv.z), bf_hi(kv.z), bf_lo(kv.w), bf_hi(kv.w)};
                        v0 = (f32x4){bf_lo(vv.x), bf_hi(vv.x), bf_lo(vv.y), bf_hi(vv.y)}; v1 = (f32x4){bf_lo(vv.z), bf_hi(vv.z), bf_lo(vv.w), bf_hi(vv.w)}; }
                    *(LAS v4u*)(lds + AT_K + row * AT_KP + ch * 16) = kv;
                    LAS bf16* vt = (LAS bf16*)(lds + AT_V + (ch * 8) * AT_VP) + row;
                    vt[0] = (bf16)(vv.x & 0xffff); vt[AT_VP / 2] = (bf16)(vv.x >> 16); vt[2 * (AT_VP / 2)] = (bf16)(vv.y & 0xffff); vt[3 * (AT_VP / 2)] = (bf16)(vv.y >> 16);
                    vt[4 * (AT_VP / 2)] = (bf16)(vv.z & 0xffff); vt[5 * (AT_VP / 2)] = (bf16)(vv.z >> 16); vt[6 * (AT_VP / 2)] = (bf16)(vv.w & 0xffff); vt[7 * (AT_VP / 2)] = (bf16)(vv.w >> 16);
                    if (row >= DS && row < 128 + DS) { const size_t o = ((size_t)(j * DB + b) * KVB + (row - DS)) * 256 + kvh * 64 + ch * 8;
                        *(f32x4*)(out + O_KS + o) = k0; *(f32x4*)(out + O_KS + o + 4) = k1; *(f32x4*)(out + O_VS + o) = v0; *(f32x4*)(out + O_VS + o + 4) = v1; }
                }
            }
        }
        LDS_WAIT();
        __syncthreads();
        const int lane = tid & 63, l31 = lane & 31, hi = lane >> 5;
        const int h = kvh * 8 + wave;
        const float sink2 = sinks[j * NHEAD + h] * LOG2E;
        const LAS float* bl = biasL + h * 192 + 160 + l31 - 4 * hi;
        const int nsub = prompt ? 4 : 1;
        bf16x8 qn[4];
        { const int qrow0 = prompt ? (row0 + l31) : (row0 + (l31 & 7));
#pragma unroll
          for (int k0 = 0; k0 < 4; ++k0) qn[k0] = *(const GAS bf16x8*)(QKV + (size_t)qrow0 * NQKV + h * 64 + 16 * k0 + 8 * hi); }
        for (int sub = 0; sub < nsub; ++sub) {
            const int qrow = prompt ? (row0 + 32 * sub + l31) : (row0 + (l31 & 7));
            bf16x8 qr[4];
#pragma unroll
            for (int k0 = 0; k0 < 4; ++k0) qr[k0] = qn[k0];
            if (sub + 1 < nsub) {
#pragma unroll
                for (int k0 = 0; k0 < 4; ++k0) qn[k0] = *(const GAS bf16x8*)(QKV + (size_t)(qrow + 32) * NQKV + h * 64 + 16 * k0 + 8 * hi); }
            f32x16 acc[5];
#pragma unroll
            for (int jt = 0; jt < 5; ++jt) {
                const int T = sub + jt;
                f32x16 c = {0.f, 0.f, 0.f, 0.f, 0.f, 0.f, 0.f, 0.f, 0.f, 0.f, 0.f, 0.f, 0.f, 0.f, 0.f, 0.f};
#pragma unroll
                for (int k0 = 0; k0 < 4; ++k0) { const bf16x8 kf = *(const LAS bf16x8*)(lds + AT_K + (32 * T + l31) * AT_KP + (16 * k0 + 8 * hi) * 2);
                    c = __builtin_amdgcn_mfma_f32_32x32x16_bf16(kf, qr[k0], c, 0, 0, 0); }
                acc[jt] = c;
            }
            float mx = -1e30f;
#pragma unroll
            for (int jt = 0; jt < 5; ++jt) {
                const float tm = (first && (sub + jt) < 4) ? -1e30f : 0.f;
#pragma unroll
                for (int r = 0; r < 16; ++r) { const float s = acc[jt][r] * CS + (bl[-32 * jt - ((r & 3) + 8 * (r >> 2))] + tm); acc[jt][r] = s; mx = fmaxf(mx, s); }
            }
            mx = fmaxf(mx, __shfl_xor(mx, 32));
            mx = fmaxf(mx, sink2);
            float ls = 0.f;
#pragma unroll
            for (int jt = 0; jt < 5; ++jt)
#pragma unroll
                for (int r = 0; r < 16; ++r) { const float p = __builtin_amdgcn_exp2f(acc[jt][r] - mx); acc[jt][r] = p; ls += p; }
            ls += __shfl_xor(ls, 32);
            ls += __builtin_amdgcn_exp2f(sink2 - mx);
            f32x16 o0 = {0.f, 0.f, 0.f, 0.f, 0.f, 0.f, 0.f, 0.f, 0.f, 0.f, 0.f, 0.f, 0.f, 0.f, 0.f, 0.f}, o1 = o0;
#pragma unroll
            for (int jt = 0; jt < 5; ++jt) {
                const int T = sub + jt;
#pragma unroll
                for (int c2 = 0; c2 < 2; ++c2) {
                    v4u pw; pw.x = pk2(acc[jt][8 * c2 + 0], acc[jt][8 * c2 + 1]); pw.y = pk2(acc[jt][8 * c2 + 2], acc[jt][8 * c2 + 3]); pw.z = pk2(acc[jt][8 * c2 + 4], acc[jt][8 * c2 + 5]); pw.w = pk2(acc[jt][8 * c2 + 6], acc[jt][8 * c2 + 7]);
                    const bf16x8 pf = __builtin_bit_cast(bf16x8, pw);
                    const LAS unsigned char* vb = lds + AT_V + l31 * AT_VP + (32 * T + 16 * c2 + 4 * hi) * 2;
                    { const s16x4 lo = *(const LAS s16x4*)vb, hh = *(const LAS s16x4*)(vb + 16); const bf16x8 vf = {lo[0], lo[1], lo[2], lo[3], hh[0], hh[1], hh[2], hh[3]};
                      o0 = __builtin_amdgcn_mfma_f32_32x32x16_bf16(vf, pf, o0, 0, 0, 0); }
                    { const s16x4 lo = *(const LAS s16x4*)(vb + 32 * AT_VP), hh = *(const LAS s16x4*)(vb + 32 * AT_VP + 16); const bf16x8 vf = {lo[0], lo[1], lo[2], lo[3], hh[0], hh[1], hh[2], hh[3]};
                      o1 = __builtin_amdgcn_mfma_f32_32x32x16_bf16(vf, pf, o1, 0, 0, 0); }
                }
            }
            const float inv = 1.0f / ls;
            if (prompt || l31 < DS) {
                bf16* orow = ATT + (size_t)(prompt ? qrow : (row0 + l31)) * D + h * 64 + 4 * hi;
#pragma unroll
                for (int rq = 0; rq < 4; ++rq) {
                    v2u w0; w0.x = pk2(o0[4 * rq] * inv, o0[4 * rq + 1] * inv); w0.y = pk2(o0[4 * rq + 2] * inv, o0[4 * rq + 3] * inv); *(GAS v2u*)(orow + 8 * rq) = w0;
                    v2u w1; w1.x = pk2(o1[4 * rq] * inv, o1[4 * rq + 1] * inv); w1.y = pk2(o1[4 * rq + 2] * inv, o1[4 * rq + 3] * inv); *(GAS v2u*)(orow + 32 + 8 * rq) = w1;
                }
            }
        }
    }
    __syncthreads();
}

__global__ void __launch_bounds__(NWAVES * 64, 2) mega_fwd(Args args) {
    extern __shared__ __attribute__((aligned(16))) unsigned char lds_raw[];
    LAS unsigned char* lds = (LAS unsigned char*)lds_raw;
    const int tid = threadIdx.x, lane = tid & 63, wave = __builtin_amdgcn_readfirstlane(tid >> 6);
    const int G = gridDim.x, bid = blockIdx.x;
    const int vcu = (G % 8 == 0) ? (bid % 8) * (G / 8) + bid / 8 : bid;
    const int gw = vcu * NWAVES + wave, NGW = G * NWAVES;
    CArgs* ap0 = fresh_args();
    for (int u = tid; u < (LDS_BYTES - LDSCTL_OFF) / 4; u += NWAVES * 64) ((LAS unsigned*)(lds + LDSCTL_OFF))[u] = 0u;
    __syncthreads();
    XcdBarrier bar = xcd_barrier_post((unsigned*)(ap0->ws + WS_CTL) + CW_BAR, (volatile LAS unsigned*)(lds + MISC_OFF) + 8);
#define GRID_BAR() xcd_barrier(bar)
#define FRESH_TID() int tid_ = threadIdx.x; asm volatile("" : "+v"(tid_)); const int lane_ = tid_ & 63, wave_ = __builtin_amdgcn_readfirstlane(tid_ >> 6), gw_ = vcu * NWAVES + wave_; (void)lane_; (void)gw_

    int cursor = 0;
#define ENSURE(need) do { const int need_ = (need); if (cursor < need_) { FRESH_TID(); conv_range(fresh_args(), lds, cursor, need_, gw_, NGW, wave_, lane_); cursor = need_; } } while (0)
#define IDLE_CONV(first_idle, per_wave) do { if (cursor < IT_TOTAL) { const int nid_ = G - (first_idle); int hi_ = cursor + nid_ * NWAVES * (per_wave); if (hi_ > IT_TOTAL) hi_ = IT_TOTAL; \
        if (bid >= (first_idle)) { FRESH_TID(); conv_range(fresh_args(), lds, cursor, hi_, (bid - (first_idle)) * NWAVES + wave_, nid_ * NWAVES, wave_, lane_); } cursor = hi_; } } while (0)
    prologue(ap0, lds, gw, NGW, wave, lane);
    ENSURE(conv_seg_start(0, 1));
    GRID_BAR();

    for (int hl = 0; hl < 8; ++hl) {
        const int l = hl >> 1, f = hl & 1, j = l >> 1;
        const bool odd = (l & 1) != 0;
        {
            CArgs* ap = fresh_args(); unsigned char* ws = ap->ws;
            const pg8::Gemm g = pg8::plain_gemm((const bf16*)(ws + WS_HB), (const bf16*)(ws + WS_W) + WO_FFNIN + (size_t)hl * SZ_FFNIN, D, D, D); pg8::StaticOrder S; S.init(M, NFF, G, bid);
            pg8::EpiSwiGLU E{(bf16*)(ws + WS_ACT), DFFP, (const float*)(ws + WS_RS)};
            pg8::gemm_phase<pg8::EpiSwiGLU, pg8::StaticOrder, true, true>(lds, g, S, E);
        }
        IDLE_CONV((M / 256) * (NFF / 256) % G == 0 ? G : (M / 256) * (NFF / 256) % G, 7);
        ENSURE(conv_seg_start(l, f ? 7 : 2));
        GRID_BAR();
        {
            CArgs* ap = fresh_args(); unsigned char* ws = ap->ws;
            const bf16* Wo_ = (const bf16*)(ws + WS_W) + WO_FFNOUT + (size_t)hl * SZ_FFNOUT;
            { const pg8::Gemm g = pg8::plain_gemm((const bf16*)(ws + WS_ACT), Wo_, DFF, DFFP, DFFP); pg8::StaticOrder S; S.init(MP, D, G, bid);
              pg8::EpiBf16S E{(bf16*)(ws + WS_Y), D, nullptr, 0, nullptr};
              pg8::gemm_phase<pg8::EpiBf16S, pg8::StaticOrder, true, true>(lds, g, S, E); }
            { const pg8::Gemm g{(const bf16*)(ws + WS_ACT) + (size_t)MP * DFFP, Wo_, KSL_FFN, DFFP, DFFP, KSL_FFN * 2, 0, (size_t)256 * DFFP * 2, KSL_FFN * 2}; pg8::StaticOrder S; S.init(NSL_FFN * 256, D, G, bid);
              pg8::EpiF32 E{(float*)(ws + WS_YP), D};
              pg8::gemm_phase<pg8::EpiF32, pg8::StaticOrder, true, true>(lds, g, S, E); }
        }
        GRID_BAR();
        {
            CArgs* ap = fresh_args(); unsigned char* ws = ap->ws; const float* NG = ap->in[6];
            const float* ga = NG + (size_t)(l * 6 + (f ? 5 : 1)) * D;
            FRESH_TID();
            norm_phase<NSL_FFN>((const bf16*)(ws + WS_Y), (const float*)(ws + WS_YP), (bf16*)(ws + WS_HB), (float*)(ws + WS_RS), hl == 7 ? ap->out : nullptr, 0.5f, ga, gw_, NGW, lane_);
        }
        ENSURE(f == 0 ? conv_seg_start(l, 3) : (l < 3 ? conv_seg_start(l + 1, 1) : IT_TOTAL));
        GRID_BAR();
        if (f == 0) {
            {
                CArgs* ap = fresh_args(); unsigned char* ws = ap->ws;
                const int N = odd ? NQKV : NMIX; const bf16* W = (const bf16*)(ws + WS_W);
                const pg8::Gemm g = pg8::plain_gemm((const bf16*)(ws + WS_HB), odd ? W + WO_QKV + (size_t)j * SZ_QKV : W + WO_MIXIN + (size_t)j * SZ_MIXIN, D, D, D); pg8::StaticOrder S; S.init(M, N, G, bid);
                pg8::EpiBf16S E{(bf16*)(ws + WS_Z), N, nullptr, 0, (const float*)(ws + WS_RS)};
                pg8::gemm_phase<pg8::EpiBf16S, pg8::StaticOrder, true, true>(lds, g, S, E);
            }
            { const int nu_ = (M / 256) * ((odd ? NQKV : NMIX) / 256); IDLE_CONV(nu_ % G == 0 ? G : nu_ % G, odd ? 5 : 4); }
            ENSURE(conv_seg_start(l, 5));
            GRID_BAR();
            if (odd) {
                FRESH_TID();
                attention_phase(fresh_args(), lds, j, bid, G, tid_, wave_, lane_);
                GRID_BAR();
            } else {
                { FRESH_TID();
                  convpool_phase(fresh_args(), j, bid, G, tid_); }
                GRID_BAR();
                {
                    CArgs* ap = fresh_args(); unsigned char* ws = ap->ws;
                    const pg8::Gemm g{(const bf16*)(ws + WS_DP), (const bf16*)(ws + WS_W) + WO_POOLW + (size_t)j * SZ_POOLW, 256, DCV, 256, (size_t)256 * DCV * 2, 512, (size_t)256 * 256 * 2, 0}; pg8::StaticOrder S; S.init(M, DCV, G, bid);
                    pg8::EpiBf16S E{(bf16*)(ws + WS_CAT), D, ap->in[12] + (size_t)j * DCV, DCV, nullptr};
                    pg8::gemm_phase<pg8::EpiBf16S, pg8::StaticOrder, true, true>(lds, g, S, E);
                }
                GRID_BAR();
            }
            {
                CArgs* ap = fresh_args(); unsigned char* ws = ap->ws; const bf16* W = (const bf16*)(ws + WS_W);
                const bf16* Wm = odd ? W + WO_WO + (size_t)j * SZ_WO : W + WO_MIXOUT + (size_t)j * SZ_MIXOUT;
                { const pg8::Gemm g = pg8::plain_gemm((const bf16*)(ws + WS_CAT), Wm, D, D, D); pg8::StaticOrder S; S.init(MP, D, G, bid);
                  pg8::EpiBf16S E{(bf16*)(ws + WS_Y), D, nullptr, 0, nullptr};
                  pg8::gemm_phase<pg8::EpiBf16S, pg8::StaticOrder, true, true>(lds, g, S, E); }
                { const pg8::Gemm g{(const bf16*)(ws + WS_CAT) + (size_t)MP * D, Wm, KSL_MIX, D, D, KSL_MIX * 2, 0, (size_t)256 * D * 2, KSL_MIX * 2}; pg8::StaticOrder S; S.init(NSL_MIX * 256, D, G, bid);
                  pg8::EpiF32 E{(float*)(ws + WS_YP), D};
                  pg8::gemm_phase<pg8::EpiF32, pg8::StaticOrder, true, true>(lds, g, S, E); }
            }
            GRID_BAR();
            {   CArgs* ap = fresh_args(); unsigned char* ws = ap->ws; const float* NG = ap->in[6];
                FRESH_TID();
                norm_phase<NSL_MIX>((const bf16*)(ws + WS_Y), (const float*)(ws + WS_YP), (bf16*)(ws + WS_HB), (float*)(ws + WS_RS), nullptr, 1.0f, NG + (size_t)(l * 6 + 3) * D, gw_, NGW, lane_); }
            ENSURE(conv_seg_start(l, 6));
            GRID_BAR();
        }
    }
}

extern "C" void kernel_launch(void* const* d_in, const int* in_sizes, int n_in, void* d_out, int out_size, void* d_ws, size_t ws_size, hipStream_t stream) {
    static int grid = 0;
    if (grid == 0) {
        if (n_in != 18 || out_size != (int)O_END || ws_size < WS_END) { fprintf(stderr, "kernel_launch: unexpected shapes (n_in %d, out %d, ws %zu; need ws >= %zu)\n", n_in, out_size, ws_size, (size_t)WS_END); grid = -1; return; }
        int dev = 0, cus = 0, per_cu = 0;
        if (hipGetDevice(&dev) != hipSuccess || hipDeviceGetAttribute(&cus, hipDeviceAttributeMultiprocessorCount, dev) != hipSuccess) { grid = -1; return; }
        if (hipFuncSetAttribute((const void*)mega_fwd, hipFuncAttributeMaxDynamicSharedMemorySize, LDS_BYTES) != hipSuccess) { fprintf(stderr, "kernel_launch: hipFuncSetAttribute failed\n"); grid = -1; return; }
        if (hipOccupancyMaxActiveBlocksPerMultiprocessor(&per_cu, (const void*)mega_fwd, NWAVES * 64, LDS_BYTES) != hipSuccess || per_cu < 1)
            fprintf(stderr, "kernel_launch: occupancy query reports %d\n", per_cu);
        (void)hipGetLastError();
        grid = cus;
    }
    if (grid < 0) return;
    if (hipMemsetAsync((char*)d_ws + WS_CTL, 0, CTL_ZERO_BYTES, stream) != hipSuccess) return;
    Args a{};
    for (int i = 0; i < 18; ++i) a.in[i] = (const float*)d_in[i];
    a.out = (float*)d_out; a.ws = (unsigned char*)d_ws;
    hipLaunchKernelGGL(mega_fwd, dim3(grid), dim3(NWAVES * 64), LDS_BYTES, stream, a);
}
```

```cpp
#include <hip/hip_runtime.h>
#include <cstdio>
#include <cstdint>

#define LAS __attribute__((address_space(3)))
#define GAS __attribute__((address_space(1)))

namespace pg8 {
typedef unsigned short bf16_t;
typedef short bf16x8 __attribute__((ext_vector_type(8)));
typedef float f32x4 __attribute__((ext_vector_type(4)));
typedef float f32x2 __attribute__((ext_vector_type(2)));
typedef unsigned u32x4 __attribute__((ext_vector_type(4)));
constexpr int BM = 256, BK = 64, HALF = 128, HTB = HALF * BK * 2, STAGE_BYTES = 8 * HTB, NXCD = 8, WGM = 8;

__host__ __device__ __forceinline__ int lds_byte(int r, int c) { const int st = (r >> 4) * 2 + (c >> 5), rr = r & 15, cc = c & 31, ob = rr * 64 + cc * 2; return st * 1024 + (ob ^ (((ob >> 9) & 1) << 5)); }
__host__ __device__ __forceinline__ void stage_rc(int b, int& R, int& C) { const int st = b / 1024, sb = b % 1024, swz = sb ^ (((sb >> 9) & 1) << 5); R = (st >> 1) * 16 + swz / 64; C = (st & 1) * 32 + (swz % 64) / 2; }
__host__ __device__ __forceinline__ int perm32(int rho) { const int n = rho >> 4, i = rho & 15; return 8 * (i >> 2) + 4 * n + (i & 3); }

struct Unit { int pm, pn; };
struct Gemm { const bf16_t* A; const bf16_t* Bt; int K, lda, ldb; size_t a_pm, a_pn, b_pn, b_pm; };
__device__ __forceinline__ Gemm plain_gemm(const bf16_t* A, const bf16_t* Bt, int K, int lda, int ldb) { return Gemm{A, Bt, K, lda, ldb, (size_t)BM * lda * 2, 0, (size_t)BM * ldb * 2, 0}; }

struct StaticOrder {
    int nM, nN, nwg, G, c;
    __host__ __device__ void init(int M, int N, int G_, int c_) { nM = M / BM; nN = N / BM; nwg = nM * nN; G = G_; c = c_; }
    __host__ __device__ bool next(int i, Unit& u) const {
        const long L = (long)i * G + c; if (L >= nwg) return false;
        int wgid = (int)L; { const int q = nwg / NXCD, r = nwg % NXCD, xcd = wgid % NXCD, off = wgid / NXCD; wgid = (xcd < r ? xcd * (q + 1) : r * (q + 1) + (xcd - r) * q) + off; }
        const int nig = WGM * nN, gid = wgid / nig, fm = gid * WGM, gsz = (nM - fm) < WGM ? (nM - fm) : WGM;
        u.pm = fm + ((wgid % nig) % gsz); u.pn = (wgid % nig) / gsz; return true;
    }
    __device__ __forceinline__ void a_ready(const Unit&) const {}
    __device__ __forceinline__ void done(const Unit&) const {}
};

__device__ __forceinline__ unsigned cvt_pk_bf16(float lo, float hi) { unsigned r; asm volatile("v_cvt_pk_bf16_f32 %0, %1, %2" : "=v"(r) : "v"(lo), "v"(hi)); return r; }

struct EpiF32 {
    static constexpr bool PERM = false, AFTER_DRAIN = false;
    float* C; int ldc;
    __device__ __forceinline__ void operator()(const f32x4 (&acc)[2][2][4][2], const Unit& u, int wr, int wc, int fr, int fq) const {
        const int row0 = u.pm * BM + wr * 64 + fr, col0 = u.pn * BM + wc * 32 + 4 * fq;
#pragma unroll
        for (int ai = 0; ai < 2; ++ai)
#pragma unroll
            for (int m = 0; m < 4; ++m) { float* rowp = C + (size_t)(row0 + ai * HALF + m * 16) * ldc + col0;
#pragma unroll
                for (int bj = 0; bj < 2; ++bj)
#pragma unroll
                    for (int n = 0; n < 2; ++n) *(f32x4*)(rowp + bj * HALF + n * 16) = acc[ai][bj][m][n]; }
    }
};
struct EpiBf16S {
    static constexpr bool PERM = true, AFTER_DRAIN = false;
    bf16_t* O; int ldc; const float* scale; int col_off; const float* rs;
    __device__ __forceinline__ void operator()(const f32x4 (&acc)[2][2][4][2], const Unit& u, int wr, int wc, int fr, int fq) const {
        float rsv[8];
        { const GAS float* p = (const GAS float*)rs + (u.pm * BM + wr * 64 + fr);
#pragma unroll
          for (int i = 0; i < 8; ++i) rsv[i] = rs ? p[(i >> 2) * HALF + (i & 3) * 16] : 1.0f; }
        const int row0 = u.pm * BM + wr * 64 + fr; const int col0 = u.pn * BM + wc * 32 + 8 * fq;
        f32x4 sv[2][2];
#pragma unroll
        for (int bj = 0; bj < 2; ++bj)
#pragma unroll
            for (int n = 0; n < 2; ++n) sv[bj][n] = scale ? *(const f32x4*)(scale + col0 + bj * HALF + 4 * n) : (f32x4){1.f, 1.f, 1.f, 1.f};
#pragma unroll
        for (int ai = 0; ai < 2; ++ai)
#pragma unroll
            for (int m = 0; m < 4; ++m) { bf16_t* rowp = O + (size_t)(row0 + ai * HALF + m * 16) * ldc + col_off + col0; const float r = rsv[ai * 4 + m];
#pragma unroll
                for (int bj = 0; bj < 2; ++bj) { const f32x4 v0 = acc[ai][bj][m][0] * sv[bj][0] * r, v1 = acc[ai][bj][m][1] * sv[bj][1] * r;
                    u32x4 w; w.x = cvt_pk_bf16(v0[0], v0[1]); w.y = cvt_pk_bf16(v0[2], v0[3]); w.z = cvt_pk_bf16(v1[0], v1[1]); w.w = cvt_pk_bf16(v1[2], v1[3]);
                    *(u32x4*)(rowp + bj * HALF) = w; } }
    }
};
__device__ __forceinline__ f32x2 silu_mul2(f32x2 g, f32x2 u) {
    const f32x2 t = g * u, a = g * -1.44269504089f;
    f32x2 e; e.x = __builtin_amdgcn_exp2f(a.x); e.y = __builtin_amdgcn_exp2f(a.y);
    const f32x2 d = e + 1.0f;
    f32x2 r; r.x = __builtin_amdgcn_rcpf(d.x); r.y = __builtin_amdgcn_rcpf(d.y);
    return t * r;
}
struct EpiSwiGLU {
    static constexpr bool PERM = true, AFTER_DRAIN = false;
    bf16_t* O; int ldc; const float* rs;
    __device__ __forceinline__ void operator()(const f32x4 (&acc)[2][2][4][2], const Unit& u, int wr, int wc, int fr, int fq) const {
        float rsv[8];
        { const GAS float* p = (const GAS float*)rs + (u.pm * BM + wr * 64 + fr);
#pragma unroll
          for (int i = 0; i < 8; ++i) rsv[i] = p[(i >> 2) * HALF + (i & 3) * 16]; }
        const int row0 = u.pm * BM + wr * 64 + fr; const int col0 = u.pn * HALF + wc * 32 + 8 * fq;
#pragma unroll
        for (int ai = 0; ai < 2; ++ai)
#pragma unroll
            for (int m = 0; m < 4; ++m) { bf16_t* rowp = O + (size_t)(row0 + ai * HALF + m * 16) * ldc + col0;
                const float r = rsv[ai * 4 + m];
                const f32x4 g0 = acc[ai][0][m][0] * r, g1 = acc[ai][0][m][1] * r, u0 = acc[ai][1][m][0] * r, u1 = acc[ai][1][m][1] * r;
                const f32x2 a = silu_mul2((f32x2){g0[0], g0[1]}, (f32x2){u0[0], u0[1]}), b = silu_mul2((f32x2){g0[2], g0[3]}, (f32x2){u0[2], u0[3]});
                const f32x2 c = silu_mul2((f32x2){g1[0], g1[1]}, (f32x2){u1[0], u1[1]}), d = silu_mul2((f32x2){g1[2], g1[3]}, (f32x2){u1[2], u1[3]});
                u32x4 w; w.x = cvt_pk_bf16(a.x, a.y); w.y = cvt_pk_bf16(b.x, b.y); w.z = cvt_pk_bf16(c.x, c.y); w.w = cvt_pk_bf16(d.x, d.y);
                *(u32x4*)rowp = w; }
    }
};

template <class Epi, class Sched, bool ALIGN_EPI = false, bool SP2 = false>
__device__ __forceinline__ void gemm_phase(LAS unsigned char* lds, const Gemm g, const Sched& S, const Epi& E) {
    int tid = threadIdx.x; asm volatile("" : "+v"(tid));
    const int wid = __builtin_amdgcn_readfirstlane(tid >> 6), lane = tid & 63, wr = wid >> 2, wc = wid & 3, fr = lane & 15, fq = lane >> 4;
    const int K = g.K, nt = K / BK;
    unsigned voffA[2], voffB[2];
#pragma unroll
    for (int i = 0; i < 2; ++i) { int R, C; stage_rc(tid * 16 + i * 8192, R, C); const int Rb = Epi::PERM ? ((R & ~31) + perm32(R & 31)) : R;
        voffA[i] = (unsigned)(R * g.lda + C) * 2u; voffB[i] = (unsigned)(Rb * g.ldb + C) * 2u; }
    const size_t kstep = (size_t)(BK * 2);
    const size_t hstepA = (size_t)HALF * g.lda * 2, hstepB = (size_t)HALF * g.ldb * 2;
    const unsigned ldsw = (unsigned)wid * 1024u;
    const int aoff = lds_byte(wr * 64 + fr, fq * 8), boff = lds_byte(wc * 32 + fr, fq * 8);
#define PG8_SA(b, h) (((b) * 2 + (h)) * HTB)
#define PG8_SB(b, h) ((4 + (b) * 2 + (h)) * HTB)
#define PG8_STAGE(bufoff, gbase, voff) do { _Pragma("unroll") for (int _i = 0; _i < 2; ++_i) \
        __builtin_amdgcn_global_load_lds((const unsigned*)((const char*)(gbase) + (voff)[_i]), (LAS unsigned*)(lds + (bufoff) + ldsw + _i * 8192), 16, 0, 0); } while (0)
#define PG8_LDA(dst, b, h) do { _Pragma("unroll") for (int m = 0; m < 4; ++m) _Pragma("unroll") for (int k = 0; k < 2; ++k) dst[m][k] = *(const LAS bf16x8*)(lds + PG8_SA(b, h) + aoff + m * 2048 + k * 1024); } while (0)
#define PG8_LDB(dst, b, h) do { _Pragma("unroll") for (int n = 0; n < 2; ++n) _Pragma("unroll") for (int k = 0; k < 2; ++k) dst[n][k] = *(const LAS bf16x8*)(lds + PG8_SB(b, h) + boff + n * 2048 + k * 1024); } while (0)
#define PG8_MMA(ai, bj, At, Bt) do { __builtin_amdgcn_s_setprio(1); _Pragma("unroll") for (int m = 0; m < 4; ++m) _Pragma("unroll") for (int n = 0; n < 2; ++n) _Pragma("unroll") for (int k = 0; k < 2; ++k) \
        acc[ai][bj][m][n] = __builtin_amdgcn_mfma_f32_16x16x32_bf16(Bt[n][k], At[m][k], acc[ai][bj][m][n], 0, 0, 0); __builtin_amdgcn_s_setprio(0); } while (0)
#define PG8_WAIT_V(n) asm volatile("s_waitcnt vmcnt(" #n ")" ::: "memory")
#define PG8_WAIT_L(n) asm volatile("s_waitcnt lgkmcnt(" #n ")" ::: "memory")
#define PG8_BAR __builtin_amdgcn_s_barrier()
#define PG8_SCHED __builtin_amdgcn_sched_barrier(0)
    Unit cur, nxt; int ui = 0;
    if (!S.next(0, cur)) return;
    f32x4 acc[2][2][4][2];
#pragma unroll
    for (int a = 0; a < 2; ++a)
#pragma unroll
        for (int b = 0; b < 2; ++b)
#pragma unroll
            for (int m = 0; m < 4; ++m)
#pragma unroll
                for (int n = 0; n < 2; ++n) acc[a][b][m][n] = (f32x4){0.f, 0.f, 0.f, 0.f};
    bf16x8 At[4][2], B0[2][2], B1[2][2];
    const char* cA = (const char*)g.A + (size_t)cur.pm * g.a_pm + (size_t)cur.pn * g.a_pn; const char* cB = (const char*)g.Bt + (size_t)cur.pn * g.b_pn + (size_t)cur.pm * g.b_pm;
    S.a_ready(cur);
    if constexpr (SP2) {
        PG8_STAGE(PG8_SB(0, 0), cB, voffB); PG8_STAGE(PG8_SB(0, 1), cB + hstepB, voffB); PG8_STAGE(PG8_SA(0, 0), cA, voffA); PG8_STAGE(PG8_SA(0, 1), cA + hstepA, voffA);
        if (wr == 1) PG8_BAR;
        PG8_WAIT_V(2); PG8_BAR;
        PG8_STAGE(PG8_SB(1, 0), cB + kstep, voffB); PG8_STAGE(PG8_SA(1, 0), cA + kstep, voffA); PG8_STAGE(PG8_SB(1, 1), cB + hstepB + kstep, voffB);
        PG8_WAIT_V(6); PG8_BAR;
    } else {
        PG8_STAGE(PG8_SB(0, 0), cB, voffB); PG8_STAGE(PG8_SA(0, 0), cA, voffA); PG8_STAGE(PG8_SB(0, 1), cB + hstepB, voffB); PG8_STAGE(PG8_SA(0, 1), cA + hstepA, voffA);
        if (wr == 1) PG8_BAR;
        PG8_WAIT_V(4); PG8_BAR;
        PG8_STAGE(PG8_SB(1, 0), cB + kstep, voffB); PG8_STAGE(PG8_SA(1, 0), cA + kstep, voffA); PG8_STAGE(PG8_SB(1, 1), cB + hstepB + kstep, voffB);
        PG8_WAIT_V(6); PG8_BAR;
    }
    for (;;) {
        const bool has_next = S.next(ui + 1, nxt);
        const char* nA = has_next ? (const char*)g.A + (size_t)nxt.pm * g.a_pm + (size_t)nxt.pn * g.a_pn : cA; const char* nB = has_next ? (const char*)g.Bt + (size_t)nxt.pn * g.b_pn + (size_t)nxt.pm * g.b_pm : cB;
        for (int t = 0; t < nt; t += 2) {
            const bool last = (t == nt - 2);
            const char* a1 = cA + (size_t)(t + 1) * kstep;
            const char* a2 = last ? nA : cA + (size_t)(t + 2) * kstep; const char* b2 = last ? nB : cB + (size_t)(t + 2) * kstep;
            const char* a3 = a2 + kstep; const char* b3 = b2 + kstep;
            if (last && has_next) S.a_ready(nxt);
            if constexpr (SP2) {
            PG8_LDB(B0, 0, 0); PG8_LDB(B1, 0, 1); PG8_SCHED; PG8_LDA(At, 0, 0); PG8_STAGE(PG8_SA(1, 1), a1 + hstepA, voffA);
            PG8_WAIT_V(8); PG8_WAIT_L(0); PG8_BAR; PG8_MMA(0, 0, At, B0); PG8_MMA(0, 1, At, B1); PG8_BAR; PG8_SCHED;
            PG8_LDA(At, 0, 1); PG8_STAGE(PG8_SB(0, 0), b2, voffB); PG8_STAGE(PG8_SB(0, 1), b2 + hstepB, voffB); PG8_STAGE(PG8_SA(0, 0), a2, voffA);
            PG8_WAIT_V(8); PG8_WAIT_L(0); PG8_BAR; PG8_MMA(1, 0, At, B0); PG8_MMA(1, 1, At, B1); PG8_BAR; PG8_SCHED;
            PG8_LDB(B0, 1, 0); PG8_LDB(B1, 1, 1); PG8_SCHED; PG8_LDA(At, 1, 0); PG8_STAGE(PG8_SA(0, 1), a2 + hstepA, voffA);
            PG8_WAIT_V(8); PG8_WAIT_L(0); PG8_BAR; PG8_MMA(0, 0, At, B0); PG8_MMA(0, 1, At, B1); PG8_BAR; PG8_SCHED;
            PG8_LDA(At, 1, 1); PG8_STAGE(PG8_SB(1, 0), b3, voffB); PG8_STAGE(PG8_SB(1, 1), b3 + hstepB, voffB); PG8_STAGE(PG8_SA(1, 0), a3, voffA);
            PG8_WAIT_V(8); PG8_WAIT_L(0); PG8_BAR; PG8_MMA(1, 0, At, B0); PG8_MMA(1, 1, At, B1); PG8_BAR; PG8_SCHED;
            } else {
            PG8_LDB(B0, 0, 0); PG8_SCHED; PG8_LDA(At, 0, 0); PG8_STAGE(PG8_SA(1, 1), a1 + hstepA, voffA);
            PG8_WAIT_L(8); PG8_BAR; PG8_WAIT_L(0); PG8_MMA(0, 0, At, B0); PG8_BAR; PG8_SCHED;
            PG8_LDB(B1, 0, 1); PG8_STAGE(PG8_SB(0, 0), b2, voffB);
            PG8_BAR; PG8_WAIT_L(0); PG8_MMA(0, 1, At, B1); PG8_BAR;
            PG8_LDA(At, 0, 1); PG8_STAGE(PG8_SA(0, 0), a2, voffA);
            PG8_BAR; PG8_WAIT_L(0); PG8_MMA(1, 0, At, B0); PG8_BAR; PG8_SCHED;
            PG8_STAGE(PG8_SB(0, 1), b2 + hstepB, voffB);
            PG8_WAIT_V(6); PG8_BAR; PG8_MMA(1, 1, At, B1); PG8_BAR;
            PG8_LDB(B0, 1, 0); PG8_SCHED; PG8_LDA(At, 1, 0); PG8_STAGE(PG8_SA(0, 1), a2 + hstepA, voffA);
            PG8_WAIT_L(8); PG8_BAR; PG8_WAIT_L(0); PG8_MMA(0, 0, At, B0); PG8_BAR; PG8_SCHED;
            PG8_LDB(B1, 1, 1); PG8_STAGE(PG8_SB(1, 0), b3, voffB);
            PG8_BAR; PG8_WAIT_L(0); PG8_MMA(0, 1, At, B1); PG8_BAR;
            PG8_LDA(At, 1, 1); PG8_STAGE(PG8_SA(1, 0), a3, voffA);
            PG8_BAR; PG8_WAIT_L(0); PG8_MMA(1, 0, At, B0); PG8_BAR; PG8_SCHED;
            PG8_STAGE(PG8_SB(1, 1), b3 + hstepB, voffB);
            PG8_WAIT_V(6); PG8_BAR; PG8_MMA(1, 1, At, B1); PG8_BAR;
            }
        }
        if constexpr (ALIGN_EPI) { if (wr == 0) PG8_BAR; }
        if constexpr (!Epi::AFTER_DRAIN) { E(acc, cur, wr, wc, fr, fq); S.done(cur); }
        if (!has_next) break;
#pragma unroll
        for (int a = 0; a < 2; ++a)
#pragma unroll
            for (int b = 0; b < 2; ++b)
#pragma unroll
                for (int m = 0; m < 4; ++m)
#pragma unroll
                    for (int n = 0; n < 2; ++n) acc[a][b][m][n] = (f32x4){0.f, 0.f, 0.f, 0.f};
        cur = nxt; cA = nA; cB = nB; ++ui;
        if constexpr (ALIGN_EPI) { if (wr == 1) PG8_BAR; }
    }
    PG8_WAIT_V(0);
    if constexpr (!ALIGN_EPI) { if (wr == 0) PG8_BAR; }
    PG8_BAR;
#undef PG8_SA
#undef PG8_SB
#undef PG8_STAGE
#undef PG8_LDA
#undef PG8_LDB
#undef PG8_MMA
#undef PG8_WAIT_V
#undef PG8_WAIT_L
#undef PG8_BAR
#undef PG8_SCHED
}
}

typedef unsigned short bf16;
typedef unsigned v4u __attribute__((ext_vector_type(4)));
typedef unsigned v2u __attribute__((ext_vector_type(2)));
typedef float f32x4 __attribute__((ext_vector_type(4)));
typedef float f32x2 __attribute__((ext_vector_type(2)));
typedef float f32x16 __attribute__((ext_vector_type(16)));
typedef short bf16x8 __attribute__((ext_vector_type(8)));
typedef short s16x4 __attribute__((ext_vector_type(4)));

constexpr int NWAVES = 8;
constexpr int CONV_PER_IDLE_WAVE = 6;
constexpr int D = 2048, MP = 8192, MS = 256, M = MP + MS, DFF = 5504, NFF = 2 * DFF, NMIX = 4096, NQKV = 2560, DCV = 1024;
constexpr int DFFP = 5632;
constexpr int KSL_FFN = 512, KSL_MIX = 256;
constexpr int NSL_FFN = DFFP / KSL_FFN, NSL_MIX = D / KSL_MIX;
constexpr int SEQ = 2048, NB = 4, DB = 32, DS = 8, NHEAD = 32, NKVH = 4, HD = 64, KVB = 128, PCTX = 15;
constexpr float EPS = 1e-6f;
constexpr float LOG2E = 1.4426950408889634f;

constexpr size_t O_Y = 0, O_CONVP = (size_t)M * D, O_POOLP = O_CONVP + 2 * NB * 2 * DCV, O_KP = O_POOLP + 2 * NB * PCTX * DCV, O_VP = O_KP + 2 * NB * KVB * 256,
                 O_CONVS = O_VP + 2 * NB * KVB * 256, O_POOLS = O_CONVS + 2 * DB * 2 * DCV, O_KS = O_POOLS + 2 * DB * PCTX * DCV, O_VS = O_KS + 2 * DB * KVB * 256, O_END = O_VS + 2 * DB * KVB * 256;
static_assert(O_END == 23273472, "output size");

constexpr size_t MiB = 1u << 20;
constexpr size_t WS_CTL = 0, CTL_ZERO_BYTES = 1 * MiB;
constexpr size_t WS_RS = 1 * MiB;
constexpr size_t WS_HB = 2 * MiB;
constexpr size_t WS_ACT = 36 * MiB;
constexpr size_t WS_Y = 128 * MiB;
constexpr size_t WS_Z = 194 * MiB;
constexpr size_t WS_CAT = 260 * MiB;
constexpr size_t WS_DP = 294 * MiB;
constexpr size_t WS_YP = 312 * MiB;
constexpr size_t WS_W = 360 * MiB;
constexpr size_t SZ_FFNIN = (size_t)NFF * D, SZ_FFNOUT = (size_t)D * DFFP, SZ_MIXIN = (size_t)NMIX * D, SZ_MIXOUT = (size_t)D * D, SZ_QKV = (size_t)NQKV * D, SZ_WO = (size_t)D * D, SZ_POOLW = 4 * 256 * 256;
constexpr size_t WO_FFNIN = 0, WO_FFNOUT = WO_FFNIN + 8 * SZ_FFNIN, WO_MIXIN = WO_FFNOUT + 8 * SZ_FFNOUT, WO_MIXOUT = WO_MIXIN + 2 * SZ_MIXIN, WO_QKV = WO_MIXOUT + 2 * SZ_MIXOUT,
                 WO_WO = WO_QKV + 2 * SZ_QKV, WO_POOLW = WO_WO + 2 * SZ_WO, WO_END = WO_POOLW + 2 * SZ_POOLW;
constexpr size_t WS_END = WS_W + WO_END * 2;
static_assert(WS_HB + (size_t)M * D * 2 <= WS_ACT && WS_ACT + (size_t)M * DFFP * 2 <= WS_Y && WS_Y + (size_t)M * D * 4 <= WS_Z && WS_Z + (size_t)M * NMIX * 2 <= WS_CAT && WS_CAT + (size_t)M * D * 2 <= WS_DP && WS_DP + (size_t)M * DCV * 2 <= WS_YP && WS_YP + (size_t)NSL_FFN * 256 * D * 4 <= WS_W, "ws map");
constexpr int CW_BAR = 4096;

constexpr int RING_BYTES = 135168;
constexpr int LDSCTL_OFF = RING_BYTES, MISC_OFF = LDSCTL_OFF + 320;
constexpr int LDS_BYTES = 147456;
static_assert(MISC_OFF + 128 <= LDS_BYTES, "LDS map");

#define LDS_WAIT() asm volatile("s_waitcnt lgkmcnt(0)" ::: "memory")
#define VM_WAIT() asm volatile("s_waitcnt vmcnt(0)" ::: "memory")
__device__ __forceinline__ unsigned f2bf(float f) { unsigned u = __builtin_bit_cast(unsigned, f); return (u + 0x7fffu + ((u >> 16) & 1u)) >> 16; }
typedef __bf16 bf16x2_t __attribute__((ext_vector_type(2)));
__device__ __forceinline__ unsigned pk2(float lo, float hi) { const f32x2 v = {lo, hi}; return __builtin_bit_cast(unsigned, __builtin_convertvector(v, bf16x2_t)); }
__device__ __forceinline__ float bf_lo(unsigned w) { return __builtin_bit_cast(float, w << 16); }
__device__ __forceinline__ float bf_hi(unsigned w) { return __builtin_bit_cast(float, w & 0xffff0000u); }

#define XB_TMO      128
#define XB_XCNT(j)  (256  + 64 * (j))
#define XB_XSUB(j)  (1280 + 64 * (j))
#define XB_XGEN(j)  (2304 + 64 * (j))
#define XB_TOP      3328
#define XB_TOPGEN   3392
#define XCD_BAR_WORDS 3456
#define XB_SPIN_CAP (1u << 18)
__device__ __forceinline__ unsigned xb_ld(unsigned* p)              { return __hip_atomic_load(p, __ATOMIC_RELAXED, __HIP_MEMORY_SCOPE_AGENT); }
__device__ __forceinline__ unsigned xb_add(unsigned* p, unsigned v) { return __hip_atomic_fetch_add(p, v, __ATOMIC_RELAXED, __HIP_MEMORY_SCOPE_AGENT); }
__device__ __forceinline__ unsigned xb_xcc_id() { return (unsigned)__builtin_amdgcn_s_getreg((3 << 11) | 20) & 0xFu; }
#define XB_SPIN(cond, bar) do { unsigned _sp = 0; while (cond) { __builtin_amdgcn_s_sleep(1); \
    if ((++_sp & 255u) == 0u) { if (xb_ld(&(bar)[XB_TMO])) break; if (_sp > XB_SPIN_CAP) { atomicAdd(&(bar)[XB_TMO], 1u); break; } } } } while (0)
struct XcdBarrier { unsigned* bar; unsigned x; volatile LAS unsigned* st; };
__device__ __forceinline__ XcdBarrier xcd_barrier_post(unsigned* bar, volatile LAS unsigned* st) {
    XcdBarrier b; b.bar = bar; b.x = xb_xcc_id(); b.st = st;
    if (threadIdx.x == 0) (void)xb_add(&bar[XB_XCNT(b.x)], 1u);
    return b;
}
__device__ __forceinline__ void xcd_barrier_complete(unsigned* bar, unsigned x, unsigned& nloc, unsigned& nx) {
    const unsigned G = gridDim.x * gridDim.y * gridDim.z;
    unsigned sum, cnt, mine, sp = 0u;
    for (;;) {
        sum = 0u; cnt = 0u; mine = 0u;
#pragma unroll
        for (unsigned j = 0; j < 16; ++j) { const unsigned c = xb_ld(&bar[XB_XCNT(j)]); sum += c; cnt += (c > 0u) ? 1u : 0u; mine = (j == x) ? c : mine; }
        if (sum == G) break;
        __builtin_amdgcn_s_sleep(1);
        if ((++sp & 255u) == 0u) { if (xb_ld(&bar[XB_TMO])) break; if (sp > XB_SPIN_CAP) { atomicAdd(&bar[XB_TMO], 1u); break; } }
    }
    nloc = mine > 0u ? mine : 1u; nx = cnt > 0u ? cnt : 1u;
}
__device__ __forceinline__ void xcd_barrier(const XcdBarrier& b) {
    asm volatile("s_waitcnt vmcnt(0)" ::: "memory");
    __syncthreads();
    if (threadIdx.x == 0) {
        unsigned* bar = b.bar; asm volatile("" : "+s"(bar));
        __builtin_amdgcn_s_waitcnt(0);
        unsigned nloc = b.st[0], nx = b.st[1];
        const unsigned bx = xb_xcc_id();
        if (nloc == 0u) { xcd_barrier_complete(bar, bx, nloc, nx); b.st[0] = nloc; b.st[1] = nx; }
        const unsigned old = xb_add(&bar[XB_XSUB(bx)], 1u);
        const unsigned gen = old / nloc;
        if (old + 1u == (gen + 1u) * nloc) {
            __builtin_amdgcn_fence(__ATOMIC_RELEASE, "agent");
            asm volatile("s_waitcnt vmcnt(0)" ::: "memory");
            const unsigned og = xb_add(&bar[XB_TOP], 1u);
            const unsigned tg = og / nx;
            if (og + 1u == (tg + 1u) * nx) xb_add(&bar[XB_TOPGEN], 1u);
            else XB_SPIN(xb_ld(&bar[XB_TOPGEN]) == tg, bar);
            __builtin_amdgcn_fence(__ATOMIC_ACQUIRE, "agent");
            xb_add(&bar[XB_XGEN(bx)], 1u);
            asm volatile("s_waitcnt vmcnt(0)" ::: "memory");
        } else {
            XB_SPIN(xb_ld(&bar[XB_XGEN(bx)]) == gen, bar);
            __builtin_amdgcn_fence(__ATOMIC_ACQUIRE, "agent");
            asm volatile("s_waitcnt vmcnt(0)" ::: "memory");
        }
    }
    __syncthreads();
}

__device__ __forceinline__ float wave_sum(float v) {
#pragma unroll
    for (int o = 1; o < 64; o <<= 1) v += __shfl_xor(v, o);
    return v;
}

__device__ __forceinline__ void tr_item(const float* __restrict__ src, int sld, bf16* __restrict__ dst, int K  , int k0, LAS float* scr, int lane, const float* gain = nullptr  ) {
    const GAS float* s = (const GAS float*)src + (size_t)(k0 + (lane >> 4)) * sld + (lane & 15) * 4;
    f32x4 v[16];
#pragma unroll
    for (int it = 0; it < 16; ++it) v[it] = *(const GAS f32x4*)(s + (size_t)(4 * it) * sld);
    if (gain) {
#pragma unroll
        for (int it = 0; it < 16; ++it) v[it] = v[it] * gain[k0 + (lane >> 4) + 4 * it]; }
#pragma unroll
    for (int it = 0; it < 16; ++it) { LAS float* w = scr + ((lane >> 4) + 4 * it) * 65 + (lane & 15) * 4; w[0] = v[it].x; w[1] = v[it].y; w[2] = v[it].z; w[3] = v[it].w; }
    LDS_WAIT(); asm volatile("" ::: "memory");
    const int c = lane >> 3, n1 = lane & 7;
#pragma unroll
    for (int jj = 0; jj < 8; ++jj) { const int n = n1 + 8 * jj; const LAS float* r = scr + (8 * c) * 65 + n;
        v4u o; o.x = pk2(r[0], r[65]); o.y = pk2(r[2 * 65], r[3 * 65]); o.z = pk2(r[4 * 65], r[5 * 65]); o.w = pk2(r[6 * 65], r[7 * 65]);
        *(GAS v4u*)(dst + (size_t)n * K + k0 + 8 * c) = o; }
    LDS_WAIT(); asm volatile("" ::: "memory");
}

struct Args { const float* in[18]; float* out; unsigned char* ws; };
typedef const __attribute__((address_space(4))) Args CArgs;
__device__ __forceinline__ CArgs* fresh_args() { CArgs* p = (CArgs*)__builtin_amdgcn_kernarg_segment_ptr(); asm volatile("" : "+s"(p)); return p; }

constexpr int CI_FFNIN = (D / 64) * (NFF / 64), CI_FFNOUT = (DFF / 64) * (D / 64), CI_MIXIN = (D / 64) * (NMIX / 64), CI_QKV = (D / 64) * (NQKV / 64), CI_SQ = (D / 64) * (D / 64), CI_POOLW = 4 * 16;
constexpr int CI_EVEN = 2 * (CI_FFNIN + CI_FFNOUT) + CI_MIXIN + CI_POOLW + CI_SQ, CI_ODD = 2 * (CI_FFNIN + CI_FFNOUT) + CI_QKV + CI_SQ, CI_PAIR = CI_EVEN + CI_ODD, IT_TOTAL = 2 * CI_PAIR;
__device__ __forceinline__ int conv_seg_start(int l, int seg) {
    const int odd = l & 1; int o = (l >> 1) * CI_PAIR + (odd ? CI_EVEN : 0);
    const int sz[7] = {CI_FFNIN, CI_FFNOUT, odd ? CI_QKV : CI_MIXIN, odd ? 0 : CI_POOLW, CI_SQ, CI_FFNIN, CI_FFNOUT};
#pragma unroll
    for (int i = 0; i < 7; ++i) o += (i < seg) ? sz[i] : 0;
    return o;
}
__device__ __forceinline__ void conv_item(CArgs* ap, int it, LAS float* scr, int lane) {
    bf16* W = (bf16*)(ap->ws + WS_W);
    int l = 2 * (it / CI_PAIR), r = it % CI_PAIR; if (r >= CI_EVEN) { r -= CI_EVEN; l += 1; }
    const int odd = l & 1, j = l >> 1;
    int hl = 2 * l, kind;
    if (r < CI_FFNIN) kind = 0;
    else if ((r -= CI_FFNIN) < CI_FFNOUT) kind = 1;
    else if ((r -= CI_FFNOUT) < (odd ? CI_QKV : CI_MIXIN)) kind = odd ? 3 : 2;
    else if ((r -= (odd ? CI_QKV : CI_MIXIN)) < (odd ? 0 : CI_POOLW)) kind = 4;
    else if ((r -= (odd ? 0 : CI_POOLW)) < CI_SQ) kind = odd ? 6 : 5;
    else if ((r -= CI_SQ) < CI_FFNIN) { kind = 0; hl += 1; }
    else { r -= CI_FFNIN; kind = 1; hl += 1; }
    if (kind == 0) { constexpr int nbn = NFF / 64; const int kb = r / nbn, nb = r % nbn;
        const int n0 = nb * 64, tile = n0 >> 8, w = n0 & 255, scol = (w < 128) ? tile * 128 + w : DFF + tile * 128 + (w - 128);
        tr_item(ap->in[7] + (size_t)hl * D * NFF + scol, NFF, W + WO_FFNIN + (size_t)hl * SZ_FFNIN + (size_t)n0 * D, D, kb * 64, scr, lane, ap->in[6] + (size_t)((hl >> 1) * 6 + ((hl & 1) ? 4 : 0)) * D); }
    else if (kind == 1) { constexpr int nbn = D / 64; const int kb = r / nbn, nb = r % nbn;
        tr_item(ap->in[8] + (size_t)hl * DFF * D + nb * 64, D, W + WO_FFNOUT + (size_t)hl * SZ_FFNOUT + (size_t)(nb * 64) * DFFP, DFFP, kb * 64, scr, lane); }
    else if (kind == 2) { constexpr int nbn = NMIX / 64; const int kb = r / nbn, nb = r % nbn;
        tr_item(ap->in[9] + (size_t)j * D * NMIX + nb * 64, NMIX, W + WO_MIXIN + (size_t)j * SZ_MIXIN + (size_t)(nb * 64) * D, D, kb * 64, scr, lane, ap->in[6] + (size_t)(l * 6 + 2) * D); }
    else if (kind == 3) { constexpr int nbn = NQKV / 64; const int kb = r / nbn, nb = r % nbn;
        tr_item(ap->in[14] + (size_t)j * D * NQKV + nb * 64, NQKV, W + WO_QKV + (size_t)j * SZ_QKV + (size_t)(nb * 64) * D, D, kb * 64, scr, lane, ap->in[6] + (size_t)(l * 6 + 2) * D); }
    else if (kind == 4) { const int mat = j * 4 + (r >> 4), rr = r & 15, kb = rr >> 2, nb = rr & 3;
        tr_item(ap->in[11] + (size_t)mat * 65536 + nb * 64, 256, W + WO_POOLW + (size_t)mat * 65536 + (size_t)(nb * 64) * 256, 256, kb * 64, scr, lane); }
    else { constexpr int nbn = D / 64; const int kb = r / nbn, nb = r % nbn;
        if (kind == 5) tr_item(ap->in[13] + (size_t)j * D * D + nb * 64, D, W + WO_MIXOUT + (size_t)j * SZ_MIXOUT + (size_t)(nb * 64) * D, D, kb * 64, scr, lane);
        else tr_item(ap->in[15] + (size_t)j * D * D + nb * 64, D, W + WO_WO + (size_t)j * SZ_WO + (size_t)(nb * 64) * D, D, kb * 64, scr, lane); }
}
__device__ __forceinline__ void conv_range(CArgs* ap, LAS unsigned char* lds, int lo, int hi, int w, int nworkers, int wave, int lane) {
    LAS float* scr = (LAS float*)(lds + wave * 16640);
    for (int it = lo + w; it < hi; it += nworkers) conv_item(ap, it, scr, lane);
}

__device__ __forceinline__ void prologue(CArgs* ap, LAS unsigned char* lds, int gw, int NGW, int wave, int lane) {
    struct { const float* in[18]; float* out; unsigned char* ws; } a;
    a.in[0] = ap->in[0]; a.in[1] = ap->in[1]; a.in[6] = ap->in[6]; a.out = ap->out; a.ws = ap->ws;
    bf16* W = (bf16*)(a.ws + WS_W);
    for (int r = gw * 4 + (lane >> 4); r < 8 * D + M; r += NGW * 4) {
        bf16* p = r < 8 * D ? W + WO_FFNOUT + (size_t)r * DFFP + DFF : (bf16*)(a.ws + WS_ACT) + (size_t)(r - 8 * D) * DFFP + DFF;
        *(GAS v4u*)(p + (lane & 15) * 8) = (v4u){0u, 0u, 0u, 0u}; }
    for (int row = gw; row < M; row += NGW) {
        const float* xr = row < MP ? a.in[0] + (size_t)row * D : a.in[1] + (size_t)(row - MP) * D;
        const GAS f32x4* x4 = (const GAS f32x4*)xr + lane;
        f32x4 v[8]; float ss = 0.f;
#pragma unroll
        for (int j = 0; j < 8; ++j) { v[j] = x4[64 * j]; ss += (v[j].x * v[j].x + v[j].y * v[j].y) + (v[j].z * v[j].z + v[j].w * v[j].w); }
        const float rs = 1.0f / sqrtf(wave_sum(ss) * (1.f / D) + EPS);
        if (lane == 0) ((float*)(a.ws + WS_RS))[row] = rs;
        GAS v2u* ho = (GAS v2u*)((bf16*)(a.ws + WS_HB) + (size_t)row * D) + lane;
#pragma unroll
        for (int j = 0; j < 8; ++j) { v2u o; o.x = pk2(v[j].x, v[j].y); o.y = pk2(v[j].z, v[j].w); ho[64 * j] = o; }
    }
}

__device__ __forceinline__ void norm_row(f32x4 (&y)[8], bf16* XB, float* RS, float* yout, float sc, const GAS f32x4* ga4, int row, int lane) {
    GAS v2u* x2 = (GAS v2u*)(XB + (size_t)row * D) + lane;
    f32x4 x[8]; float ss = 0.f;
#pragma unroll
    for (int j = 0; j < 8; ++j) { const v2u w = x2[64 * j]; x[j] = (f32x4){bf_lo(w.x), bf_hi(w.x), bf_lo(w.y), bf_hi(w.y)}; }
#pragma unroll
    for (int j = 0; j < 8; ++j) ss += (y[j].x * y[j].x + y[j].y * y[j].y) + (y[j].z * y[j].z + y[j].w * y[j].w);
    const float r1 = sc / sqrtf(wave_sum(ss) * (1.f / D) + EPS);
    float s2 = 0.f;
#pragma unroll
    for (int j = 0; j < 8; ++j) { const f32x4 g = ga4[lane + 64 * j]; x[j] = x[j] + y[j] * g * r1;
        s2 += (x[j].x * x[j].x + x[j].y * x[j].y) + (x[j].z * x[j].z + x[j].w * x[j].w); }
    if (yout) {
        GAS f32x4* o4 = (GAS f32x4*)(yout + (size_t)row * D) + lane;
#pragma unroll
        for (int j = 0; j < 8; ++j) o4[64 * j] = x[j];
    } else {
#pragma unroll
        for (int j = 0; j < 8; ++j) { v2u o; o.x = pk2(x[j].x, x[j].y); o.y = pk2(x[j].z, x[j].w); x2[64 * j] = o; }
        const float r2 = 1.0f / sqrtf(wave_sum(s2) * (1.f / D) + EPS);
        if (lane == 0) RS[row] = r2;
    }
}
template <int NSL>
__device__ __forceinline__ void norm_phase(const bf16* Y, const float* YP, bf16* XB, float* RS, float* yout, float sc, const float* ga, int gw, int NGW, int lane) {
    const GAS f32x4* ga4 = (const GAS f32x4*)ga;
    if ((gw & 7) == 0) {
        for (int r = gw >> 3; r < MS; r += (NGW >> 3)) {
            const GAS f32x4* p4 = (const GAS f32x4*)(YP + (size_t)r * D) + lane;
            f32x4 y[8];
#pragma unroll
            for (int j = 0; j < 8; ++j) { f32x4 pv[NSL];
#pragma unroll
                for (int i = 0; i < NSL; ++i) pv[i] = p4[(size_t)i * (256 * D / 4) + 64 * j];
                f32x4 a = pv[0];
#pragma unroll
                for (int i = 1; i < NSL; ++i) a = a + pv[i];
                y[j] = a; }
            norm_row(y, XB, RS, yout, sc, ga4, MP + r, lane);
        }
    }
    for (int row = gw; row < MP; row += NGW) {
        const GAS v2u* y2 = (const GAS v2u*)(Y + (size_t)row * D) + lane;
        f32x4 y[8];
#pragma unroll
        for (int j = 0; j < 8; ++j) { const v2u w = y2[64 * j]; y[j] = (f32x4){bf_lo(w.x), bf_hi(w.x), bf_lo(w.y), bf_hi(w.y)}; }
        norm_row(y, XB, RS, yout, sc, ga4, row, lane);
    }
}

__device__ __forceinline__ unsigned ldz(const bf16* Zb, unsigned off) { return *(const GAS unsigned*)((const GAS char*)Zb + off); }
__device__ __forceinline__ void convpool_phase(CArgs* ap, int j, int bid, int G, int tid) {
    const bf16* Z = (const bf16*)(ap->ws + WS_Z); bf16* CAT = (bf16*)(ap->ws + WS_CAT); bf16* DP = (bf16*)(ap->ws + WS_DP);
    const int c = 2 * tid, gi = tid >> 7, w = 2 << gi;
    const float* cw = ap->in[10] + (size_t)j * 3 * DCV + c;
    const f32x2 w0 = *(const f32x2*)cw, w1 = *(const f32x2*)(cw + DCV), w2 = *(const f32x2*)(cw + 2 * DCV);
    float* out = ap->out;
    for (int u = bid; u < 256 + DB; u += G) {
        if (u < 256) {
            const int b = u >> 6, t0 = (u & 63) * 32; const int rb = b * SEQ;
            const bf16* Zb = Z + (size_t)rb * NMIX; bf16* Cb = CAT + (size_t)rb * D; bf16* Db = DP + (size_t)rb * DCV;
            f32x2 vm2 = {0.f, 0.f}, vm1 = {0.f, 0.f}, S = {0.f, 0.f};
            if (t0 > 0) {
                { const unsigned o = (unsigned)((t0 - 2) * NMIX + c) * 2u; const unsigned h = ldz(Zb, o), g = ldz(Zb, o + 2048u); vm2 = (f32x2){bf_lo(h) * bf_lo(g), bf_hi(h) * bf_hi(g)}; }
                { const unsigned o = (unsigned)((t0 - 1) * NMIX + c) * 2u; const unsigned h = ldz(Zb, o), g = ldz(Zb, o + 2048u); vm1 = (f32x2){bf_lo(h) * bf_lo(g), bf_hi(h) * bf_hi(g)}; }
                for (int i = 1; i <= w; ++i) { const unsigned uu = ldz(Zb, (unsigned)((t0 - i) * NMIX + 3072 + c) * 2u); S.x += bf_lo(uu); S.y += bf_hi(uu); }
            }
            const bool lastc = (t0 == SEQ - 32);
#pragma unroll 2
            for (int t = t0; t < t0 + 32; ++t) {
                const unsigned o = (unsigned)(t * NMIX + c) * 2u;
                const unsigned hh = ldz(Zb, o), gg = ldz(Zb, o + 2048u), bb = ldz(Zb, o + 4096u), uu = ldz(Zb, o + 6144u);
                unsigned uo = 0u; if (t >= w) uo = ldz(Zb, (unsigned)((t - w) * NMIX + 3072 + c) * 2u);
                const f32x2 v = {bf_lo(hh) * bf_lo(gg), bf_hi(hh) * bf_hi(gg)};
                const f32x2 yc = w0 * vm2 + w1 * vm1 + w2 * v; vm2 = vm1; vm1 = v;
                const f32x2 ut = {bf_lo(uu), bf_hi(uu)};
                S.x += ut.x - bf_lo(uo); S.y += ut.y - bf_hi(uo);
                const float cnt = (float)((t + 1 < w) ? (t + 1) : w);
                const f32x2 dd = S / cnt - ut;
                *(GAS unsigned*)((GAS char*)Cb + (unsigned)(t * D + c) * 2u) = pk2(bf_lo(bb) * yc.x, bf_hi(bb) * yc.y);
                *(GAS unsigned*)((GAS char*)Db + (unsigned)(t * DCV + c) * 2u) = pk2(dd.x, dd.y);
                if (lastc) {
                    if (t >= SEQ - 2) *(GAS f32x2*)((GAS char*)(out + O_CONVP + (size_t)(j * NB + b) * 2 * DCV) + (unsigned)((t - (SEQ - 2)) * DCV + c) * 4u) = v;
                    if (t >= SEQ - PCTX) *(GAS f32x2*)((GAS char*)(out + O_POOLP + (size_t)(j * NB + b) * PCTX * DCV) + (unsigned)((t - (SEQ - PCTX)) * DCV + c) * 4u) = ut;
                }
            }
        } else {
            const int b = u - 256; const int rb = MP + b * DS;
            const bf16* Zb = Z + (size_t)rb * NMIX; bf16* Cb = CAT + (size_t)rb * D; bf16* Db = DP + (size_t)rb * DCV;
            const GAS char* cc = (const GAS char*)(ap->in[2] + (size_t)(j * DB + b) * 2 * DCV);
            const GAS char* pc = (const GAS char*)(ap->in[3] + (size_t)(j * DB + b) * PCTX * DCV);
            GAS char* pso = (GAS char*)(out + O_POOLS + (size_t)(j * DB + b) * PCTX * DCV);
            GAS char* cso = (GAS char*)(out + O_CONVS + (size_t)(j * DB + b) * 2 * DCV);
            const unsigned c4 = (unsigned)c * 4u;
            f32x2 vm2 = *(const GAS f32x2*)(cc + c4), vm1 = *(const GAS f32x2*)(cc + c4 + DCV * 4u), S = {0.f, 0.f};
            for (int i = 1; i <= w && i <= PCTX; ++i) { const f32x2 p = *(const GAS f32x2*)(pc + c4 + (unsigned)(PCTX - i) * (DCV * 4u)); S += p; }
            for (int i = 0; i < PCTX - DS; ++i) *(GAS f32x2*)(pso + c4 + (unsigned)i * (DCV * 4u)) = *(const GAS f32x2*)(pc + c4 + (unsigned)(DS + i) * (DCV * 4u));
            for (int t = 0; t < DS; ++t) {
                const unsigned o = (unsigned)(t * NMIX + c) * 2u;
                const unsigned hh = ldz(Zb, o), gg = ldz(Zb, o + 2048u), bb = ldz(Zb, o + 4096u), uu = ldz(Zb, o + 6144u);
                f32x2 uo = {0.f, 0.f};
                if (t - w >= 0) { const unsigned uw = ldz(Zb, (unsigned)((t - w) * NMIX + 3072 + c) * 2u); uo = (f32x2){bf_lo(uw), bf_hi(uw)}; }
                else if (t - w >= -PCTX) uo = *(const GAS f32x2*)(pc + c4 + (unsigned)(PCTX + t - w) * (DCV * 4u));
                const f32x2 v = {bf_lo(hh) * bf_lo(gg), bf_hi(hh) * bf_hi(gg)};
                const f32x2 yc = w0 * vm2 + w1 * vm1 + w2 * v; vm2 = vm1; vm1 = v;
                const f32x2 ut = {bf_lo(uu), bf_hi(uu)};
                S += ut - uo;
                const f32x2 dd = S / (float)w - ut;
                *(GAS unsigned*)((GAS char*)Cb + (unsigned)(t * D + c) * 2u) = pk2(bf_lo(bb) * yc.x, bf_hi(bb) * yc.y);
                *(GAS unsigned*)((GAS char*)Db + (unsigned)(t * DCV + c) * 2u) = pk2(dd.x, dd.y);
                if (t >= DS - 2) *(GAS f32x2*)(cso + c4 + (unsigned)(t - (DS - 2)) * (DCV * 4u)) = v;
                *(GAS f32x2*)(pso + c4 + (unsigned)(PCTX - DS + t) * (DCV * 4u)) = ut;
            }
        }
    }
}

constexpr int AT_KP = 144, AT_VP = 520;
constexpr int AT_K = 0, AT_V = 256 * AT_KP, AT_B = AT_V + 64 * AT_VP, AT_END = AT_B + NHEAD * 192 * 4;
static_assert(AT_END <= RING_BYTES && (AT_V % 16) == 0 && (AT_B % 16) == 0, "attention LDS map");
__device__ __forceinline__ int crow(int r, int hi) { return (r & 3) + 8 * (r >> 2) + 4 * hi; }

__device__ __forceinline__ void attention_phase(CArgs* ap, LAS unsigned char* lds, int j, int bid, int G, int tid, int wave, int lane_in) {
    const bf16* QKV = (const bf16*)(ap->ws + WS_Z); bf16* ATT = (bf16*)(ap->ws + WS_CAT);
    float* out = ap->out; const float* relb = ap->in[17]; const float* ck = ap->in[4]; const float* cv = ap->in[5]; const float* sinks = ap->in[16];
    LAS float* biasL = (LAS float*)(lds + AT_B);
    for (int e = tid; e < NHEAD * 192; e += NWAVES * 64) {
        const int h = e / 192, dist = e % 192 - 32; float v = -1e30f;
        if (dist >= 0 && dist <= 128) { int bk = dist;
            if (dist >= 16) { const float ratio = logf((float)dist / 16.0f) / 2.0794415416798357f; bk = 16 + (int)(ratio * 16.0f); if (bk > 31) bk = 31; }
            v = relb[bk * NHEAD + h] * LOG2E; }
        biasL[e] = v;
    }
    const float CS = 0.125f * LOG2E;
    for (int u = bid; u < 256 + DB * NKVH; u += G) {
        __syncthreads();
        asm volatile("" : "+v"(tid));
        const bool prompt = u < 256;
        int b, kvh, row0; bool first = false, lastb = false;
        if (prompt) { b = u >> 6; kvh = (u >> 4) & 3; const int qb = u & 15; row0 = b * SEQ + qb * 128; first = (qb == 0); lastb = (qb == 15); }
        else { const int su = u - 256; b = su >> 2; kvh = su & 3; row0 = MP + b * DS; }
        if (prompt) {
#pragma unroll
            for (int it = 0; it < 4; ++it) { const int id = it * 512 + tid, row = id >> 3, ch = id & 7;
                v4u kv = {0u, 0u, 0u, 0u}, vv = {0u, 0u, 0u, 0u};
                if (!(first && row < 128)) { const bf16* src = QKV + (size_t)(row0 - 128 + row) * NQKV + 2048 + kvh * 64 + ch * 8; kv = *(const GAS v4u*)src; vv = *(const GAS v4u*)(src + 256); }
                *(LAS v4u*)(lds + AT_K + row * AT_KP + ch * 16) = kv;
                LAS bf16* vt = (LAS bf16*)(lds + AT_V + (ch * 8) * AT_VP) + row;
                vt[0] = (bf16)(vv.x & 0xffff); vt[AT_VP / 2] = (bf16)(vv.x >> 16); vt[2 * (AT_VP / 2)] = (bf16)(vv.y & 0xffff); vt[3 * (AT_VP / 2)] = (bf16)(vv.y >> 16);
                vt[4 * (AT_VP / 2)] = (bf16)(vv.z & 0xffff); vt[5 * (AT_VP / 2)] = (bf16)(vv.z >> 16); vt[6 * (AT_VP / 2)] = (bf16)(vv.w & 0xffff); vt[7 * (AT_VP / 2)] = (bf16)(vv.w >> 16);
                if (lastb && row >= 128) { const size_t o = ((size_t)(j * NB + b) * KVB + (row - 128)) * 256 + kvh * 64 + ch * 8;
                    *(f32x4*)(out + O_KP + o) = (f32x4){bf_lo(kv.x), bf_hi(kv.x), bf_lo(kv.y), bf_hi(kv.y)}; *(f32x4*)(out + O_KP + o + 4) = (f32x4){bf_lo(kv.z), bf_hi(kv.z), bf_lo(kv.w), bf_hi(kv.w)};
                    *(f32x4*)(out + O_VP + o) = (f32x4){bf_lo(vv.x), bf_hi(vv.x), bf_lo(vv.y), bf_hi(vv.y)}; *(f32x4*)(out + O_VP + o + 4) = (f32x4){bf_lo(vv.z), bf_hi(vv.z), bf_lo(vv.w), bf_hi(vv.w)}; }
            }
        } else {
#pragma unroll
            for (int it = 0; it < 3; ++it) { const int id = it * 512 + tid, row = id >> 3, ch = id & 7;
                if (row < 160) {
                    v4u kv = {0u, 0u, 0u, 0u}, vv = {0u, 0u, 0u, 0u};
                    f32x4 k0 = {0.f, 0.f, 0.f, 0.f}, k1 = k0, v0 = k0, v1 = k0;
                    if (row < 128) { const size_t so = ((size_t)(j * DB + b) * KVB + row) * 256 + kvh * 64 + ch * 8;
                        k0 = *(const f32x4*)(ck + so); k1 = *(const f32x4*)(ck + so + 4); v0 = *(const f32x4*)(cv + so); v1 = *(const f32x4*)(cv + so + 4);
                        kv = (v4u){pk2(k0.x, k0.y), pk2(k0.z, k0.w), pk2(k1.x, k1.y), pk2(k1.z, k1.w)}; vv = (v4u){pk2(v0.x, v0.y), pk2(v0.z, v0.w), pk2(v1.x, v1.y), pk2(v1.z, v1.w)}; }
                    else if (row < 128 + DS) { const bf16* src = QKV + (size_t)(row0 + row - 128) * NQKV + 2048 + kvh * 64 + ch * 8; kv = *(const GAS v4u*)src; vv = *(const GAS v4u*)(src + 256);
                        k0 = (f32x4){bf_lo(kv.x), bf_hi(kv.x), bf_lo(kv.y), bf_hi(kv.y)}; k1 = (f32x4){bf_lo(kv.z), bf_hi(kv.z), bf_lo(kv.w), bf_hi(kv.w)};
                        v0 = (f32x4){bf_lo(vv.x), bf_hi(vv.x), bf_lo(vv.y), bf_hi(vv.y)}; v1 = (f32x4){bf_lo(vv.z), bf_hi(vv.z), bf_lo(vv.w), bf_hi(vv.w)}; }
                    *(LAS v4u*)(lds + AT_K + row * AT_KP + ch * 16) = kv;
                    LAS bf16* vt = (LAS bf16*)(lds + AT_V + (ch * 8) * AT_VP) + row;
                    vt[0] = (bf16)(vv.x & 0xffff); vt[AT_VP / 2] = (bf16)(vv.x >> 16); vt[2 * (AT_VP / 2)] = (bf16)(vv.y & 0xffff); vt[3 * (AT_VP / 2)] = (bf16)(vv.y >> 16);
                    vt[4 * (AT_VP / 2)] = (bf16)(vv.z & 0xffff); vt[5 * (AT_VP / 2)] = (bf16)(vv.z >> 16); vt[6 * (AT_VP / 2)] = (bf16)(vv.w & 0xffff); vt[7 * (AT_VP / 2)] = (bf16)(vv.w >> 16);
                    if (row >= DS && row < 128 + DS) { const size_t o = ((size_t)(j * DB + b) * KVB + (row - DS)) * 256 + kvh * 64 + ch * 8;
                        *(f32x4*)(out + O_KS + o) = k0; *(f32x4*)(out + O_KS + o + 4) = k1; *(f32x4*)(out + O_VS + o) = v0; *(f32x4*)(out + O_VS + o + 4) = v1; }
                }
            }
        }
        LDS_WAIT();
        __syncthreads();
        const int lane = tid & 63, l31 = lane & 31, hi = lane >> 5;
        const int h = kvh * 8 + wave;
        const float sink2 = sinks[j * NHEAD + h] * LOG2E;
        const LAS float* bl = biasL + h * 192 + 160 + l31 - 4 * hi;
        const int nsub = prompt ? 4 : 1;
        bf16x8 qn[4];
        { const int qrow0 = prompt ? (row0 + l31) : (row0 + (l31 & 7));
#pragma unroll
          for (int k0 = 0; k0 < 4; ++k0) qn[k0] = *(const GAS bf16x8*)(QKV + (size_t)qrow0 * NQKV + h * 64 + 16 * k0 + 8 * hi); }
        for (int sub = 0; sub < nsub; ++sub) {
            const int qrow = prompt ? (row0 + 32 * sub + l31) : (row0 + (l31 & 7));
            bf16x8 qr[4];
#pragma unroll
            for (int k0 = 0; k0 < 4; ++k0) qr[k0] = qn[k0];
            if (sub + 1 < nsub) {
#pragma unroll
                for (int k0 = 0; k0 < 4; ++k0) qn[k0] = *(const GAS bf16x8*)(QKV + (size_t)(qrow + 32) * NQKV + h * 64 + 16 * k0 + 8 * hi); }
            f32x16 acc[5];
#pragma unroll
            for (int jt = 0; jt < 5; ++jt) {
                const int T = sub + jt;
                f32x16 c = {0.f, 0.f, 0.f, 0.f, 0.f, 0.f, 0.f, 0.f, 0.f, 0.f, 0.f, 0.f, 0.f, 0.f, 0.f, 0.f};
#pragma unroll
                for (int k0 = 0; k0 < 4; ++k0) { const bf16x8 kf = *(const LAS bf16x8*)(lds + AT_K + (32 * T + l31) * AT_KP + (16 * k0 + 8 * hi) * 2);
                    c = __builtin_amdgcn_mfma_f32_32x32x16_bf16(kf, qr[k0], c, 0, 0, 0); }
                acc[jt] = c;
            }
            float mx = -1e30f;
#pragma unroll
            for (int jt = 0; jt < 5; ++jt) {
                const float tm = (first && (sub + jt) < 4) ? -1e30f : 0.f;
#pragma unroll
                for (int r = 0; r < 16; ++r) { const float s = acc[jt][r] * CS + (bl[-32 * jt - ((r & 3) + 8 * (r >> 2))] + tm); acc[jt][r] = s; mx = fmaxf(mx, s); }
            }
            mx = fmaxf(mx, __shfl_xor(mx, 32));
            mx = fmaxf(mx, sink2);
            float ls = 0.f;
#pragma unroll
            for (int jt = 0; jt < 5; ++jt)
#pragma unroll
                for (int r = 0; r < 16; ++r) { const float p = __builtin_amdgcn_exp2f(acc[jt][r] - mx); acc[jt][r] = p; ls += p; }
            ls += __shfl_xor(ls, 32);
            ls += __builtin_amdgcn_exp2f(sink2 - mx);
            f32x16 o0 = {0.f, 0.f, 0.f, 0.f, 0.f, 0.f, 0.f, 0.f, 0.f, 0.f, 0.f, 0.f, 0.f, 0.f, 0.f, 0.f}, o1 = o0;
#pragma unroll
            for (int jt = 0; jt < 5; ++jt) {
                const int T = sub + jt;
#pragma unroll
                for (int c2 = 0; c2 < 2; ++c2) {
                    v4u pw; pw.x = pk2(acc[jt][8 * c2 + 0], acc[jt][8 * c2 + 1]); pw.y = pk2(acc[jt][8 * c2 + 2], acc[jt][8 * c2 + 3]); pw.z = pk2(acc[jt][8 * c2 + 4], acc[jt][8 * c2 + 5]); pw.w = pk2(acc[jt][8 * c2 + 6], acc[jt][8 * c2 + 7]);
                    const bf16x8 pf = __builtin_bit_cast(bf16x8, pw);
                    const LAS unsigned char* vb = lds + AT_V + l31 * AT_VP + (32 * T + 16 * c2 + 4 * hi) * 2;
                    { const s16x4 lo = *(const LAS s16x4*)vb, hh = *(const LAS s16x4*)(vb + 16); const bf16x8 vf = {lo[0], lo[1], lo[2], lo[3], hh[0], hh[1], hh[2], hh[3]};
                      o0 = __builtin_amdgcn_mfma_f32_32x32x16_bf16(vf, pf, o0, 0, 0, 0); }
                    { const s16x4 lo = *(const LAS s16x4*)(vb + 32 * AT_VP), hh = *(const LAS s16x4*)(vb + 32 * AT_VP + 16); const bf16x8 vf = {lo[0], lo[1], lo[2], lo[3], hh[0], hh[1], hh[2], hh[3]};
                      o1 = __builtin_amdgcn_mfma_f32_32x32x16_bf16(vf, pf, o1, 0, 0, 0); }
                }
            }
            const float inv = 1.0f / ls;
            if (prompt || l31 < DS) {
                bf16* orow = ATT + (size_t)(prompt ? qrow : (row0 + l31)) * D + h * 64 + 4 * hi;
#pragma unroll
                for (int rq = 0; rq < 4; ++rq) {
                    v2u w0; w0.x = pk2(o0[4 * rq] * inv, o0[4 * rq + 1] * inv); w0.y = pk2(o0[4 * rq + 2] * inv, o0[4 * rq + 3] * inv); *(GAS v2u*)(orow + 8 * rq) = w0;
                    v2u w1; w1.x = pk2(o1[4 * rq] * inv, o1[4 * rq + 1] * inv); w1.y = pk2(o1[4 * rq + 2] * inv, o1[4 * rq + 3] * inv); *(GAS v2u*)(orow + 32 + 8 * rq) = w1;
                }
            }
        }
    }
    __syncthreads();
}

__global__ void __launch_bounds__(NWAVES * 64, 2) mega_fwd(Args args) {
    extern __shared__ __attribute__((aligned(16))) unsigned char lds_raw[];
    LAS unsigned char* lds = (LAS unsigned char*)lds_raw;
    const int tid = threadIdx.x, lane = tid & 63, wave = __builtin_amdgcn_readfirstlane(tid >> 6);
    const int G = gridDim.x, bid = blockIdx.x;
    const int vcu = (G % 8 == 0) ? (bid % 8) * (G / 8) + bid / 8 : bid;
    const int gw = vcu * NWAVES + wave, NGW = G * NWAVES;
    CArgs* ap0 = fresh_args();
    for (int u = tid; u < (LDS_BYTES - LDSCTL_OFF) / 4; u += NWAVES * 64) ((LAS unsigned*)(lds + LDSCTL_OFF))[u] = 0u;
    __syncthreads();
    XcdBarrier bar = xcd_barrier_post((unsigned*)(ap0->ws + WS_CTL) + CW_BAR, (volatile LAS unsigned*)(lds + MISC_OFF) + 8);
#define GRID_BAR() xcd_barrier(bar)
#define FRESH_TID() int tid_ = threadIdx.x; asm volatile("" : "+v"(tid_)); const int lane_ = tid_ & 63, wave_ = __builtin_amdgcn_readfirstlane(tid_ >> 6), gw_ = vcu * NWAVES + wave_; (void)lane_; (void)gw_

    int cursor = 0;
#define ENSURE(need) do { const int need_ = (need); if (cursor < need_) { FRESH_TID(); conv_range(fresh_args(), lds, cursor, need_, gw_, NGW, wave_, lane_); cursor = need_; } } while (0)
#define IDLE_CONV(first_idle, per_wave) do { if (cursor < IT_TOTAL) { const int nid_ = G - (first_idle); int hi_ = cursor + nid_ * NWAVES * (per_wave); if (hi_ > IT_TOTAL) hi_ = IT_TOTAL; \
        if (bid >= (first_idle)) { FRESH_TID(); conv_range(fresh_args(), lds, cursor, hi_, (bid - (first_idle)) * NWAVES + wave_, nid_ * NWAVES, wave_, lane_); } cursor = hi_; } } while (0)
    prologue(ap0, lds, gw, NGW, wave, lane);
    ENSURE(conv_seg_start(0, 1));
    GRID_BAR();

    for (int hl = 0; hl < 8; ++hl) {
        const int l = hl >> 1, f = hl & 1, j = l >> 1;
        const bool odd = (l & 1) != 0;
        {
            CArgs* ap = fresh_args(); unsigned char* ws = ap->ws;
            const pg8::Gemm g = pg8::plain_gemm((const bf16*)(ws + WS_HB), (const bf16*)(ws + WS_W) + WO_FFNIN + (size_t)hl * SZ_FFNIN, D, D, D); pg8::StaticOrder S; S.init(M, NFF, G, bid);
            pg8::EpiSwiGLU E{(bf16*)(ws + WS_ACT), DFFP, (const float*)(ws + WS_RS)};
            pg8::gemm_phase<pg8::EpiSwiGLU, pg8::StaticOrder, true, true>(lds, g, S, E);
        }
        IDLE_CONV((M / 256) * (NFF / 256) % G == 0 ? G : (M / 256) * (NFF / 256) % G, 7);
        ENSURE(conv_seg_start(l, f ? 7 : 2));
        GRID_BAR();
        {
            CArgs* ap = fresh_args(); unsigned char* ws = ap->ws;
            const bf16* Wo_ = (const bf16*)(ws + WS_W) + WO_FFNOUT + (size_t)hl * SZ_FFNOUT;
            { const pg8::Gemm g = pg8::plain_gemm((const bf16*)(ws + WS_ACT), Wo_, DFF, DFFP, DFFP); pg8::StaticOrder S; S.init(MP, D, G, bid);
              pg8::EpiBf16S E{(bf16*)(ws + WS_Y), D, nullptr, 0, nullptr};
              pg8::gemm_phase<pg8::EpiBf16S, pg8::StaticOrder, true, true>(lds, g, S, E); }
            { const pg8::Gemm g{(const bf16*)(ws + WS_ACT) + (size_t)MP * DFFP, Wo_, KSL_FFN, DFFP, DFFP, KSL_FFN * 2, 0, (size_t)256 * DFFP * 2, KSL_FFN * 2}; pg8::StaticOrder S; S.init(NSL_FFN * 256, D, G, bid);
              pg8::EpiF32 E{(float*)(ws + WS_YP), D};
              pg8::gemm_phase<pg8::EpiF32, pg8::StaticOrder, true, true>(lds, g, S, E); }
        }
        GRID_BAR();
        {
            CArgs* ap = fresh_args(); unsigned char* ws = ap->ws; const float* NG = ap->in[6];
            const float* ga = NG + (size_t)(l * 6 + (f ? 5 : 1)) * D;
            FRESH_TID();
            norm_phase<NSL_FFN>((const bf16*)(ws + WS_Y), (const float*)(ws + WS_YP), (bf16*)(ws + WS_HB), (float*)(ws + WS_RS), hl == 7 ? ap->out : nullptr, 0.5f, ga, gw_, NGW, lane_);
        }
        ENSURE(f == 0 ? conv_seg_start(l, 3) : (l < 3 ? conv_seg_start(l + 1, 1) : IT_TOTAL));
        GRID_BAR();
        if (f == 0) {
            {
                CArgs* ap = fresh_args(); unsigned char* ws = ap->ws;
                const int N = odd ? NQKV : NMIX; const bf16* W = (const bf16*)(ws + WS_W);
                const pg8::Gemm g = pg8::plain_gemm((const bf16*)(ws + WS_HB), odd ? W + WO_QKV + (size_t)j * SZ_QKV : W + WO_MIXIN + (size_t)j * SZ_MIXIN, D, D, D); pg8::StaticOrder S; S.init(M, N, G, bid);
                pg8::EpiBf16S E{(bf16*)(ws + WS_Z), N, nullptr, 0, (const float*)(ws + WS_RS)};
                pg8::gemm_phase<pg8::EpiBf16S, pg8::StaticOrder, true, true>(lds, g, S, E);
            }
            { const int nu_ = (M / 256) * ((odd ? NQKV : NMIX) / 256); IDLE_CONV(nu_ % G == 0 ? G : nu_ % G, odd ? 5 : 4); }
            ENSURE(conv_seg_start(l, 5));
            GRID_BAR();
            if (odd) {
                FRESH_TID();
                attention_phase(fresh_args(), lds, j, bid, G, tid_, wave_, lane_);
                GRID_BAR();
            } else {
                { FRESH_TID();
                  convpool_phase(fresh_args(), j, bid, G, tid_); }
                GRID_BAR();
                {
                    CArgs* ap = fresh_args(); unsigned char* ws = ap->ws;
                    const pg8::Gemm g{(const bf16*)(ws + WS_DP), (const bf16*)(ws + WS_W) + WO_POOLW + (size_t)j * SZ_POOLW, 256, DCV, 256, (size_t)256 * DCV * 2, 512, (size_t)256 * 256 * 2, 0}; pg8::StaticOrder S; S.init(M, DCV, G, bid);
                    pg8::EpiBf16S E{(bf16*)(ws + WS_CAT), D, ap->in[12] + (size_t)j * DCV, DCV, nullptr};
                    pg8::gemm_phase<pg8::EpiBf16S, pg8::StaticOrder, true, true>(lds, g, S, E);
                }
                GRID_BAR();
            }
            {
                CArgs* ap = fresh_args(); unsigned char* ws = ap->ws; const bf16* W = (const bf16*)(ws + WS_W);
                const bf16* Wm = odd ? W + WO_WO + (size_t)j * SZ_WO : W + WO_MIXOUT + (size_t)j * SZ_MIXOUT;
                { const pg8::Gemm g = pg8::plain_gemm((const bf16*)(ws + WS_CAT), Wm, D, D, D); pg8::StaticOrder S; S.init(MP, D, G, bid);
                  pg8::EpiBf16S E{(bf16*)(ws + WS_Y), D, nullptr, 0, nullptr};
                  pg8::gemm_phase<pg8::EpiBf16S, pg8::StaticOrder, true, true>(lds, g, S, E); }
                { const pg8::Gemm g{(const bf16*)(ws + WS_CAT) + (size_t)MP * D, Wm, KSL_MIX, D, D, KSL_MIX * 2, 0, (size_t)256 * D * 2, KSL_MIX * 2}; pg8::StaticOrder S; S.init(NSL_MIX * 256, D, G, bid);
                  pg8::EpiF32 E{(float*)(ws + WS_YP), D};
                  pg8::gemm_phase<pg8::EpiF32, pg8::StaticOrder, true, true>(lds, g, S, E); }
            }
            GRID_BAR();
            {   CArgs* ap = fresh_args(); unsigned char* ws = ap->ws; const float* NG = ap->in[6];
                FRESH_TID();
                norm_phase<NSL_MIX>((const bf16*)(ws + WS_Y), (const float*)(ws + WS_YP), (bf16*)(ws + WS_HB), (float*)(ws + WS_RS), nullptr, 1.0f, NG + (size_t)(l * 6 + 3) * D, gw_, NGW, lane_); }
            ENSURE(conv_seg_start(l, 6));
            GRID_BAR();
        }
    }
}

extern "C" void kernel_launch(void* const* d_in, const int* in_sizes, int n_in, void* d_out, int out_size, void* d_ws, size_t ws_size, hipStream_t stream) {
    static int grid = 0;
    if (grid == 0) {
        if (n_in != 18 || out_size != (int)O_END || ws_size < WS_END) { fprintf(stderr, "kernel_launch: unexpected shapes (n_in %d, out %d, ws %zu; need ws >= %zu)\n", n_in, out_size, ws_size, (size_t)WS_END); grid = -1; return; }
        int dev = 0, cus = 0, per_cu = 0;
        if (hipGetDevice(&dev) != hipSuccess || hipDeviceGetAttribute(&cus, hipDeviceAttributeMultiprocessorCount, dev) != hipSuccess) { grid = -1; return; }
        if (hipFuncSetAttribute((const void*)mega_fwd, hipFuncAttributeMaxDynamicSharedMemorySize, LDS_BYTES) != hipSuccess) { fprintf(stderr, "kernel_launch: hipFuncSetAttribute failed\n"); grid = -1; return; }
        if (hipOccupancyMaxActiveBlocksPerMultiprocessor(&per_cu, (const void*)mega_fwd, NWAVES * 64, LDS_BYTES) != hipSuccess || per_cu < 1)
            fprintf(stderr, "kernel_launch: occupancy query reports %d\n", per_cu);
        (void)hipGetLastError();
        grid = cus;
    }
    if (grid < 0) return;
    if (hipMemsetAsync((char*)d_ws + WS_CTL, 0, CTL_ZERO_BYTES, stream) != hipSuccess) return;
    Args a{};
    for (int i = 0; i < 18; ++i) a.in[i] = (const float*)d_in[i];
    a.out = (float*)d_out; a.ws = (unsigned char*)d_ws;
    hipLaunchKernelGGL(mega_fwd, dim3(grid), dim3(NWAVES * 64), LDS_BYTES, stream, a);
}
```
